# Optimizing an MI355X kernel written in HIP

```python
import jax
import jax.numpy as jnp
from jax import lax
import numpy as np

D_MODEL = 2048
BATCH = 4
SEQ = 4096
DEPTH = 2

GRID_W = 64
CTX_LEN = 256
ROPE_THETA = 10000.0
NORM_EPS = 1e-6
Q_BLOCK = 128

A_HEADS = 8
A_KV_HEADS = 2
A_HEAD_DIM = 128
B_HEADS = 4
B_Q_RANK = 512
B_KV_RANK = 256
B_NOPE = 128
B_ROPE = 64
B_V = 128
C_HEADS = 4
C_DK = 64
C_DV = 128
C_GATE_RANK = 16
C_GATE_NORM = 16.0
C_CHUNK = 64

MIX_WIDTH = A_HEADS * A_HEAD_DIM + B_HEADS * B_V + C_HEADS * C_DV
D_FF = -(-8 * D_MODEL // (3 * 256)) * 256

SPLIT_SIZES = (
    A_HEADS * A_HEAD_DIM,
    A_KV_HEADS * A_HEAD_DIM,
    A_KV_HEADS * A_HEAD_DIM,
    B_Q_RANK,
    B_KV_RANK,
    B_ROPE,
    C_HEADS * C_DK,
    C_HEADS * C_DK,
    C_HEADS * C_DV,
    C_HEADS * C_DV,
    C_GATE_RANK,
    C_GATE_RANK,
)
IN_COLS = sum(SPLIT_SIZES)

kernel_name = "hybrid_dit_gqa_mla_gla_block"


def _rms_norm(x, g):
    xf = x.astype(jnp.float32)
    y = xf * lax.rsqrt(jnp.mean(xf * xf, axis=-1, keepdims=True) + NORM_EPS)
    return (y * g.astype(jnp.float32)).astype(x.dtype)


def _grid_positions(n):
    rows = n // GRID_W
    row = jnp.repeat(jnp.arange(rows, dtype=jnp.int32), GRID_W)
    col = jnp.tile(jnp.arange(GRID_W, dtype=jnp.int32), rows)
    return row, col


def _rope_1d(x, pos):
    half = x.shape[-1] // 2
    inv_freq = ROPE_THETA ** (-jnp.arange(half, dtype=jnp.float32) / half)
    ang = pos.astype(jnp.float32)[:, None] * inv_freq[None, :]
    cos = jnp.cos(ang)[:, None, :]
    sin = jnp.sin(ang)[:, None, :]
    xf = x.astype(jnp.float32)
    x1, x2 = xf[..., :half], xf[..., half:]
    return jnp.concatenate([x1 * cos - x2 * sin, x1 * sin + x2 * cos], axis=-1).astype(x.dtype)


def _rope_2d(x, row, col):
    d = x.shape[-1]
    return jnp.concatenate([_rope_1d(x[..., : d // 2], row), _rope_1d(x[..., d // 2:], col)], axis=-1)


def _block_attention(q, k, v):
    bsz, nq, hk, grp, d = q.shape
    nb = nq // Q_BLOCK
    scale = d ** -0.5
    qb = q.reshape(bsz, nb, Q_BLOCK, hk, grp, d).transpose(1, 0, 2, 3, 4, 5)

    def one_block(qblk):
        s = jnp.einsum("bqkgd,bnkd->bkgqn", qblk, k, preferred_element_type=jnp.float32) * scale
        p = jax.nn.softmax(s, axis=-1)
        return jnp.einsum("bkgqn,bnke->bqkge", p.astype(v.dtype), v)

    o = lax.map(one_block, qb)
    return o.transpose(1, 0, 2, 3, 4, 5).reshape(bsz, nq, hk * grp, v.shape[-1])


def _gla_chunk_scan(q, k, v, log_a, s0):
    bsz, n, h, _ = q.shape
    nc = n // C_CHUNK

    def to_chunks(t):
        return t.reshape(bsz, nc, C_CHUNK, h, t.shape[-1]).transpose(1, 0, 3, 2, 4)

    mask = jnp.tril(jnp.ones((C_CHUNK, C_CHUNK), dtype=bool))[:, :, None]

    def step(state, inp):
        qc, kc, vc, gc = inp
        cb = jnp.cumsum(gc, axis=2)
        inter = jnp.einsum("bhcd,bhde->bhce", qc * jnp.exp(cb), state)
        diff = cb[:, :, :, None, :] - cb[:, :, None, :, :]
        decay = jnp.where(mask, jnp.exp(jnp.where(mask, diff, 0.0)), 0.0)
        att = jnp.einsum("bhid,bhijd,bhjd->bhij", qc, decay, kc)
        intra = jnp.einsum("bhij,bhje->bhie", att, vc)
        last = cb[:, :, -1, :]
        new_state = jnp.exp(last)[..., None] * state + jnp.einsum(
            "bhjd,bhje->bhde", kc * jnp.exp(last[:, :, None, :] - cb), vc)
        return new_state, inter + intra

    s_fin, o = lax.scan(step, s0, (to_chunks(q), to_chunks(k), to_chunks(v), to_chunks(log_a)))
    o = o.transpose(1, 0, 3, 2, 4).reshape(bsz, n, h, v.shape[-1])
    return o, s_fin


def _gla_bidirectional(lat, cx):
    zero = jnp.zeros((cx["c_q"].shape[0], C_HEADS, C_DK, C_DV), jnp.float32)
    flip = lambda t: t[:, ::-1]
    oc_f, s_f = _gla_chunk_scan(cx["c_q"], cx["c_k"], cx["c_v"], cx["c_af"], zero)
    ol_f, _ = _gla_chunk_scan(lat["c_q"], lat["c_k"], lat["c_v"], lat["c_af"], s_f)
    oc_b, s_b = _gla_chunk_scan(flip(cx["c_q"]), flip(cx["c_k"]), flip(cx["c_v"]), flip(cx["c_ab"]), zero)
    ol_b, _ = _gla_chunk_scan(flip(lat["c_q"]), flip(lat["c_k"]), flip(lat["c_v"]), flip(lat["c_ab"]), s_b)
    return ol_f + flip(ol_b), oc_f + flip(oc_b)


def _stream_proj(h, pos, p):
    bsz, n, _ = h.shape
    idx = np.cumsum(SPLIT_SIZES)[:-1].tolist()
    (a_q, a_k, a_v, b_cq, b_ckv, b_kr, c_q, c_k, c_v, c_g, c_gf, c_gb) = jnp.split(h @ p["w_in"], idx, axis=-1)
    a_q = _rms_norm(a_q.reshape(bsz, n, A_HEADS, A_HEAD_DIM), p["a_q_norm"])
    a_k = _rms_norm(a_k.reshape(bsz, n, A_KV_HEADS, A_HEAD_DIM), p["a_k_norm"])
    a_v = a_v.reshape(bsz, n, A_KV_HEADS, A_HEAD_DIM)
    qb = (_rms_norm(b_cq, p["b_q_lora_norm"]) @ p["w_uq"]).reshape(bsz, n, B_HEADS, B_NOPE + B_ROPE)
    kvb = (_rms_norm(b_ckv, p["b_kv_lora_norm"]) @ p["w_ukv"]).reshape(bsz, n, B_HEADS, B_NOPE + B_V)
    q_nope = _rms_norm(qb[..., :B_NOPE], p["b_q_nope_norm"])
    q_rope = _rms_norm(qb[..., B_NOPE:], p["b_q_rope_norm"])
    k_nope = _rms_norm(kvb[..., :B_NOPE], p["b_k_nope_norm"])
    b_v = kvb[..., B_NOPE:]
    k_rope = _rms_norm(b_kr.reshape(bsz, n, 1, B_ROPE), p["b_k_rope_norm"])
    if pos is not None:
        row, col = pos
        a_q = _rope_2d(a_q, row, col)
        a_k = _rope_2d(a_k, row, col)
        q_rope = _rope_2d(q_rope, row, col)
        k_rope = _rope_2d(k_rope, row, col)
    b_q = jnp.concatenate([q_nope, q_rope], axis=-1)
    b_k = jnp.concatenate([k_nope, jnp.broadcast_to(k_rope, (bsz, n, B_HEADS, B_ROPE))], axis=-1)
    f32 = jnp.float32
    c_q = c_q.reshape(bsz, n, C_HEADS, C_DK).astype(f32) * (C_DK ** -0.5)
    c_k = c_k.reshape(bsz, n, C_HEADS, C_DK).astype(f32)
    c_v = c_v.reshape(bsz, n, C_HEADS, C_DV).astype(f32)
    c_af = jax.nn.log_sigmoid((c_gf @ p["w_gk_f"] + p["b_gk_f"]).astype(f32)).reshape(bsz, n, C_HEADS, C_DK) / C_GATE_NORM
    c_ab = jax.nn.log_sigmoid((c_gb @ p["w_gk_b"] + p["b_gk_b"]).astype(f32)).reshape(bsz, n, C_HEADS, C_DK) / C_GATE_NORM
    return {"a_q": a_q, "a_k": a_k, "a_v": a_v, "b_q": b_q, "b_k": b_k, "b_v": b_v,
            "c_q": c_q, "c_k": c_k, "c_v": c_v, "c_g": c_g, "c_af": c_af, "c_ab": c_ab}


def _merge(o_a, o_b, o_c, g, p):
    bsz, n = o_a.shape[:2]
    o_c = _rms_norm(o_c, p["c_out_norm"]) * jax.nn.silu(g.reshape(bsz, n, C_HEADS, C_DV).astype(jnp.float32))
    z = jnp.concatenate([o_a.reshape(bsz, n, -1), o_b.reshape(bsz, n, -1),
                         o_c.reshape(bsz, n, -1).astype(o_a.dtype)], axis=-1)
    return z @ p["w_out"]


def _mixers(h, hc, row, col, p, ctx_out):
    bsz, n, _ = h.shape
    lat = _stream_proj(h, (row, col), p)
    cx = _stream_proj(hc, None, p)
    grp = A_HEADS // A_KV_HEADS
    cat = lambda a, b: jnp.concatenate([a, b], axis=1)
    o_a = _block_attention(lat["a_q"].reshape(bsz, n, A_KV_HEADS, grp, A_HEAD_DIM),
                           cat(cx["a_k"], lat["a_k"]), cat(cx["a_v"], lat["a_v"]))
    o_b = _block_attention(lat["b_q"][:, :, :, None, :], cat(cx["b_k"], lat["b_k"]), cat(cx["b_v"], lat["b_v"]))
    o_c, oc_c = _gla_bidirectional(lat, cx)
    y = _merge(o_a, o_b, o_c, lat["c_g"], p)
    if not ctx_out:
        return y, None
    lc = hc.shape[1]
    oc_a = _block_attention(cx["a_q"].reshape(hc.shape[0], lc, A_KV_HEADS, grp, A_HEAD_DIM), cx["a_k"], cx["a_v"])
    oc_b = _block_attention(cx["b_q"][:, :, :, None, :], cx["b_k"], cx["b_v"])
    yc = _merge(oc_a, oc_b, oc_c, cx["c_g"], p)
    return y, yc


def _modulation(cvec, w_mod, b_mod):
    m = (jax.nn.silu(cvec) @ w_mod + b_mod)[:, None, :]
    return jnp.split(m, 6, axis=-1)


def _swiglu(h, p):
    return (jax.nn.silu(h @ p["w_gate"]) * (h @ p["w_up"])) @ p["w_down"]


def _layer(x, xc, c, c_ctx, row, col, p, ctx_out):
    sh1, sc1, g1, sh2, sc2, g2 = _modulation(c, p["w_mod"], p["b_mod"])
    csh1, csc1, cg1, csh2, csc2, cg2 = _modulation(c_ctx[None, :], p["w_mod"], p["b_mod"])
    h = _rms_norm(x, p["norm1_g"]) * (1 + sc1) + sh1
    hc = _rms_norm(xc, p["norm1_g"]) * (1 + csc1) + csh1
    y, yc = _mixers(h, hc, row, col, p, ctx_out)
    x = x + g1 * y
    x = x + g2 * _swiglu(_rms_norm(x, p["norm2_g"]) * (1 + sc2) + sh2, p)
    if ctx_out:
        xc = xc + cg1 * yc
        xc = xc + cg2 * _swiglu(_rms_norm(xc, p["norm2_g"]) * (1 + csc2) + csh2, p)
    return x, xc


def setup_inputs(seed: int = 0) -> dict:
    key = jax.random.key(seed)
    ks = jax.random.split(key, 32)
    f32 = jnp.float32

    def nrm(k, shape, scale):
        return jax.random.normal(k, shape, f32) * scale

    def gain(k, shape):
        return 1.0 + 0.02 * jax.random.normal(k, shape, f32)

    L = DEPTH
    return {
        "x": nrm(ks[0], (BATCH, SEQ, D_MODEL), 1.0),
        "c": nrm(ks[1], (BATCH, D_MODEL), 1.0),
        "ctx": nrm(ks[2], (BATCH, CTX_LEN, D_MODEL), 1.0),
        "c_ctx": nrm(ks[3], (D_MODEL,), 1.0),
        "w_mod": nrm(ks[4], (L, D_MODEL, 6 * D_MODEL), D_MODEL ** -0.5),
        "b_mod": nrm(ks[5], (L, 6 * D_MODEL), 0.01),
        "norm1_g": gain(ks[6], (L, D_MODEL)),
        "norm2_g": gain(ks[7], (L, D_MODEL)),
        "w_in": nrm(ks[8], (L, D_MODEL, IN_COLS), D_MODEL ** -0.5),
        "a_q_norm": gain(ks[9], (L, A_HEAD_DIM)),
        "a_k_norm": gain(ks[10], (L, A_HEAD_DIM)),
        "b_q_lora_norm": gain(ks[11], (L, B_Q_RANK)),
        "b_kv_lora_norm": gain(ks[12], (L, B_KV_RANK)),
        "w_uq": nrm(ks[13], (L, B_Q_RANK, B_HEADS * (B_NOPE + B_ROPE)), B_Q_RANK ** -0.5),
        "w_ukv": nrm(ks[14], (L, B_KV_RANK, B_HEADS * (B_NOPE + B_V)), B_KV_RANK ** -0.5),
        "b_q_nope_norm": gain(ks[15], (L, B_NOPE)),
        "b_k_nope_norm": gain(ks[16], (L, B_NOPE)),
        "b_q_rope_norm": gain(ks[17], (L, B_ROPE)),
        "b_k_rope_norm": gain(ks[18], (L, B_ROPE)),
        "w_gk_f": nrm(ks[19], (L, C_GATE_RANK, C_HEADS * C_DK), C_GATE_RANK ** -0.5),
        "b_gk_f": nrm(ks[20], (L, C_HEADS * C_DK), 0.1),
        "w_gk_b": nrm(ks[21], (L, C_GATE_RANK, C_HEADS * C_DK), C_GATE_RANK ** -0.5),
        "b_gk_b": nrm(ks[22], (L, C_HEADS * C_DK), 0.1),
        "c_out_norm": gain(ks[23], (L, C_DV)),
        "w_out": nrm(ks[24], (L, MIX_WIDTH, D_MODEL), MIX_WIDTH ** -0.5),
        "w_gate": nrm(ks[25], (L, D_MODEL, D_FF), D_MODEL ** -0.5),
        "w_up": nrm(ks[26], (L, D_MODEL, D_FF), D_MODEL ** -0.5),
        "w_down": nrm(ks[27], (L, D_FF, D_MODEL), D_FF ** -0.5),
    }


def reference(x, c, ctx, c_ctx, w_mod, b_mod, norm1_g, norm2_g, w_in, a_q_norm, a_k_norm,
              b_q_lora_norm, b_kv_lora_norm, w_uq, w_ukv, b_q_nope_norm, b_k_nope_norm,
              b_q_rope_norm, b_k_rope_norm, w_gk_f, b_gk_f, w_gk_b, b_gk_b, c_out_norm,
              w_out, w_gate, w_up, w_down):
    row, col = _grid_positions(x.shape[1])
    xc = ctx
    for l in range(DEPTH):
        p = {
            "w_mod": w_mod[l], "b_mod": b_mod[l], "norm1_g": norm1_g[l], "norm2_g": norm2_g[l],
            "w_in": w_in[l], "a_q_norm": a_q_norm[l], "a_k_norm": a_k_norm[l],
            "b_q_lora_norm": b_q_lora_norm[l], "b_kv_lora_norm": b_kv_lora_norm[l],
            "w_uq": w_uq[l], "w_ukv": w_ukv[l], "b_q_nope_norm": b_q_nope_norm[l],
            "b_k_nope_norm": b_k_nope_norm[l], "b_q_rope_norm": b_q_rope_norm[l],
            "b_k_rope_norm": b_k_rope_norm[l], "w_gk_f": w_gk_f[l], "b_gk_f": b_gk_f[l],
            "w_gk_b": w_gk_b[l], "b_gk_b": b_gk_b[l], "c_out_norm": c_out_norm[l],
            "w_out": w_out[l], "w_gate": w_gate[l], "w_up": w_up[l], "w_down": w_down[l],
        }
        x, xc = _layer(x, xc, c, c_ctx, row, col, p, l < DEPTH - 1)
    return x
```

```cpp
#include <hip/hip_runtime.h>
#include <hip/hip_cooperative_groups.h>
#include <hip/hip_bf16.h>
#include <cstdio>
#include <cstdint>
namespace cg = cooperative_groups;

#ifndef MK_COOP
#define MK_COOP 1
#endif
#define PROBE_DUP -1
#define PROBE_CUT 0
#define PROBE_ATT 0
#define PROBE_SYNC 0
#define PROBE_KIND -1

#define LAS __attribute__((address_space(3)))
typedef unsigned short bf16_t;
typedef short bf16x8 __attribute__((ext_vector_type(8)));
typedef short s16x4 __attribute__((ext_vector_type(4)));
typedef float f32x4 __attribute__((ext_vector_type(4)));
typedef float f32x2 __attribute__((ext_vector_type(2)));
typedef float f32x16 __attribute__((ext_vector_type(16)));
typedef unsigned u32x4 __attribute__((ext_vector_type(4)));
typedef unsigned u32x2 __attribute__((ext_vector_type(2)));

constexpr int DM = 2048, NBATCH = 4, SEQ = 4096, CTXL = 256, TOK = SEQ + CTXL  , NR = NBATCH * TOK  ;
constexpr int INC = 3936, INP = 4096, DFF = 5632;
constexpr int C_AQ = 0, C_AK = 1024, C_AV = 1280, C_BCQ = 1536, C_BCKV = 2048, C_BKR = 2304, C_CQ = 2368, C_CK = 2624, C_CV = 2880, C_CG = 3392, C_CGF = 3904, C_CGB = 3920;
constexpr float EPS = 1e-6f;
constexpr float QSCALE_A = 0.088388347648318440f * 1.4426950408889634f, QSCALE_B = 0.072168783648703220f * 1.4426950408889634f;
constexpr int NCHUNK = NR / 64;
constexpr size_t MiB = 1u << 20;
constexpr size_t WS_CTL = 0, CTL_BYTES = 1 * MiB;
constexpr size_t WS_MOD = 64 * 1024;
constexpr size_t WS_W = 1 * MiB, W_LAYER = 92 * MiB;
constexpr size_t WO_IN = 0, WO_UQ = 16 * MiB, WO_UKV = 17 * MiB, WO_OUT = 18 * MiB, WO_GU = 26 * MiB, WO_DN = 70 * MiB;
constexpr size_t WS_HZ = WS_W + 2 * W_LAYER;
constexpr size_t WS_XR = WS_HZ + 68 * MiB;
constexpr size_t WS_S = WS_XR + 136 * MiB;
constexpr size_t WS_PROJ = WS_S;
constexpr size_t WS_QB = WS_PROJ + 136 * MiB;
constexpr size_t WS_KVB = WS_QB + 26 * MiB;
constexpr size_t WS_KB = WS_KVB + 34 * MiB;
constexpr size_t WS_KVS = WS_KB + 26 * MiB;
constexpr size_t WS_DEC = WS_KVS + 68 * MiB;
constexpr size_t WS_ACT = WS_S;
constexpr size_t WS_END = WS_DEC + 1 * MiB;
constexpr int CW_QUEUE = 64;

constexpr size_t PART_OFF = 10u << 20;
constexpr int LDS_BYTES = 155648;
constexpr int LDS_QWORD = 153600;

__device__ __forceinline__ float bf2f(unsigned short x) { return __uint_as_float(((unsigned)x) << 16); }
__device__ __forceinline__ float bflo(unsigned w) { return __uint_as_float(w << 16); }
__device__ __forceinline__ float bfhi(unsigned w) { return __uint_as_float(w & 0xffff0000u); }
__device__ __forceinline__ unsigned cvt_pk_bf16(float lo, float hi) { unsigned r; asm volatile("v_cvt_pk_bf16_f32 %0, %1, %2" : "=v"(r) : "v"(lo), "v"(hi)); return r; }
__device__ __forceinline__ unsigned short f2bf(float f) { return (unsigned short)(cvt_pk_bf16(f, 0.f) & 0xffffu); }
__device__ __forceinline__ float wave_sum(float v) {
#pragma unroll
    for (int o = 1; o < 64; o <<= 1) v += __shfl_xor(v, o);
    return v;
}
__device__ __forceinline__ float silu_f(float g) { return g * __builtin_amdgcn_rcpf(1.f + __expf(-g)); }

namespace pg8 {
constexpr int BM = 256, BK = 64, HALF = 128, HTB = HALF * BK * 2, STAGE_BYTES = 8 * HTB, NXCD = 8, WGM = 8;
__host__ __device__ __forceinline__ int lds_byte(int r, int c) { const int st = (r >> 4) * 2 + (c >> 5), rr = r & 15, cc = c & 31, ob = rr * 64 + cc * 2; return st * 1024 + (ob ^ (((ob >> 9) & 1) << 5)); }
__host__ __device__ __forceinline__ void stage_rc(int b, int& R, int& C) { const int st = b / 1024, sb = b % 1024, swz = sb ^ (((sb >> 9) & 1) << 5); R = (st >> 1) * 16 + swz / 64; C = (st & 1) * 32 + (swz % 64) / 2; }
__host__ __device__ __forceinline__ int perm32(int rho) { const int n = rho >> 4, i = rho & 15; return 8 * (i >> 2) + 4 * n + (i & 3); }
struct Unit { int pm, pn, kp; };
struct Gemm { const bf16_t* A; const bf16_t* Bt; int M, N, K, lda, skipctx, kpart; };
__device__ __forceinline__ int phys_tile(int pm, int skip) { return skip == 1 ? pm + (pm >> 4) + 1 : (skip == 2 ? pm * 17 : pm); }
struct StaticOrder {
    int nM, nN, nwg, G, c, n2;
    __device__ void init(int M, int N, int G_, int c_, int ks = 1) { nM = M / BM; nN = N / BM; n2 = nM * nN; nwg = n2 * ks; G = G_; c = c_; }
    __device__ bool next(int i, Unit& u) const {
        const long L = (long)i * G + c; if (L >= nwg) return false;
        int wgid = (int)L; { const int q = nwg / NXCD, r = nwg % NXCD, xcd = wgid % NXCD, off = wgid / NXCD; wgid = (xcd < r ? xcd * (q + 1) : r * (q + 1) + (xcd - r) * q) + off; }
        u.kp = wgid / n2; wgid -= u.kp * n2;
        const int nig = WGM * nN, gid = wgid / nig, fm = gid * WGM, gsz = (nM - fm) < WGM ? (nM - fm) : WGM;
        u.pm = fm + ((wgid % nig) % gsz); u.pn = (wgid % nig) / gsz; return true;
    }
};
struct EpiStore {
    static constexpr bool PERM = true;
    bf16_t* O; int ldc; int skipctx;
    __device__ __forceinline__ void operator()(const f32x4 (&acc)[2][2][4][2], const Unit& u, int wr, int wc, int fr, int fq) const {
        const int row0 = phys_tile(u.pm, skipctx) * BM + wr * 64 + fr, col0 = u.pn * BM + wc * 32 + 8 * fq;
#pragma unroll
        for (int ai = 0; ai < 2; ++ai)
#pragma unroll
            for (int m = 0; m < 4; ++m) { bf16_t* rowp = O + (size_t)(row0 + ai * HALF + m * 16) * ldc + col0;
#pragma unroll
                for (int bj = 0; bj < 2; ++bj) { const f32x4 v0 = acc[ai][bj][m][0], v1 = acc[ai][bj][m][1];
                    u32x4 w; w.x = cvt_pk_bf16(v0[0], v0[1]); w.y = cvt_pk_bf16(v0[2], v0[3]); w.z = cvt_pk_bf16(v1[0], v1[1]); w.w = cvt_pk_bf16(v1[2], v1[3]);
                    *(u32x4*)(rowp + bj * HALF) = w; } }
    }
};
struct EpiSwiGLU {
    static constexpr bool PERM = true;
    bf16_t* O; int skipctx;
    __device__ __forceinline__ void operator()(const f32x4 (&acc)[2][2][4][2], const Unit& u, int wr, int wc, int fr, int fq) const {
        const int row0 = phys_tile(u.pm, skipctx) * BM + wr * 64 + fr, col0 = u.pn * HALF + wc * 32 + 8 * fq;
#pragma unroll
        for (int ai = 0; ai < 2; ++ai)
#pragma unroll
            for (int m = 0; m < 4; ++m) { bf16_t* rowp = O + (size_t)(row0 + ai * HALF + m * 16) * DFF + col0;
                float r[8];
#pragma unroll
                for (int n = 0; n < 2; ++n)
#pragma unroll
                    for (int e = 0; e < 4; ++e) r[n * 4 + e] = silu_f(acc[ai][0][m][n][e]) * acc[ai][1][m][n][e];
                u32x4 w; w.x = cvt_pk_bf16(r[0], r[1]); w.y = cvt_pk_bf16(r[2], r[3]); w.z = cvt_pk_bf16(r[4], r[5]); w.w = cvt_pk_bf16(r[6], r[7]);
                *(u32x4*)rowp = w; }
    }
};
struct EpiPartial {
    static constexpr bool PERM = false;
    float* P;
    __device__ __forceinline__ void operator()(const f32x4 (&acc)[2][2][4][2], const Unit& u, int wr, int wc, int fr, int fq) const {
        float* t = P + ((size_t)(u.kp * 32 + u.pm * 8 + u.pn) << 16); const int col0 = wc * 32 + 4 * fq;
#pragma unroll
        for (int ai = 0; ai < 2; ++ai)
#pragma unroll
            for (int m = 0; m < 4; ++m) { float* rp = t + (ai * HALF + wr * 64 + m * 16 + fr) * 256 + col0;
#pragma unroll
                for (int bj = 0; bj < 2; ++bj)
#pragma unroll
                    for (int n = 0; n < 2; ++n) *(f32x4*)(rp + bj * HALF + n * 16) = acc[ai][bj][m][n]; }
    }
};
struct EpiResid {
    static constexpr bool PERM = false;
    const float* xin; const float* ctxin; const float* xr_in; float* xr_out; float* fin_out; const float* gate; int in_split, out_final, skipctx;
    __device__ __forceinline__ void operator()(const f32x4 (&acc)[2][2][4][2], const Unit& u, int wr, int wc, int fr, int fq) const {
        const int pt = phys_tile(u.pm, skipctx), b = pt / 17, t = pt - b * 17, v = (t == 0) ? 4 : b;
        const float* inb = in_split ? (t == 0 ? ctxin + (size_t)b * CTXL * DM : xin + ((size_t)b * SEQ + (size_t)(t - 1) * 256) * DM) : xr_in + (size_t)pt * BM * DM;
        float* ob = out_final ? fin_out + ((size_t)b * SEQ + (size_t)(t - 1) * 256) * DM : xr_out + (size_t)pt * BM * DM;
        const int col0 = u.pn * BM + wc * 32 + 4 * fq;
        const float* gp = gate + (size_t)v * 12288 + col0;
        f32x4 gv[2][2];
#pragma unroll
        for (int bj = 0; bj < 2; ++bj)
#pragma unroll
            for (int n = 0; n < 2; ++n) gv[bj][n] = *(const f32x4*)(gp + bj * HALF + n * 16);
#pragma unroll
        for (int ai = 0; ai < 2; ++ai)
#pragma unroll
            for (int m = 0; m < 4; ++m) { const size_t off = (size_t)(ai * HALF + wr * 64 + m * 16 + fr) * DM + col0;
#pragma unroll
                for (int bj = 0; bj < 2; ++bj)
#pragma unroll
                    for (int n = 0; n < 2; ++n) { const f32x4 bs = *(const f32x4*)(inb + off + bj * HALF + n * 16);
                        *(f32x4*)(ob + off + bj * HALF + n * 16) = bs + gv[bj][n] * acc[ai][bj][m][n]; }
                if (m == 3) asm volatile("" ::: "memory"); }
    }
};

template <class Epi>
__device__ __forceinline__ void gemm_phase(LAS unsigned char* lds, const Gemm g, const StaticOrder& S, const Epi& E) {
    int tid_ = threadIdx.x; asm volatile("" : "+v"(tid_));
    const int tid = tid_, wid = __builtin_amdgcn_readfirstlane(tid >> 6), lane = tid & 63, wr = wid >> 2, wc = wid & 3, fr = lane & 15, fq = lane >> 4;
    const int K = g.K, nt = g.kpart / BK, lda = g.lda;
    unsigned voffA[2], voffB[2];
#pragma unroll
    for (int i = 0; i < 2; ++i) { int R, C; stage_rc(tid * 16 + i * 8192, R, C); const int Rb = Epi::PERM ? ((R & ~31) + perm32(R & 31)) : R;
        voffA[i] = (unsigned)(R * lda + C) * 2u; voffB[i] = (unsigned)(Rb * K + C) * 2u; }
    const size_t kstep = (size_t)(BK * 2);
    const size_t hstepA = (size_t)HALF * lda * 2, hstepB = (size_t)HALF * K * 2;
    const size_t tstepA = 2 * hstepA, tstepB = 2 * hstepB;
    const unsigned ldsw = (unsigned)wid * 1024u;
    const int aoff = lds_byte(wr * 64 + fr, fq * 8), boff = lds_byte(wc * 32 + fr, fq * 8);
#define PG8_SA(b, h) (((b) * 2 + (h)) * HTB)
#define PG8_SB(b, h) ((4 + (b) * 2 + (h)) * HTB)
#define PG8_STAGE(bufoff, gbase, voff) do { _Pragma("unroll") for (int _i = 0; _i < 2; ++_i) \
        __builtin_amdgcn_global_load_lds((const unsigned*)((const char*)(gbase) + (voff)[_i]), (LAS unsigned*)(lds + (bufoff) + ldsw + _i * 8192), 16, 0, 0); } while (0)
#define PG8_LDA(dst, b, h) do { _Pragma("unroll") for (int m = 0; m < 4; ++m) _Pragma("unroll") for (int k = 0; k < 2; ++k) dst[m][k] = *(const LAS bf16x8*)(lds + PG8_SA(b, h) + aoff + m * 2048 + k * 1024); } while (0)
#define PG8_LDB(dst, b, h) do { _Pragma("unroll") for (int n = 0; n < 2; ++n) _Pragma("unroll") for (int k = 0; k < 2; ++k) dst[n][k] = *(const LAS bf16x8*)(lds + PG8_SB(b, h) + boff + n * 2048 + k * 1024); } while (0)
#define PG8_MMA(ai, bj, At, Bt) do { __builtin_amdgcn_s_setprio(1); _Pragma("unroll") for (int m = 0; m < 4; ++m) _Pragma("unroll") for (int n = 0; n < 2; ++n) _Pragma("unroll") for (int k = 0; k < 2; ++k) \
        acc[ai][bj][m][n] = __builtin_amdgcn_mfma_f32_16x16x32_bf16(Bt[n][k], At[m][k], acc[ai][bj][m][n], 0, 0, 0); __builtin_amdgcn_s_setprio(0); } while (0)
#define PG8_WAIT_V(n) asm volatile("s_waitcnt vmcnt(" #n ")" ::: "memory")
#define PG8_WAIT_L(n) asm volatile("s_waitcnt lgkmcnt(" #n ")" ::: "memory")
#define PG8_BAR __builtin_amdgcn_s_barrier()
#define PG8_SCHED __builtin_amdgcn_sched_barrier(0)
    Unit cur, nxt; int ui = 0;
    if (!S.next(0, cur)) return;
    f32x4 acc[2][2][4][2];
#pragma unroll
    for (int a = 0; a < 2; ++a)
#pragma unroll
        for (int b = 0; b < 2; ++b)
#pragma unroll
            for (int m = 0; m < 4; ++m)
#pragma unroll
                for (int n = 0; n < 2; ++n) acc[a][b][m][n] = (f32x4){0.f, 0.f, 0.f, 0.f};
    bf16x8 At[4][2], B0[2][2], B1[2][2];
    const size_t kpb = (size_t)g.kpart * 2;
    const char* cA = (const char*)g.A + (size_t)phys_tile(cur.pm, g.skipctx) * tstepA + cur.kp * kpb; const char* cB = (const char*)g.Bt + (size_t)cur.pn * tstepB + cur.kp * kpb;
    PG8_STAGE(PG8_SB(0, 0), cB, voffB); PG8_STAGE(PG8_SB(0, 1), cB + hstepB, voffB); PG8_STAGE(PG8_SA(0, 0), cA, voffA); PG8_STAGE(PG8_SA(0, 1), cA + hstepA, voffA);
    if (wr == 1) PG8_BAR;
    PG8_WAIT_V(2); PG8_BAR;
    PG8_STAGE(PG8_SB(1, 0), cB + kstep, voffB); PG8_STAGE(PG8_SA(1, 0), cA + kstep, voffA); PG8_STAGE(PG8_SB(1, 1), cB + hstepB + kstep, voffB);
    PG8_WAIT_V(6); PG8_BAR;
    for (;;) {
        const bool has_next = S.next(ui + 1, nxt);
        const char* nA = has_next ? (const char*)g.A + (size_t)phys_tile(nxt.pm, g.skipctx) * tstepA + nxt.kp * kpb : cA; const char* nB = has_next ? (const char*)g.Bt + (size_t)nxt.pn * tstepB + nxt.kp * kpb : cB;
        for (int t = 0; t < nt; t += 2) {
            const bool last = (t == nt - 2);
            const char* a1 = cA + (size_t)(t + 1) * kstep;
            const char* a2 = last ? nA : cA + (size_t)(t + 2) * kstep; const char* b2 = last ? nB : cB + (size_t)(t + 2) * kstep;
            const char* a3 = a2 + kstep; const char* b3 = b2 + kstep;
            PG8_LDB(B0, 0, 0); PG8_LDB(B1, 0, 1); PG8_SCHED; PG8_LDA(At, 0, 0); PG8_STAGE(PG8_SA(1, 1), a1 + hstepA, voffA);
            PG8_WAIT_V(8); PG8_WAIT_L(0); PG8_BAR; PG8_MMA(0, 0, At, B0); PG8_MMA(0, 1, At, B1); PG8_BAR; PG8_SCHED;
            PG8_LDA(At, 0, 1); PG8_STAGE(PG8_SB(0, 0), b2, voffB); PG8_STAGE(PG8_SB(0, 1), b2 + hstepB, voffB); PG8_STAGE(PG8_SA(0, 0), a2, voffA);
            PG8_WAIT_V(8); PG8_WAIT_L(0); PG8_BAR; PG8_MMA(1, 0, At, B0); PG8_MMA(1, 1, At, B1); PG8_BAR; PG8_SCHED;
            PG8_LDB(B0, 1, 0); PG8_LDB(B1, 1, 1); PG8_SCHED; PG8_LDA(At, 1, 0); PG8_STAGE(PG8_SA(0, 1), a2 + hstepA, voffA);
            PG8_WAIT_V(8); PG8_WAIT_L(0); PG8_BAR; PG8_MMA(0, 0, At, B0); PG8_MMA(0, 1, At, B1); PG8_BAR; PG8_SCHED;
            PG8_LDA(At, 1, 1); PG8_STAGE(PG8_SB(1, 0), b3, voffB); PG8_STAGE(PG8_SB(1, 1), b3 + hstepB, voffB); PG8_STAGE(PG8_SA(1, 0), a3, voffA);
            PG8_WAIT_V(8); PG8_WAIT_L(0); PG8_BAR; PG8_MMA(1, 0, At, B0); PG8_MMA(1, 1, At, B1); PG8_BAR; PG8_SCHED;
        }
        if (wr == 0) PG8_BAR;
        E(acc, cur, wr, wc, fr, fq);
        if (!has_next) break;
#pragma unroll
        for (int a = 0; a < 2; ++a)
#pragma unroll
            for (int b = 0; b < 2; ++b)
#pragma unroll
                for (int m = 0; m < 4; ++m)
#pragma unroll
                    for (int n = 0; n < 2; ++n) acc[a][b][m][n] = (f32x4){0.f, 0.f, 0.f, 0.f};
        cur = nxt; cA = nA; cB = nB; ++ui;
        if (wr == 1) PG8_BAR;
    }
    PG8_WAIT_V(0);
    PG8_BAR;
#undef PG8_SA
#undef PG8_SB
#undef PG8_STAGE
#undef PG8_LDA
#undef PG8_LDB
#undef PG8_MMA
#undef PG8_WAIT_V
#undef PG8_WAIT_L
#undef PG8_BAR
#undef PG8_SCHED
}
}

namespace att {
using bf16 = bf16_t;
constexpr int NW = 8, QBLK = 32, KVBLK = 64;
constexpr float THR = 8.f;
#define SBAR() __builtin_amdgcn_sched_barrier(0)
__device__ __forceinline__ int crow(int r, int hi) { return (r & 3) + 8 * (r >> 2) + 4 * hi; }
template <int DQK> __device__ __forceinline__ int kswz(int r) { return DQK == 128 ? ((r & 15) << 4) : (((r >> 1) & 7) << 4); }
template <int DQK> struct Cfg {
    static constexpr int KCH = DQK / 8, NKC = 64 * KCH / 512, ROWB = DQK * 2;
    static constexpr int SHM_K = 64 * DQK * 2, SHM_V = 64 * 128 * 2;
    static constexpr float SCALE = DQK == 128 ? 0.088388347648318440f : 0.072168783648703220f;
};
template <int DQK> __device__ __forceinline__ void partialSM(f32x16& p0, f32x16& p1, float& m_reg, float& mn, float& alpha) {
    constexpr float SCALE = Cfg<DQK>::SCALE;
    constexpr float C = SCALE * 1.4426950408889634f;
    float pmax = p0[0];
#pragma unroll
    for (int r = 1; r < 16; ++r) pmax = fmaxf(pmax, p0[r]);
#pragma unroll
    for (int r = 0; r < 16; ++r) pmax = fmaxf(pmax, p1[r]);
    { auto rr = __builtin_amdgcn_permlane32_swap(__float_as_uint(pmax), __float_as_uint(pmax), false, false);
      pmax = fmaxf(__uint_as_float(rr[0]), __uint_as_float(rr[1])); }
    if (__builtin_expect(__all(pmax - m_reg <= THR / SCALE), 1)) { mn = m_reg; alpha = 1.f; }
    else { mn = fmaxf(m_reg, pmax); alpha = __builtin_amdgcn_exp2f((m_reg - mn) * C); m_reg = mn; }
    float mnC = -mn * C;
#pragma unroll
    for (int r = 0; r < 16; ++r) p0[r] = fmaf(p0[r], C, mnC);
#pragma unroll
    for (int r = 0; r < 16; ++r) p1[r] = fmaf(p1[r], C, mnC);
#pragma unroll
    for (int r = 0; r < 16; ++r) p0[r] = __builtin_amdgcn_exp2f(p0[r]);
}
__device__ __forceinline__ void finishSM(f32x16& p0, f32x16& p1, float alpha, float& l_reg, bf16x8& pa0, bf16x8& pa1, bf16x8& pa2, bf16x8& pa3) {
#pragma unroll
    for (int r = 0; r < 16; ++r) p1[r] = __builtin_amdgcn_exp2f(p1[r]);
    float ps = 0;
#pragma unroll
    for (int r = 0; r < 16; ++r) ps += p0[r];
#pragma unroll
    for (int r = 0; r < 16; ++r) ps += p1[r];
    { auto rr = __builtin_amdgcn_permlane32_swap(__float_as_uint(ps), __float_as_uint(ps), false, false);
      ps = __uint_as_float(rr[0]) + __uint_as_float(rr[1]); }
    l_reg = l_reg * alpha + ps;
#define PK4(P, BASE, OUT) do { unsigned a0 = cvt_pk_bf16(P[BASE + 0], P[BASE + 1]), a1 = cvt_pk_bf16(P[BASE + 2], P[BASE + 3]);   \
    unsigned b0 = cvt_pk_bf16(P[BASE + 4], P[BASE + 5]), b1 = cvt_pk_bf16(P[BASE + 6], P[BASE + 7]);                              \
    auto r0 = __builtin_amdgcn_permlane32_swap(a0, b0, false, false); auto r1 = __builtin_amdgcn_permlane32_swap(a1, b1, false, false); \
    u32x4 w = {r0[0], r1[0], r0[1], r1[1]}; OUT = *reinterpret_cast<bf16x8*>(&w); } while (0)
    PK4(p0, 0, pa0); PK4(p0, 8, pa1); PK4(p1, 0, pa2); PK4(p1, 8, pa3);
#undef PK4
}
constexpr float THR2 = 8.f;
__device__ __forceinline__ void partialSM2(f32x16& p0, f32x16& p1, float& m_hat, f32x16& negm, float& alpha) {
    float pmax = fmaxf(p0[0], p0[1]);
#pragma unroll
    for (int r = 2; r < 16; ++r) pmax = fmaxf(pmax, p0[r]);
#pragma unroll
    for (int r = 0; r < 16; ++r) pmax = fmaxf(pmax, p1[r]);
    { auto rr = __builtin_amdgcn_permlane32_swap(__float_as_uint(pmax), __float_as_uint(pmax), false, false);
      pmax = fmaxf(__uint_as_float(rr[0]), __uint_as_float(rr[1])); }
    if (__builtin_expect(__all(pmax <= THR2), 1)) { alpha = 1.f; }
    else { const float dl = fmaxf(pmax, 0.f); m_hat += dl; alpha = __builtin_amdgcn_exp2f(-dl);
#pragma unroll
        for (int r = 0; r < 16; ++r) { p0[r] -= dl; p1[r] -= dl; }
#pragma unroll
        for (int r = 0; r < 16; ++r) negm[r] = -m_hat; }
#pragma unroll
    for (int r = 0; r < 16; ++r) p0[r] = __builtin_amdgcn_exp2f(p0[r]);
}
__device__ __forceinline__ void finishSM2(f32x16& p0, f32x16& p1, bf16x8& pa0, bf16x8& pa1, bf16x8& pa2, bf16x8& pa3) {
#pragma unroll
    for (int r = 0; r < 16; ++r) p1[r] = __builtin_amdgcn_exp2f(p1[r]);
#define PK4(P, BASE, OUT) do { unsigned a0 = cvt_pk_bf16(P[BASE + 0], P[BASE + 1]), a1 = cvt_pk_bf16(P[BASE + 2], P[BASE + 3]);   \
    unsigned b0 = cvt_pk_bf16(P[BASE + 4], P[BASE + 5]), b1 = cvt_pk_bf16(P[BASE + 6], P[BASE + 7]);                              \
    auto r0 = __builtin_amdgcn_permlane32_swap(a0, b0, false, false); auto r1 = __builtin_amdgcn_permlane32_swap(a1, b1, false, false); \
    u32x4 w = {r0[0], r1[0], r0[1], r1[1]}; OUT = *reinterpret_cast<bf16x8*>(&w); } while (0)
    PK4(p0, 0, pa0); PK4(p0, 8, pa1); PK4(p1, 0, pa2); PK4(p1, 8, pa3);
#undef PK4
}
template <int DQK> __device__ __forceinline__ void qkt(f32x16& p0, f32x16& p1, const char* Ks, const bf16x8* qr, const char* qrl, int r32, int hi, const f32x16& c0) {
    constexpr int ROWB = Cfg<DQK>::ROWB;
    p0 = c0; p1 = c0;
#pragma unroll
    for (int d0 = 0; d0 < 8; ++d0) { const int cb = (d0 * 16 + hi * 8) * 2;
        bf16x8 b0 = *reinterpret_cast<const bf16x8*>(Ks + r32 * ROWB + (cb ^ kswz<DQK>(r32)));
        bf16x8 b1 = *reinterpret_cast<const bf16x8*>(Ks + (32 + r32) * ROWB + (cb ^ kswz<DQK>(r32)));
        p0 = __builtin_amdgcn_mfma_f32_32x32x16_bf16(b0, qr[d0], p0, 0, 0, 0);
        p1 = __builtin_amdgcn_mfma_f32_32x32x16_bf16(b1, qr[d0], p1, 0, 0, 0);
        if constexpr (DQK == 192) { if (d0 == 3 || d0 == 7) SBAR(); } }
    if constexpr (DQK == 192) {
#pragma unroll
        for (int d0 = 8; d0 < 12; ++d0) { const int cb = (d0 * 16 + hi * 8) * 2;
            const bf16x8 q = *reinterpret_cast<const bf16x8*>(qrl + (d0 - 8) * 1024);
            bf16x8 b0 = *reinterpret_cast<const bf16x8*>(Ks + r32 * ROWB + (cb ^ kswz<DQK>(r32)));
            bf16x8 b1 = *reinterpret_cast<const bf16x8*>(Ks + (32 + r32) * ROWB + (cb ^ kswz<DQK>(r32)));
            p0 = __builtin_amdgcn_mfma_f32_32x32x16_bf16(b0, q, p0, 0, 0, 0);
            p1 = __builtin_amdgcn_mfma_f32_32x32x16_bf16(b1, q, p1, 0, 0, 0); }
    }
}
__device__ __forceinline__ int v_st(int k, int c) { const int kk = (k & ~0xC) | ((k & 4) << 1) | ((k & 8) >> 1); return ((kk >> 3) * 4 + (c >> 5)) * 512 + ((kk & 7) * 32 + (c & 31)) * 2; }
__device__ __forceinline__ int v_rd_base(int lane) { return ((lane & 3) << 3) | (((lane >> 2) & 3) << 6) | (((lane >> 4) & 1) << 5) | (((lane >> 5) & 1) << 8); }
constexpr int v_rd_off(int d0, int ks, int half) { return d0 * 512 + ks * 4096 + half * 2048; }
template <int OFF> __device__ __forceinline__ s16x4 tr_read(int vb) {
    s16x4 r; asm volatile("ds_read_b64_tr_b16 %0, %1 offset:%2" : "=&v"(r) : "v"(vb), "i"(OFF) : "memory"); return r;
}
template <int D0> __device__ __forceinline__ void pv_one(f32x16& od, int vb, bf16x8 pa0, bf16x8 pa1, bf16x8 pa2, bf16x8 pa3) {
    const s16x4 l0 = tr_read<v_rd_off(D0, 0, 0)>(vb), h0 = tr_read<v_rd_off(D0, 0, 1)>(vb), l1 = tr_read<v_rd_off(D0, 1, 0)>(vb), h1 = tr_read<v_rd_off(D0, 1, 1)>(vb);
    const s16x4 l2 = tr_read<v_rd_off(D0, 2, 0)>(vb), h2 = tr_read<v_rd_off(D0, 2, 1)>(vb), l3 = tr_read<v_rd_off(D0, 3, 0)>(vb), h3 = tr_read<v_rd_off(D0, 3, 1)>(vb);
    asm volatile("s_waitcnt lgkmcnt(0)" ::: "memory"); SBAR();
#define PK(L, H) (bf16x8){L[0], L[1], L[2], L[3], H[0], H[1], H[2], H[3]}
    od = __builtin_amdgcn_mfma_f32_32x32x16_bf16(pa0, PK(l0, h0), od, 0, 0, 0);
    od = __builtin_amdgcn_mfma_f32_32x32x16_bf16(pa1, PK(l1, h1), od, 0, 0, 0);
    od = __builtin_amdgcn_mfma_f32_32x32x16_bf16(pa2, PK(l2, h2), od, 0, 0, 0);
    od = __builtin_amdgcn_mfma_f32_32x32x16_bf16(pa3, PK(l3, h3), od, 0, 0, 0);
#undef PK
}
__device__ __forceinline__ void pv_d0(f32x16* o, int vb, bf16x8 pa0, bf16x8 pa1, bf16x8 pa2, bf16x8 pa3) {
    pv_one<0>(o[0], vb, pa0, pa1, pa2, pa3); pv_one<1>(o[1], vb, pa0, pa1, pa2, pa3); pv_one<2>(o[2], vb, pa0, pa1, pa2, pa3); pv_one<3>(o[3], vb, pa0, pa1, pa2, pa3);
}
template <int DQK, int SDEPTH, int LDQ, int LDK, int LDV, int LDO>
__device__ __forceinline__ void attn_body(const bf16* __restrict__ Qb, const bf16* __restrict__ Kh, const bf16* __restrict__ Vh,
                                          bf16* __restrict__ Ob, int seq, char* lds) {
    using C = Cfg<DQK>;
    constexpr int SHM_K = C::SHM_K, SHM_V = C::SHM_V, NKC = C::NKC, KCH = C::KCH, ROWB = C::ROWB;
    int tid_ = threadIdx.x; asm volatile("" : "+v"(tid_));
    const int tid = tid_, wid = tid >> 6, lane = tid & 63, r32 = lane & 31, hi = lane >> 5;
    char* V_lds = lds; char* K_lds = lds + 2 * SHM_V;
    float* ws = (float*)(lds + 2 * SHM_V + 2 * SHM_K) + wid * 64; float* li_l = ws; float* al_l = ws + 32;
    char* QR_lds = lds + 2 * SHM_V + 2 * SHM_K + 2048 + wid * 4096 + lane * 16;
    float m_reg = -1e30f, l_reg = 0; f32x16 o[4] = {}; bf16x8 qr[8];
    const bf16* Qw = Qb + (long)(wid * QBLK + r32) * LDQ + hi * 8;
    __syncthreads();
#pragma unroll
    for (int d0 = 0; d0 < 8; ++d0) qr[d0] = *reinterpret_cast<const bf16x8*>(Qw + d0 * 16);
    if constexpr (DQK == 192) {
#pragma unroll
        for (int d0 = 8; d0 < 12; ++d0) *reinterpret_cast<bf16x8*>(QR_lds + (d0 - 8) * 1024) = *reinterpret_cast<const bf16x8*>(Qw + d0 * 16);
    }
    const int sr = tid >> 4, sc = (tid & 15) * 8, vst0 = v_st(sr, sc), vst1 = v_st(32 + sr, sc);
    int krow[NKC], kcol[NKC], kdst[NKC];
#pragma unroll
    for (int i = 0; i < NKC; ++i) { const int c = tid + 512 * i; krow[i] = c / KCH; kcol[i] = (c % KCH) * 8; kdst[i] = krow[i] * ROWB + ((kcol[i] * 2) ^ kswz<DQK>(krow[i])); }
    const int vb0 = (int)(uintptr_t)V_lds + v_rd_base(lane);
    struct { bf16x8 vs0, vs1, ks[NKC]; } sr_[SDEPTH];
#define SLOAD(i, k0) do { sr_[i].vs0 = *reinterpret_cast<const bf16x8*>(&Vh[(long)((k0) + sr) * LDV + sc]); sr_[i].vs1 = *reinterpret_cast<const bf16x8*>(&Vh[(long)((k0) + 32 + sr) * LDV + sc]); \
    _Pragma("unroll") for (int q_ = 0; q_ < NKC; ++q_) sr_[i].ks[q_] = *reinterpret_cast<const bf16x8*>(&Kh[(long)((k0) + krow[q_]) * LDK + kcol[q_]]); } while (0)
#define SWRITE(b, i) do { *(bf16x8*)(V_lds + (b) * SHM_V + vst0) = sr_[i].vs0; *(bf16x8*)(V_lds + (b) * SHM_V + vst1) = sr_[i].vs1; \
    _Pragma("unroll") for (int q_ = 0; q_ < NKC; ++q_) *(bf16x8*)(K_lds + (b) * SHM_K + kdst[q_]) = sr_[i].ks[q_]; } while (0)
#define SWAIT() do { if constexpr (SDEPTH == 2) { if constexpr (NKC == 2) asm volatile("s_waitcnt vmcnt(4)" ::: "memory"); else asm volatile("s_waitcnt vmcnt(5)" ::: "memory"); } else asm volatile("s_waitcnt vmcnt(0)" ::: "memory"); } while (0)
#define RESC(a) do { if (__any((a) < 1.f)) { if (hi == 0) al_l[r32] = (a); asm volatile("s_waitcnt lgkmcnt(0)" ::: "memory"); \
    _Pragma("unroll") for (int d = 0; d < 4; ++d) _Pragma("unroll") for (int r = 0; r < 16; ++r) o[d][r] *= al_l[crow(r, hi)]; } } while (0)
    f32x16 pA0, pA1, pB0, pB1; float mnA, mnB, alA, alB; bf16x8 pa0, pa1, pa2, pa3; const int NT = seq / KVBLK;
    constexpr int SE = 0, SO = SDEPTH - 1;
    SLOAD(SE, 0); asm volatile("s_waitcnt vmcnt(0)" ::: "memory"); SWRITE(0, SE); __syncthreads();
    qkt<DQK>(pA0, pA1, K_lds, qr, QR_lds, r32, hi, f32x16{}); partialSM<DQK>(pA0, pA1, m_reg, mnA, alA);
    SLOAD(SO, KVBLK); if constexpr (SDEPTH == 2) { if (2 < NT) SLOAD(SE, 2 * KVBLK); }
    SWAIT(); SWRITE(1, SO); __syncthreads();
    for (int j = 1; j + 1 < NT; j += 2) {
        SBAR(); qkt<DQK>(pB0, pB1, K_lds + SHM_K, qr, QR_lds, r32, hi, f32x16{});
        finishSM(pA0, pA1, alA, l_reg, pa0, pa1, pa2, pa3); SBAR();
        SLOAD(SO, (j + SDEPTH) * KVBLK); SBAR();
        pv_d0(o, vb0, pa0, pa1, pa2, pa3); partialSM<DQK>(pB0, pB1, m_reg, mnB, alB);
        __syncthreads(); SWAIT(); SWRITE(0, SE);
        RESC(alB); __syncthreads();
        SBAR(); qkt<DQK>(pA0, pA1, K_lds, qr, QR_lds, r32, hi, f32x16{});
        finishSM(pB0, pB1, alB, l_reg, pa0, pa1, pa2, pa3); SBAR();
        if (SDEPTH == 1 || j + 3 < NT) SLOAD(SE, (j + 1 + SDEPTH) * KVBLK); SBAR();
        pv_d0(o, vb0 + (int)SHM_V, pa0, pa1, pa2, pa3); partialSM<DQK>(pA0, pA1, m_reg, mnA, alA);
        __syncthreads(); SWAIT(); SWRITE(1, SO);
        RESC(alA); __syncthreads();
    }
    SBAR(); qkt<DQK>(pB0, pB1, K_lds + SHM_K, qr, QR_lds, r32, hi, f32x16{});
    finishSM(pA0, pA1, alA, l_reg, pa0, pa1, pa2, pa3); SBAR();
    pv_d0(o, vb0, pa0, pa1, pa2, pa3); partialSM<DQK>(pB0, pB1, m_reg, mnB, alB);
    __syncthreads(); RESC(alB);
    finishSM(pB0, pB1, alB, l_reg, pa0, pa1, pa2, pa3); SBAR();
    pv_d0(o, vb0 + (int)SHM_V, pa0, pa1, pa2, pa3);
    if (hi == 0) li_l[r32] = l_reg; asm volatile("s_waitcnt lgkmcnt(0)" ::: "memory");
    float rli[16];
#pragma unroll
    for (int r = 0; r < 16; ++r) rli[r] = __builtin_amdgcn_rcpf(li_l[crow(r, hi)]);
    bf16* Ow = Ob + (long)(wid * QBLK) * LDO;
#pragma unroll
    for (int r = 0; r < 16; ++r) { const int orow = crow(r, hi);
#pragma unroll
        for (int d0 = 0; d0 < 4; ++d0) Ow[(long)orow * LDO + d0 * 32 + r32] = f2bf(o[d0][r] * rli[r]); }
#undef SLOAD
#undef SWRITE
#undef SWAIT
#undef RESC
}

template <int DQK, int LDQ, int LDK, int LDV, int LDO>
__device__ __forceinline__ void attn_body_s(const bf16* __restrict__ Qb, const bf16* __restrict__ Kh, const bf16* __restrict__ Vh,
                                            bf16* __restrict__ Ob, int seq, char* lds, int dup) {
    using C = Cfg<DQK>;
    constexpr int SHM_K = C::SHM_K, SHM_V = C::SHM_V, NKC = C::NKC, KCH = C::KCH, ROWB = C::ROWB;
    int tid_ = threadIdx.x; asm volatile("" : "+v"(tid_));
    const int tid = tid_, wid = __builtin_amdgcn_readfirstlane(tid >> 6), lane = tid & 63, r32 = lane & 31, hi = lane >> 5;
    const bool late = false;
    char* V_lds = lds; char* K_lds = lds + 3 * SHM_V;
    float* ws = (float*)(lds + 3 * SHM_V + 2 * SHM_K) + wid * 64; float* li_l = ws; float* al_l = ws + 32;
    char* QR_lds = lds + 3 * SHM_V + 2 * SHM_K + 2048 + wid * 4096 + lane * 16;
    float m_reg = 0.f; f32x16 o[4] = {}; f32x16 negm = {}, lsum = {}; bf16x8 qr[8];
    const bf16x8 ones = {0x3F80, 0x3F80, 0x3F80, 0x3F80, 0x3F80, 0x3F80, 0x3F80, 0x3F80};
    const bf16* Qw = Qb + (long)(wid * QBLK + r32) * LDQ + hi * 8;
    __syncthreads();
#pragma unroll
    for (int d0 = 0; d0 < 8; ++d0) qr[d0] = *reinterpret_cast<const bf16x8*>(Qw + d0 * 16);
    if constexpr (DQK == 192) {
#pragma unroll
        for (int d0 = 8; d0 < 12; ++d0) *reinterpret_cast<bf16x8*>(QR_lds + (d0 - 8) * 1024) = *reinterpret_cast<const bf16x8*>(Qw + d0 * 16);
    }
    const int sr = tid >> 4, sc = (tid & 15) * 8, vst0 = v_st(sr, sc), vst1 = v_st(32 + sr, sc);
    int ksrc[NKC], kdst[NKC];
#pragma unroll
    for (int i = 0; i < NKC; ++i) { const int c = tid + 512 * i, kr = c / KCH, kc = (c % KCH) * 8; ksrc[i] = kr * LDK + kc; kdst[i] = kr * ROWB + ((kc * 2) ^ kswz<DQK>(kr)); }
    const int vb0 = (int)(uintptr_t)V_lds + v_rd_base(lane);
    bf16x8 vs0, vs1, ks[NKC];
#define SLOAD(k0) do { vs0 = *reinterpret_cast<const bf16x8*>(&Vh[(long)((k0) + sr) * LDV + sc]); vs1 = *reinterpret_cast<const bf16x8*>(&Vh[(long)((k0) + 32 + sr) * LDV + sc]); \
    _Pragma("unroll") for (int q_ = 0; q_ < NKC; ++q_) ks[q_] = *reinterpret_cast<const bf16x8*>(&Kh[(long)(k0) * LDK + ksrc[q_]]); } while (0)
#define SWRITE(kb, vslot) do { *(bf16x8*)(V_lds + (vslot) * SHM_V + vst0) = vs0; *(bf16x8*)(V_lds + (vslot) * SHM_V + vst1) = vs1; \
    _Pragma("unroll") for (int q_ = 0; q_ < NKC; ++q_) *(bf16x8*)(K_lds + (kb) * SHM_K + kdst[q_]) = ks[q_]; } while (0)
    const int NT = seq / KVBLK;
    SLOAD(0); SWRITE(0, 0); SLOAD(KVBLK);
    __syncthreads();
    int vcur = 0, vnext = 1, vprev = 2;
    bf16x8 pa0, pa1, pa2, pa3;
    pa0 = bf16x8{}; pa1 = bf16x8{}; pa2 = bf16x8{}; pa3 = bf16x8{};
    for (int j = 0; j < NT; ++j) {
        const int b = j & 1;
        f32x16 p0, p1; float mn, al;
        if (late && j > 0) { pv_d0(o, vb0 + vprev * (int)SHM_V, pa0, pa1, pa2, pa3); }
        SBAR(); qkt<DQK>(p0, p1, K_lds + b * SHM_K, qr, QR_lds, r32, hi, negm);
        if ((PROBE_ATT & 1) && dup) { mn = 0.f; al = 1.f; } else
        partialSM2(p0, p1, m_reg, negm, al); SBAR();
        if (!((PROBE_ATT & 4) && dup)) {
        if (j + 1 < NT) { SWRITE(b ^ 1, vnext); }
        if (j + 2 < NT) { SLOAD((j + 2) * KVBLK); } }
        SBAR();
        if (__any(al < 1.f)) { if (hi == 0) al_l[r32] = al; asm volatile("s_waitcnt lgkmcnt(0)" ::: "memory");
#pragma unroll
            for (int d = 0; d < 4; ++d)
#pragma unroll
                for (int r = 0; r < 16; ++r) o[d][r] *= al_l[crow(r, hi)];
#pragma unroll
            for (int r = 0; r < 16; ++r) lsum[r] *= al_l[crow(r, hi)]; }
        if ((PROBE_ATT & 1) && dup) { pa0 = __builtin_bit_cast(bf16x8, (u32x4){cvt_pk_bf16(p0[0], p0[1]), cvt_pk_bf16(p0[2], p0[3]), cvt_pk_bf16(p0[4], p0[5]), cvt_pk_bf16(p0[6], p0[7])});
            pa1 = __builtin_bit_cast(bf16x8, (u32x4){cvt_pk_bf16(p0[8], p0[9]), cvt_pk_bf16(p0[10], p0[11]), cvt_pk_bf16(p0[12], p0[13]), cvt_pk_bf16(p0[14], p0[15])});
            pa2 = __builtin_bit_cast(bf16x8, (u32x4){cvt_pk_bf16(p1[0], p1[1]), cvt_pk_bf16(p1[2], p1[3]), cvt_pk_bf16(p1[4], p1[5]), cvt_pk_bf16(p1[6], p1[7])});
            pa3 = __builtin_bit_cast(bf16x8, (u32x4){cvt_pk_bf16(p1[8], p1[9]), cvt_pk_bf16(p1[10], p1[11]), cvt_pk_bf16(p1[12], p1[13]), cvt_pk_bf16(p1[14], p1[15])}); } else
        finishSM2(p0, p1, pa0, pa1, pa2, pa3); SBAR();
        lsum = __builtin_amdgcn_mfma_f32_32x32x16_bf16(pa0, ones, lsum, 0, 0, 0); lsum = __builtin_amdgcn_mfma_f32_32x32x16_bf16(pa1, ones, lsum, 0, 0, 0);
        lsum = __builtin_amdgcn_mfma_f32_32x32x16_bf16(pa2, ones, lsum, 0, 0, 0); lsum = __builtin_amdgcn_mfma_f32_32x32x16_bf16(pa3, ones, lsum, 0, 0, 0);
        if (!late && !((PROBE_ATT & 2) && dup)) { pv_d0(o, vb0 + vcur * (int)SHM_V, pa0, pa1, pa2, pa3); }
        if (!((PROBE_ATT & 8) && dup)) __syncthreads();
        { const int t = vprev; vprev = vcur; vcur = vnext; vnext = t; }
    }
    if (late) { pv_d0(o, vb0 + vprev * (int)SHM_V, pa0, pa1, pa2, pa3); }
    float rli[16];
#pragma unroll
    for (int r = 0; r < 16; ++r) rli[r] = __builtin_amdgcn_rcpf(lsum[r]);
    bf16* Ow = Ob + (long)(wid * QBLK) * LDO;
#pragma unroll
    for (int r = 0; r < 16; ++r) { const int orow = crow(r, hi);
#pragma unroll
        for (int d0 = 0; d0 < 4; ++d0) Ow[(long)orow * LDO + d0 * 32 + r32] = f2bf(o[d0][r] * rli[r]); }
#undef SLOAD
#undef SWRITE
}
#undef SBAR
}

struct Args { const float* in[28]; float* out; unsigned char* ws; int ph_lo, ph_hi, coop, pad; };
typedef const __attribute__((address_space(4))) Args CArgs;
enum { I_X = 0, I_C, I_CTX, I_CCTX, I_WMOD, I_BMOD, I_N1G, I_N2G, I_WIN, I_AQN, I_AKN, I_BQLN, I_BKVLN, I_WUQ, I_WUKV, I_BQNN, I_BKNN, I_BQRN, I_BKRN,
       I_WGKF, I_BGKF, I_WGKB, I_BGKB, I_CON, I_WOUT, I_WGATE, I_WUP, I_WDOWN };

__device__ __forceinline__ unsigned pk2(float lo, float hi) { return cvt_pk_bf16(lo, hi); }
struct TrDesc { const float* W; bf16_t* WT; int K, N, grp, gstride, off, item; };
__device__ __forceinline__ void tr_load(const TrDesc& t, f32x4 (&v)[16], int lane) {
    const int nblk = (t.N + 63) / 64, kb = t.item / nblk, nb = t.item % nblk, k0 = 64 * kb, n0 = 64 * nb;
    const int kr = lane >> 4, c = lane & 15; const bool valid = n0 + 4 * c < t.N;
#pragma unroll
    for (int i = 0; i < 16; ++i) v[i] = valid ? *(const f32x4*)(t.W + (size_t)(k0 + 4 * i + kr) * t.N + n0 + 4 * c) : (f32x4){0.f, 0.f, 0.f, 0.f};
}
__device__ __forceinline__ void tr_store(const TrDesc& t, const f32x4 (&v)[16], LAS float* scr, int lane) {
    const int nblk = (t.N + 63) / 64, kb = t.item / nblk, nb = t.item % nblk, k0 = 64 * kb, n0 = 64 * nb;
    const int drow0 = (n0 / t.grp) * t.gstride + (n0 % t.grp) + t.off;
    const int kr = lane >> 4, c = lane & 15;
#pragma unroll
    for (int i = 0; i < 16; ++i) { LAS float* p = scr + (4 * i + kr) * 65 + 4 * c; p[0] = v[i].x; p[1] = v[i].y; p[2] = v[i].z; p[3] = v[i].w; }
    asm volatile("s_waitcnt lgkmcnt(0)" ::: "memory");
    const int c8 = lane & 7, nl = lane >> 3;
#pragma unroll
    for (int j = 0; j < 8; ++j) { const int n = nl + 8 * j; const LAS float* s = scr + (8 * c8) * 65 + n;
        u32x4 o; o.x = pk2(s[0 * 65], s[1 * 65]); o.y = pk2(s[2 * 65], s[3 * 65]); o.z = pk2(s[4 * 65], s[5 * 65]); o.w = pk2(s[6 * 65], s[7 * 65]);
        if (n0 + n < t.N) *(u32x4*)(t.WT + (size_t)(drow0 + n) * t.K + k0 + 8 * c8) = o; }
    asm volatile("s_waitcnt lgkmcnt(0)" ::: "memory");
}
constexpr int TR_IN = 32 * 62, TR_UQ = 8 * 12, TR_UKV = 4 * 16, TR_OUT = 32 * 32, TR_G = 32 * 88, TR_D = 88 * 32, TR_L = TR_IN + TR_UQ + TR_UKV + TR_OUT + 2 * TR_G + TR_D;
__device__ __forceinline__ TrDesc tr_decode(CArgs& a, int it) {
    constexpr int BIG = 1 << 30;
    const int l = it / TR_L; int r = it % TR_L;
    unsigned char* wb = a.ws + WS_W + (size_t)l * W_LAYER;
    if (r < TR_IN) return TrDesc{a.in[I_WIN] + (size_t)l * DM * INC, (bf16_t*)(wb + WO_IN), DM, INC, BIG, 0, 0, r}; r -= TR_IN;
    if (r < TR_UQ) return TrDesc{a.in[I_WUQ] + (size_t)l * 512 * 768, (bf16_t*)(wb + WO_UQ), 512, 768, BIG, 0, 0, r}; r -= TR_UQ;
    if (r < TR_UKV) return TrDesc{a.in[I_WUKV] + (size_t)l * 256 * 1024, (bf16_t*)(wb + WO_UKV), 256, 1024, BIG, 0, 0, r}; r -= TR_UKV;
    if (r < TR_OUT) return TrDesc{a.in[I_WOUT] + (size_t)l * DM * DM, (bf16_t*)(wb + WO_OUT), DM, DM, BIG, 0, 0, r}; r -= TR_OUT;
    if (r < TR_G) return TrDesc{a.in[I_WGATE] + (size_t)l * DM * DFF, (bf16_t*)(wb + WO_GU), DM, DFF, 128, 256, 0, r}; r -= TR_G;
    if (r < TR_G) return TrDesc{a.in[I_WUP] + (size_t)l * DM * DFF, (bf16_t*)(wb + WO_GU), DM, DFF, 128, 256, 128, r}; r -= TR_G;
    return TrDesc{a.in[I_WDOWN] + (size_t)l * DFF * DM, (bf16_t*)(wb + WO_DN), DFF, DM, BIG, 0, 0, r};
}
__device__ __forceinline__ void transposes_dynamic(CArgs& a, LAS unsigned char* lds, int layer) {
    int tid = threadIdx.x; asm volatile("" : "+v"(tid));
    const int lane = tid & 63, wid = tid >> 6;
    LAS float* scr = (LAS float*)(lds + wid * 16640);
    unsigned* ctr = (unsigned*)(a.ws + WS_CTL) + CW_QUEUE + 128 + 64 * layer;
    for (;;) {
        unsigned base = 0; if (lane == 0) base = atomicAdd(ctr, 2u);
        const int it = __builtin_amdgcn_readfirstlane(base);
        if (it >= TR_L) break;
        const bool two = it + 1 < TR_L;
        const TrDesc t0 = tr_decode(a, layer * TR_L + it), t1 = tr_decode(a, layer * TR_L + (two ? it + 1 : it));
        f32x4 v0[16], v1[16];
        tr_load(t0, v0, lane); tr_load(t1, v1, lane);
        tr_store(t0, v0, scr, lane);
        if (two) tr_store(t1, v1, scr, lane);
    }
}
__device__ __forceinline__ void phase_prologue(CArgs& a, LAS unsigned char* lds) {
    int tid = threadIdx.x; asm volatile("" : "+v"(tid));
    const int lane = tid & 63, wid = tid >> 6;
    LAS float* scr = (LAS float*)(lds + wid * 16384);
    const int gw = blockIdx.x * 8 + wid, NGW = gridDim.x * 8;
    float* MOD = (float*)(a.ws + WS_MOD);
    for (int it = blockIdx.x; it < 2 * 96; it += gridDim.x) {
        const int l = it / 96, jb = it % 96;
        __syncthreads();
#pragma unroll
        for (int q = 0; q < 4; ++q) { const int k = wid * 256 + q * 64 + lane;
#pragma unroll
            for (int v = 0; v < 5; ++v) { const float cv = (v < 4) ? a.in[I_C][v * DM + k] : a.in[I_CCTX][k]; scr[v * 256 + q * 64 + lane] = silu_f(cv); } }
        asm volatile("s_waitcnt lgkmcnt(0)" ::: "memory");
        const float* W = a.in[I_WMOD] + (size_t)l * DM * 12288 + (size_t)(wid * 256) * 12288 + jb * 128 + lane * 2;
        f32x2 acc[5];
#pragma unroll
        for (int v = 0; v < 5; ++v) acc[v] = (f32x2){0.f, 0.f};
        for (int k0 = 0; k0 < 256; k0 += 64) { f32x2 wv[64];
#pragma unroll
            for (int e = 0; e < 64; ++e) wv[e] = *(const f32x2*)(W + (size_t)(k0 + e) * 12288);
#pragma unroll
            for (int e = 0; e < 64; ++e) { const int kk = k0 + e; const f32x2 w = wv[e];
#pragma unroll
            for (int v = 0; v < 5; ++v) acc[v] += scr[v * 256 + kk] * w; } }
#pragma unroll
        for (int v = 0; v < 5; ++v) *(LAS f32x2*)(scr + 2048 + v * 128 + lane * 2) = acc[v];
        __syncthreads();
        if (wid < 5) { f32x2 sum = *(const f32x2*)(a.in[I_BMOD] + l * 12288 + jb * 128 + lane * 2);
#pragma unroll
            for (int w = 0; w < 8; ++w) sum += *(const LAS f32x2*)((LAS float*)(lds + w * 16384) + 2048 + wid * 128 + lane * 2);
            *(f32x2*)(MOD + (size_t)(l * 5 + wid) * 12288 + jb * 128 + lane * 2) = sum; }
    }
    __syncthreads();
    transposes_dynamic(a, lds, 0); transposes_dynamic(a, lds, 1);
    for (int l = 0; l < 2; ++l) { u32x4* z = (u32x4*)(a.ws + WS_W + (size_t)l * W_LAYER + WO_IN + (size_t)INC * DM * 2);
        for (int i = blockIdx.x * 512 + tid; i < (INP - INC) * DM * 2 / 16; i += gridDim.x * 512) z[i] = (u32x4){0u, 0u, 0u, 0u}; }
}

__device__ __forceinline__ void phase_norm(CArgs& a, int l, int which) {
    int tid = threadIdx.x; asm volatile("" : "+v"(tid));
    const int lane = tid & 63, wid = tid >> 6;
    const int gw = blockIdx.x * 8 + wid, NGW = gridDim.x * 8;
    const float* MOD = (const float*)(a.ws + WS_MOD) + (size_t)l * 5 * 12288;
    const float* MOD0 = (const float*)(a.ws + WS_MOD);
    const float* gn = a.in[which ? I_N2G : I_N1G] + l * DM;
    float* XR = (float*)(a.ws + WS_XR);
    const float* PART = (const float*)a.out + PART_OFF;
    bf16_t* H = (bf16_t*)(a.ws + WS_HZ);
    const bool skip = (l == 1 && which == 1);
    const int npart = (l == 0 && which == 1) ? 8 : ((l == 1 && which == 0) ? 4 : 0);
    for (int r0 = gw; r0 < NR; r0 += 2 * NGW) {
        f32x4 x[2][8]; const float* sh[2]; const float* sc[2]; bool ok[2];
#pragma unroll
        for (int u = 0; u < 2; ++u) { const int r = r0 + u * NGW; ok[u] = r < NR; const int rr = ok[u] ? r : r0;
            const int b = rr / TOK, i = rr - b * TOK, v = (i < CTXL) ? 4 : b;
            if (skip && i < CTXL) ok[u] = false;
            const bool first = (l == 0 && which == 0), ctxsplit = (npart == 8 && i < CTXL);
            const float* src = (first || ctxsplit) ? (i < CTXL ? a.in[I_CTX] + ((size_t)b * CTXL + i) * DM : a.in[I_X] + ((size_t)b * SEQ + (i - CTXL)) * DM) : XR + (size_t)rr * DM;
            sh[u] = MOD + (size_t)v * 12288 + (which * 3 + 0) * DM; sc[u] = MOD + (size_t)v * 12288 + (which * 3 + 1) * DM;
#pragma unroll
            for (int j = 0; j < 8; ++j) x[u][j] = *(const f32x4*)(src + 4 * lane + 256 * j);
            if (npart && i < CTXL) {
                const float* gt = MOD0 + (size_t)4 * 12288 + (npart == 8 ? 2 : 5) * DM;
                f32x4 ps[8];
#pragma unroll
                for (int j = 0; j < 8; ++j) ps[j] = (f32x4){0.f, 0.f, 0.f, 0.f};
                for (int p = 0; p < npart; ++p)
#pragma unroll
                    for (int j = 0; j < 8; ++j) ps[j] += *(const f32x4*)(PART + ((size_t)(p * 32 + b * 8 + j) << 16) + i * 256 + 4 * lane);
#pragma unroll
                for (int j = 0; j < 8; ++j) { x[u][j] += *(const f32x4*)(gt + 4 * lane + 256 * j) * ps[j]; *(f32x4*)(XR + (size_t)rr * DM + 4 * lane + 256 * j) = x[u][j]; }
            } }
#pragma unroll
        for (int u = 0; u < 2; ++u) { float ss = 0.f;
#pragma unroll
            for (int j = 0; j < 8; ++j) ss += (x[u][j].x * x[u][j].x + x[u][j].y * x[u][j].y) + (x[u][j].z * x[u][j].z + x[u][j].w * x[u][j].w);
            const float rs = rsqrtf(wave_sum(ss) * (1.f / DM) + EPS);
            if (!ok[u]) continue;
            bf16_t* o = H + (size_t)(r0 + u * NGW) * DM;
#pragma unroll
            for (int j = 0; j < 8; ++j) { const int c = 4 * lane + 256 * j; const f32x4 g = *(const f32x4*)(gn + c), s1 = *(const f32x4*)(sc[u] + c), s0 = *(const f32x4*)(sh[u] + c);
                const f32x4 y = (x[u][j] * rs) * g * (1.f + s1) + s0;
                u32x2 w; w.x = cvt_pk_bf16(y.x, y.y); w.y = cvt_pk_bf16(y.z, y.w); *(u32x2*)(o + c) = w; } }
    }
}

__device__ __forceinline__ void rope128(float& y0, float& y1, int lane, int prow, int pcol) {
    const float pos = (float)(lane < 32 ? prow : pcol);
    const int i0 = (2 * lane) & 31;
    const float f0 = __builtin_amdgcn_exp2f(-(float)i0 * (13.287712379549449f / 32.f)), f1 = __builtin_amdgcn_exp2f(-(float)(i0 + 1) * (13.287712379549449f / 32.f));
    const float a0 = pos * f0, a1 = pos * f1;
    const float c0 = __cosf(a0), s0 = __sinf(a0), c1 = __cosf(a1), s1 = __sinf(a1);
    const float p0 = __shfl_xor(y0, 16), p1 = __shfl_xor(y1, 16);
    if (((lane >> 4) & 1) == 0) { y0 = y0 * c0 - p0 * s0; y1 = y1 * c1 - p1 * s1; }
    else { y0 = p0 * s0 + y0 * c0; y1 = p1 * s1 + y1 * c1; }
}
__device__ __forceinline__ void rope64(float& y0, float& y1, int lane, int prow, int pcol) {
    const int l = lane & 31;
    const float pos = (float)(l < 16 ? prow : pcol);
    const int i0 = (2 * l) & 15;
    const float f0 = __builtin_amdgcn_exp2f(-(float)i0 * (13.287712379549449f / 16.f)), f1 = __builtin_amdgcn_exp2f(-(float)(i0 + 1) * (13.287712379549449f / 16.f));
    const float a0 = pos * f0, a1 = pos * f1;
    const float c0 = __cosf(a0), s0 = __sinf(a0), c1 = __cosf(a1), s1 = __sinf(a1);
    const float p0 = __shfl_xor(y0, 8), p1 = __shfl_xor(y1, 8);
    if (((l >> 3) & 1) == 0) { y0 = y0 * c0 - p0 * s0; y1 = y1 * c1 - p1 * s1; }
    else { y0 = p0 * s0 + y0 * c0; y1 = p1 * s1 + y1 * c1; }
}

struct E1Regs { u32x4 hq[3]; u32x4 cqw; u32x2 ckw; unsigned krw; };
__device__ __forceinline__ void e1_load(CArgs& a, int r, int lane, E1Regs& g) {
    const bf16_t* P0 = (const bf16_t*)(a.ws + WS_PROJ) + (size_t)r * INP;
#pragma unroll
    for (int t = 0; t < 3; ++t) g.hq[t] = *((const u32x4*)(P0 + t * 512) + lane);
    g.cqw = *((const u32x4*)(P0 + C_BCQ) + lane);
    g.ckw = *((const u32x2*)(P0 + C_BCKV) + lane);
    g.krw = *((const unsigned*)(P0 + C_BKR) + (lane & 31));
}
__device__ __forceinline__ void e1_row(CArgs& a, int l, int r, int lane, int dup, const E1Regs& g) {
    bf16_t* P0 = (bf16_t*)(a.ws + WS_PROJ) + (size_t)r * INP;
    bf16_t* P = dup ? (bf16_t*)((float*)a.out + (10u << 20)) + (size_t)r * 2368 : P0;
    const int i = r % TOK; const bool lat = i >= CTXL; const int n = i - CTXL, prow = n >> 6, pcol = n & 63;
    { const int li = lane & 15, hsub = lane >> 4;
      const float pos = (float)(li < 8 ? prow : pcol); const bool second = ((li >> 2) & 1) != 0;
      float cs[8], sn[8];
      if (lat) {
#pragma unroll
          for (int e = 0; e < 8; ++e) { const float ang = pos * __builtin_amdgcn_exp2f(-(float)(8 * (li & 3) + e) * (13.287712379549449f / 32.f)); cs[e] = __cosf(ang); sn[e] = __sinf(ang); } }
#pragma unroll
      for (int t = 0; t < 3; ++t) { const int hh = 4 * t + hsub; const u32x4 w = g.hq[t];
          float x[8] = {bflo(w.x), bfhi(w.x), bflo(w.y), bfhi(w.y), bflo(w.z), bfhi(w.z), bflo(w.w), bfhi(w.w)};
          float ss = 0.f;
#pragma unroll
          for (int e = 0; e < 8; ++e) ss += x[e] * x[e];
#pragma unroll
          for (int m = 1; m < 16; m <<= 1) ss += __shfl_xor(ss, m);
          const float rs = rsqrtf(ss * (1.f / 128.f) + EPS) * (hh < 8 ? QSCALE_A : 1.f);
          const float* gg = a.in[hh < 8 ? I_AQN : I_AKN] + l * 128 + 8 * li;
          const f32x4 ga = *(const f32x4*)gg, gb = *(const f32x4*)(gg + 4);
          float y[8] = {x[0] * rs * ga.x, x[1] * rs * ga.y, x[2] * rs * ga.z, x[3] * rs * ga.w, x[4] * rs * gb.x, x[5] * rs * gb.y, x[6] * rs * gb.z, x[7] * rs * gb.w};
          if (lat) {
#pragma unroll
              for (int e = 0; e < 8; ++e) { const float p = __shfl_xor(y[e], 4); y[e] = second ? (p * sn[e] + y[e] * cs[e]) : (y[e] * cs[e] - p * sn[e]); } }
          u32x4 o; o.x = cvt_pk_bf16(y[0], y[1]); o.y = cvt_pk_bf16(y[2], y[3]); o.z = cvt_pk_bf16(y[4], y[5]); o.w = cvt_pk_bf16(y[6], y[7]);
          if (hh < 10) *((u32x4*)(P + t * 512) + lane) = o; } }
    { const u32x4 w = g.cqw;
        float x[8] = {bflo(w.x), bfhi(w.x), bflo(w.y), bfhi(w.y), bflo(w.z), bfhi(w.z), bflo(w.w), bfhi(w.w)};
        float ss = 0.f;
#pragma unroll
        for (int e = 0; e < 8; ++e) ss += x[e] * x[e];
        const float rs = rsqrtf(wave_sum(ss) * (1.f / 512.f) + EPS);
        const float* gg = a.in[I_BQLN] + l * 512 + 8 * lane;
        u32x4 o; o.x = cvt_pk_bf16(x[0] * rs * gg[0], x[1] * rs * gg[1]); o.y = cvt_pk_bf16(x[2] * rs * gg[2], x[3] * rs * gg[3]);
        o.z = cvt_pk_bf16(x[4] * rs * gg[4], x[5] * rs * gg[5]); o.w = cvt_pk_bf16(x[6] * rs * gg[6], x[7] * rs * gg[7]); *((u32x4*)(P + C_BCQ) + lane) = o;
    }
    { const u32x2 w = g.ckw;
        float x[4] = {bflo(w.x), bfhi(w.x), bflo(w.y), bfhi(w.y)};
        const float rs = rsqrtf(wave_sum(x[0] * x[0] + x[1] * x[1] + x[2] * x[2] + x[3] * x[3]) * (1.f / 256.f) + EPS);
        const float* gg = a.in[I_BKVLN] + l * 256 + 4 * lane;
        u32x2 o; o.x = cvt_pk_bf16(x[0] * rs * gg[0], x[1] * rs * gg[1]); o.y = cvt_pk_bf16(x[2] * rs * gg[2], x[3] * rs * gg[3]); *((u32x2*)(P + C_BCKV) + lane) = o;
    }
    { const unsigned w = g.krw;
        float x0 = lane < 32 ? bflo(w) : 0.f, x1 = lane < 32 ? bfhi(w) : 0.f;
        const float rs = rsqrtf(wave_sum(x0 * x0 + x1 * x1) * (1.f / 64.f) + EPS);
        const float* gg = a.in[I_BKRN] + l * 64 + 2 * (lane & 31);
        float y0 = x0 * rs * gg[0], y1 = x1 * rs * gg[1];
        if (lat) rope64(y0, y1, lane, prow, pcol);
        if (lane < 32) *((unsigned*)(P + C_BKR) + lane) = cvt_pk_bf16(y0, y1);
    }
}
struct E2Regs { u32x4 qn, qr, kn, kr; };
__device__ __forceinline__ void e2_load(CArgs& a, int r, int lane, E2Regs& g) {
    const bf16_t* Q0 = (const bf16_t*)(a.ws + WS_QB) + (size_t)r * 768;
    const bf16_t* KV = (const bf16_t*)(a.ws + WS_KVB) + (size_t)r * 1024;
    const bf16_t* P = (const bf16_t*)(a.ws + WS_PROJ) + (size_t)r * INP;
    const int h16 = lane >> 4, li = lane & 15, h8 = (lane >> 3) & 3, li8 = lane & 7;
    g.qn = *(const u32x4*)(Q0 + h16 * 192 + 8 * li);
    g.qr = *(const u32x4*)(Q0 + h8 * 192 + 128 + 8 * li8);
    g.kn = *(const u32x4*)(KV + h16 * 256 + 8 * li);
    g.kr = *(const u32x4*)(P + C_BKR + 8 * li8);
}
__device__ __forceinline__ void e2_row(CArgs& a, int l, int r, int lane, int dup, const E2Regs& g) {
    bf16_t* Q = dup ? (bf16_t*)((float*)a.out + (10u << 20)) + (size_t)r * 768 : (bf16_t*)(a.ws + WS_QB) + (size_t)r * 768;
    bf16_t* KB = dup ? (bf16_t*)((float*)a.out + (18u << 20)) + (size_t)r * 768 : (bf16_t*)(a.ws + WS_KB) + (size_t)r * 768;
    const int i = r % TOK; const bool lat = i >= CTXL; const int n = i - CTXL, prow = n >> 6, pcol = n & 63;
    const int h16 = lane >> 4, li = lane & 15, h8 = (lane >> 3) & 3, li8 = lane & 7;
#define E2_UNPK(wv_, arr_) float arr_[8] = {bflo(wv_[0]), bfhi(wv_[0]), bflo(wv_[1]), bfhi(wv_[1]), bflo(wv_[2]), bfhi(wv_[2]), bflo(wv_[3]), bfhi(wv_[3])}
    { E2_UNPK(g.qn, x); float ss = 0.f;
#pragma unroll
      for (int e = 0; e < 8; ++e) ss += x[e] * x[e];
#pragma unroll
      for (int m = 1; m < 16; m <<= 1) ss += __shfl_xor(ss, m);
      const float rs = rsqrtf(ss * (1.f / 128.f) + EPS) * QSCALE_B;
      const float* gg = a.in[I_BQNN] + l * 128 + 8 * li; const f32x4 ga = *(const f32x4*)gg, gb = *(const f32x4*)(gg + 4);
      u32x4 o; o.x = cvt_pk_bf16(x[0] * rs * ga.x, x[1] * rs * ga.y); o.y = cvt_pk_bf16(x[2] * rs * ga.z, x[3] * rs * ga.w);
      o.z = cvt_pk_bf16(x[4] * rs * gb.x, x[5] * rs * gb.y); o.w = cvt_pk_bf16(x[6] * rs * gb.z, x[7] * rs * gb.w);
      *(u32x4*)(Q + h16 * 192 + 8 * li) = o; }
    { E2_UNPK(g.qr, x); float ss = 0.f;
#pragma unroll
      for (int e = 0; e < 8; ++e) ss += x[e] * x[e];
#pragma unroll
      for (int m = 1; m < 8; m <<= 1) ss += __shfl_xor(ss, m);
      const float rs = rsqrtf(ss * (1.f / 64.f) + EPS) * QSCALE_B;
      const float* gg = a.in[I_BQRN] + l * 64 + 8 * li8; const f32x4 ga = *(const f32x4*)gg, gb = *(const f32x4*)(gg + 4);
      float y[8] = {x[0] * rs * ga.x, x[1] * rs * ga.y, x[2] * rs * ga.z, x[3] * rs * ga.w, x[4] * rs * gb.x, x[5] * rs * gb.y, x[6] * rs * gb.z, x[7] * rs * gb.w};
      if (lat) { const float pos = (float)(li8 < 4 ? prow : pcol); const bool second = ((li8 >> 1) & 1) != 0;
#pragma unroll
          for (int e = 0; e < 8; ++e) { const float ang = pos * __builtin_amdgcn_exp2f(-(float)(8 * (li8 & 1) + e) * (13.287712379549449f / 16.f));
              const float c = __cosf(ang), sn = __sinf(ang), p = __shfl_xor(y[e], 2); y[e] = second ? (p * sn + y[e] * c) : (y[e] * c - p * sn); } }
      u32x4 o; o.x = cvt_pk_bf16(y[0], y[1]); o.y = cvt_pk_bf16(y[2], y[3]); o.z = cvt_pk_bf16(y[4], y[5]); o.w = cvt_pk_bf16(y[6], y[7]);
      if (lane < 32) { *(u32x4*)(Q + h8 * 192 + 128 + 8 * li8) = o; *(u32x4*)(KB + h8 * 192 + 128 + 8 * li8) = g.kr; } }
    { E2_UNPK(g.kn, x); float ss = 0.f;
#pragma unroll
      for (int e = 0; e < 8; ++e) ss += x[e] * x[e];
#pragma unroll
      for (int m = 1; m < 16; m <<= 1) ss += __shfl_xor(ss, m);
      const float rs = rsqrtf(ss * (1.f / 128.f) + EPS);
      const float* gg = a.in[I_BKNN] + l * 128 + 8 * li; const f32x4 ga = *(const f32x4*)gg, gb = *(const f32x4*)(gg + 4);
      u32x4 o; o.x = cvt_pk_bf16(x[0] * rs * ga.x, x[1] * rs * ga.y); o.y = cvt_pk_bf16(x[2] * rs * ga.z, x[3] * rs * ga.w);
      o.z = cvt_pk_bf16(x[4] * rs * gb.x, x[5] * rs * gb.y); o.w = cvt_pk_bf16(x[6] * rs * gb.z, x[7] * rs * gb.w);
      *(u32x4*)(KB + h16 * 192 + 8 * li) = o; }
#undef E2_UNPK
}

constexpr int GS = 65, GA = 64 * GS;
constexpr int GL_QF = 0, GL_QB = GA, GL_CGF = 33664, GL_CGB = 34688, GL_WF = 35712, GL_WB = 36736, GL_BF = 37760, GL_BB = 37824, GL_END = 37888;
constexpr int GB_QDF = 33280, GB_QDB = 42496, GB_KDF = 51712, GB_KDB = 60928, GB_VT = 70144, GB_ATT = 88576, GB_SFT = 97792, GB_SBT = 116224;
constexpr int HS = 72;
static_assert(GL_END * 4 <= LDS_QWORD && GB_SBT + 128 * HS * 2 <= GL_CGF * 4, "GLA LDS");
__device__ __forceinline__ bf16x8 ldfrag(const LAS unsigned char* base, int row, int ks, int hi) { return *(const LAS bf16x8*)(base + row * (HS * 2) + ks * 32 + hi * 16); }
__device__ __forceinline__ int crow16(int r, int hi) { return (r & 3) + 8 * (r >> 2) + 4 * hi; }
__device__ __forceinline__ float logsig(float x) { return fminf(x, 0.f) - __logf(1.f + __expf(-fabsf(x))); }
__device__ __forceinline__ float wave_incl_scan(float x, int lane) {
#pragma unroll
    for (int o = 1; o < 64; o <<= 1) { const float t = __shfl_up(x, o); if (lane >= o) x += t; }
    return x;
}
__device__ __forceinline__ void gla_store_vt(const u32x4 v0, const u32x4 v1, LAS unsigned char* B, int wid, int lane) {
    const int e0 = (lane & 15) * 8;
#pragma unroll
    for (int i = 0; i < 2; ++i) { const u32x4 v = i ? v1 : v0; const int j = 8 * wid + 4 * i + (lane >> 4);
#pragma unroll
        for (int q = 0; q < 4; ++q) { *(LAS unsigned short*)(B + GB_VT + ((e0 + 2 * q) * HS + j) * 2) = (unsigned short)(v[q] & 0xffffu);
            *(LAS unsigned short*)(B + GB_VT + ((e0 + 2 * q + 1) * HS + j) * 2) = (unsigned short)(v[q] >> 16); } }
}
__device__ __forceinline__ void gla_p1(CArgs& a, int l, int cc, int h, LAS float* L, int dup, bool stagew) {
    int tid = threadIdx.x; asm volatile("" : "+v"(tid));
    LAS unsigned char* B = (LAS unsigned char*)L;
    const int wid = __builtin_amdgcn_readfirstlane(tid >> 6), lane = tid & 63;
    const bf16_t* Pj = (const bf16_t*)(a.ws + WS_PROJ) + (size_t)(cc * 64 + lane) * INP;
    float* KVS = (float*)(a.ws + WS_KVS); float* DEC = (float*)(a.ws + WS_DEC);
    bf16_t* GQ = (bf16_t*)a.out + (size_t)(cc * 4 + h) * 16384;
    const int slot = (cc * 4 + h) * 2;
    const bf16_t* Pw = (const bf16_t*)(a.ws + WS_PROJ) + (size_t)(cc * 64 + 8 * wid) * INP;
    const int lr8 = lane >> 3, lc8 = lane & 7;
    const u32x4 cgx = *(const u32x4*)(Pw + (size_t)((lane >> 2) & 7) * INP + C_CGF + (lane & 3) * 8);
    const u32x4 kx = *(const u32x4*)(Pw + (size_t)lr8 * INP + C_CK + h * 64 + lc8 * 8), qx = *(const u32x4*)(Pw + (size_t)lr8 * INP + C_CQ + h * 64 + lc8 * 8);
    const u32x4 v0 = *(const u32x4*)(Pw + (size_t)(lane >> 4) * INP + C_CV + h * 128 + (lane & 15) * 8), v1 = *(const u32x4*)(Pw + (size_t)(4 + (lane >> 4)) * INP + C_CV + h * 128 + (lane & 15) * 8);
    __syncthreads();
    { LAS unsigned char* S = B + GB_SFT;
      if (lane < 32) *(LAS u32x4*)(S + (8 * wid + (lane >> 2)) * 64 + (lane & 3) * 16) = cgx;
      *(LAS u32x4*)(S + 4096 + (8 * wid + lr8) * 128 + lc8 * 16) = kx; *(LAS u32x4*)(S + 12288 + (8 * wid + lr8) * 128 + lc8 * 16) = qx; }
    if (stagew) {
    for (int i = tid; i < 2048; i += 512) { const int dir = i >> 10, r = (i >> 6) & 15, d = i & 63; L[(dir ? GL_WB : GL_WF) + d * 16 + r] = a.in[dir ? I_WGKB : I_WGKF][(size_t)l * 16 * 256 + r * 256 + h * 64 + d]; }
    if (tid < 128) { const int dir = tid >> 6, d = tid & 63; L[(dir ? GL_BB : GL_BF) + d] = a.in[dir ? I_BGKB : I_BGKF][l * 256 + h * 64 + d]; } }
    gla_store_vt(v0, v1, B, wid, lane);
    __syncthreads();
    if (PROBE_CUT == 1 && dup) return;
    float cgf[16], cgb[16];
    const LAS unsigned char* S = B + GB_SFT;
    const u32x4 g0 = *(const LAS u32x4*)(S + lane * 64), g1 = *(const LAS u32x4*)(S + lane * 64 + 16), g2 = *(const LAS u32x4*)(S + lane * 64 + 32), g3 = *(const LAS u32x4*)(S + lane * 64 + 48);
    const u32x4 k8 = *(const LAS u32x4*)(S + 4096 + lane * 128 + wid * 16), q8 = *(const LAS u32x4*)(S + 12288 + lane * 128 + wid * 16);
    { const unsigned wf[8] = {g0.x, g0.y, g0.z, g0.w, g1.x, g1.y, g1.z, g1.w}, wb[8] = {g2.x, g2.y, g2.z, g2.w, g3.x, g3.y, g3.z, g3.w};
#pragma unroll
      for (int q = 0; q < 8; ++q) { cgf[2 * q] = bflo(wf[q]); cgf[2 * q + 1] = bfhi(wf[q]); cgb[2 * q] = bflo(wb[q]); cgb[2 * q + 1] = bfhi(wb[q]); } }
    const unsigned kw[4] = {k8.x, k8.y, k8.z, k8.w}, qw[4] = {q8.x, q8.y, q8.z, q8.w};
    float oqf[8], oqb[8], okf[8], okb[8];
#pragma unroll
    for (int dd = 0; dd < 8; ++dd) { const int d = 8 * wid + dd;
        float pf = L[GL_BF + d], pb = L[GL_BB + d];
#pragma unroll
        for (int q = 0; q < 4; ++q) { const f32x4 wf4 = *(const LAS f32x4*)(L + GL_WF + d * 16 + 4 * q), wb4 = *(const LAS f32x4*)(L + GL_WB + d * 16 + 4 * q);
#pragma unroll
            for (int e = 0; e < 4; ++e) { pf += cgf[4 * q + e] * wf4[e]; pb += cgb[4 * q + e] * wb4[e]; } }
        const float gf = logsig(pf) * (1.f / 16.f), gb = logsig(pb) * (1.f / 16.f);
        const float cf = wave_incl_scan(gf, lane), pbi = wave_incl_scan(gb, lane);
        const float totf = __shfl(cf, 63), totb = __shfl(pbi, 63);
        const float cb = totb - pbi + gb;
        const float k = (dd & 1) ? bfhi(kw[dd >> 1]) : bflo(kw[dd >> 1]), q = ((dd & 1) ? bfhi(qw[dd >> 1]) : bflo(qw[dd >> 1])) * 0.125f;
        oqf[dd] = q * __expf(cf); oqb[dd] = q * __expf(cb); okf[dd] = k * __expf(-cf); okb[dd] = k * __expf(-cb);
        *(LAS unsigned short*)(B + GB_QDF + (d * HS + lane) * 2) = f2bf(k * __expf(totf - cf));
        *(LAS unsigned short*)(B + GB_QDB + (d * HS + lane) * 2) = f2bf(k * __expf(totb - cb));
        if (lane == 0) { DEC[(size_t)slot * 64 + d] = __expf(totf); DEC[(size_t)(slot + 1) * 64 + d] = __expf(totb); } }
    { u32x4 w;
      w.x = cvt_pk_bf16(oqf[0], oqf[1]); w.y = cvt_pk_bf16(oqf[2], oqf[3]); w.z = cvt_pk_bf16(oqf[4], oqf[5]); w.w = cvt_pk_bf16(oqf[6], oqf[7]); *(u32x4*)(GQ + 0 * 4096 + lane * 64 + 8 * wid) = w;
      w.x = cvt_pk_bf16(oqb[0], oqb[1]); w.y = cvt_pk_bf16(oqb[2], oqb[3]); w.z = cvt_pk_bf16(oqb[4], oqb[5]); w.w = cvt_pk_bf16(oqb[6], oqb[7]); *(u32x4*)(GQ + 1 * 4096 + lane * 64 + 8 * wid) = w;
      w.x = cvt_pk_bf16(okf[0], okf[1]); w.y = cvt_pk_bf16(okf[2], okf[3]); w.z = cvt_pk_bf16(okf[4], okf[5]); w.w = cvt_pk_bf16(okf[6], okf[7]); *(u32x4*)(GQ + 2 * 4096 + lane * 64 + 8 * wid) = w;
      w.x = cvt_pk_bf16(okb[0], okb[1]); w.y = cvt_pk_bf16(okb[2], okb[3]); w.z = cvt_pk_bf16(okb[4], okb[5]); w.w = cvt_pk_bf16(okb[6], okb[7]); *(u32x4*)(GQ + 3 * 4096 + lane * 64 + 8 * wid) = w; }
    if (PROBE_CUT == 2 && dup) return;
    __syncthreads();
    { const int r32 = lane & 31, hi = lane >> 5, dir = wid >> 2, eb = wid & 3;
      const LAS unsigned char* X = B + GB_VT; const LAS unsigned char* Y = B + (dir ? GB_QDB : GB_QDF);
      f32x16 c0 = {}, c1 = {};
#pragma unroll
      for (int ks = 0; ks < 4; ++ks) { const bf16x8 av = ldfrag(X, 32 * eb + r32, ks, hi), b0 = ldfrag(Y, r32, ks, hi), b1 = ldfrag(Y, 32 + r32, ks, hi);
          c0 = __builtin_amdgcn_mfma_f32_32x32x16_bf16(av, b0, c0, 0, 0, 0); c1 = __builtin_amdgcn_mfma_f32_32x32x16_bf16(av, b1, c1, 0, 0, 0); }
      float* out = KVS + (size_t)(slot + dir) * 8192;
#pragma unroll
      for (int r = 0; r < 16; ++r) { const int e = 32 * eb + crow16(r, hi); out[e * 64 + r32] = c0[r]; out[e * 64 + 32 + r32] = c1[r]; } }
}
__device__ __forceinline__ void gla_scan(CArgs& a, int dup) {
    float* KVS = (float*)(a.ws + WS_KVS); float* KVO = dup ? (float*)a.out + (10u << 20) : KVS; const float* DEC = (const float*)(a.ws + WS_DEC);
    int tid = threadIdx.x; asm volatile("" : "+v"(tid));
    for (int g = blockIdx.x * 512 + tid; g < 32 * 2048; g += gridDim.x * 512) {
        const int seq = g >> 11, el = (g & 2047) * 4, d = el & 63, b = seq >> 3, h = (seq >> 1) & 3, dir = seq & 1;
        f32x4 carry = {0.f, 0.f, 0.f, 0.f};
        for (int s0 = 0; s0 < 68; s0 += 17) {
            f32x4 kv[17], dc[17]; size_t ad[17];
#pragma unroll
            for (int q = 0; q < 17; ++q) { const int s = s0 + q; const int c = dir == 0 ? s : (s < 4 ? 3 - s : 71 - s); const size_t slot = (size_t)((b * 68 + c) * 4 + h) * 2 + dir;
                ad[q] = slot * 8192 + el; kv[q] = *(const f32x4*)(KVS + ad[q]); dc[q] = *(const f32x4*)(DEC + slot * 64 + d); }
#pragma unroll
            for (int q = 0; q < 17; ++q) { *(f32x4*)(KVO + ad[q]) = carry; carry = dc[q] * carry + kv[q]; }
        }
    }
}
__device__ __forceinline__ void gla_p3(CArgs& a, int l, int cc, int h, LAS float* L) {
    int tid = threadIdx.x; asm volatile("" : "+v"(tid));
    LAS unsigned char* B = (LAS unsigned char*)L;
    const int wid = tid >> 6, lane = tid & 63, r32 = lane & 31, hi = lane >> 5;
    const bf16_t* P = (const bf16_t*)(a.ws + WS_PROJ) + (size_t)(cc * 64) * INP;
    const float* KVS = (const float*)(a.ws + WS_KVS);
    const bf16_t* GQ = (const bf16_t*)a.out + (size_t)(cc * 4 + h) * 16384;
    const int slot = (cc * 4 + h) * 2;
    u32x4 qk[4];
#pragma unroll
    for (int q = 0; q < 4; ++q) qk[q] = *(const u32x4*)(GQ + (size_t)(tid + 512 * q) * 8);
    const bf16_t* Pw = P + (size_t)(8 * wid) * INP;
    const u32x4 v0 = *(const u32x4*)(Pw + (size_t)(lane >> 4) * INP + C_CV + h * 128 + (lane & 15) * 8), v1 = *(const u32x4*)(Pw + (size_t)(4 + (lane >> 4)) * INP + C_CV + h * 128 + (lane & 15) * 8);
    f32x4 sv[8];
#pragma unroll
    for (int q = 0; q < 8; ++q) sv[q] = *(const f32x4*)(KVS + (size_t)slot * 8192 + (size_t)(tid + 512 * q) * 4);
    __syncthreads();
#pragma unroll
    for (int q = 0; q < 4; ++q) { const int idx = tid + 512 * q, arr = idx >> 9, rem = idx & 511, j = rem >> 3, c = rem & 7; *(LAS u32x4*)(B + GB_QDF + arr * 9216 + (j * HS + c * 8) * 2) = qk[q]; }
    gla_store_vt(v0, v1, B, wid, lane);
#pragma unroll
    for (int q = 0; q < 8; ++q) { const int idx = tid + 512 * q, dir = idx >> 11, i = idx & 2047, e = i >> 4, d4 = (i & 15) * 4;
        u32x2 w; w.x = cvt_pk_bf16(sv[q].x, sv[q].y); w.y = cvt_pk_bf16(sv[q].z, sv[q].w); *(LAS u32x2*)(B + (dir ? GB_SBT : GB_SFT) + (e * HS + d4) * 2) = w; }
    __syncthreads();
    if (wid < 4) { const int ib = wid >> 1, jb = wid & 1; f32x16 cf = {}, cb = {};
#pragma unroll
        for (int ks = 0; ks < 4; ++ks) {
            cf = __builtin_amdgcn_mfma_f32_32x32x16_bf16(ldfrag(B + GB_QDF, 32 * ib + r32, ks, hi), ldfrag(B + GB_KDF, 32 * jb + r32, ks, hi), cf, 0, 0, 0);
            cb = __builtin_amdgcn_mfma_f32_32x32x16_bf16(ldfrag(B + GB_QDB, 32 * ib + r32, ks, hi), ldfrag(B + GB_KDB, 32 * jb + r32, ks, hi), cb, 0, 0, 0); }
#pragma unroll
        for (int r = 0; r < 16; ++r) { const int i = 32 * ib + crow16(r, hi), j = 32 * jb + r32;
            const float v = (j <= i ? cf[r] : 0.f) + (j >= i ? cb[r] : 0.f);
            *(LAS unsigned short*)(B + GB_ATT + (i * HS + j) * 2) = f2bf(v); } }
    __syncthreads();
    { const int ib = wid >> 2, eb = wid & 3; f32x16 acc = {};
#pragma unroll
      for (int ks = 0; ks < 4; ++ks) {
          acc = __builtin_amdgcn_mfma_f32_32x32x16_bf16(ldfrag(B + GB_ATT, 32 * ib + r32, ks, hi), ldfrag(B + GB_VT, 32 * eb + r32, ks, hi), acc, 0, 0, 0);
          acc = __builtin_amdgcn_mfma_f32_32x32x16_bf16(ldfrag(B + GB_QDF, 32 * ib + r32, ks, hi), ldfrag(B + GB_SFT, 32 * eb + r32, ks, hi), acc, 0, 0, 0);
          acc = __builtin_amdgcn_mfma_f32_32x32x16_bf16(ldfrag(B + GB_QDB, 32 * ib + r32, ks, hi), ldfrag(B + GB_SBT, 32 * eb + r32, ks, hi), acc, 0, 0, 0); }
#pragma unroll
      for (int r = 0; r < 16; ++r) L[(32 * ib + crow16(r, hi)) * 128 + 32 * eb + r32] = acc[r]; }
    __syncthreads();
    const int i0 = (tid >> 5) * 4, e4 = (tid & 31) * 4;
    bf16_t* Z = (bf16_t*)(a.ws + WS_HZ);
    const f32x4 gn = *(const f32x4*)(a.in[I_CON] + l * 128 + e4);
#pragma unroll
    for (int r = 0; r < 4; ++r) { const f32x4 o = *(const LAS f32x4*)(L + (i0 + r) * 128 + e4);
        float ss = (o.x * o.x + o.y * o.y) + (o.z * o.z + o.w * o.w);
#pragma unroll
        for (int m = 1; m < 32; m <<= 1) ss += __shfl_xor(ss, m);
        const float rs = rsqrtf(ss * (1.f / 128.f) + EPS);
        const size_t row = (size_t)cc * 64 + i0 + r;
        const u32x2 gw = *(const u32x2*)(P + (size_t)(i0 + r) * INP + C_CG + h * 128 + e4);
        const f32x4 y = o * rs * gn;
        u32x2 w; w.x = cvt_pk_bf16(y.x * silu_f(bflo(gw.x)), y.y * silu_f(bfhi(gw.x))); w.y = cvt_pk_bf16(y.z * silu_f(bflo(gw.y)), y.w * silu_f(bfhi(gw.y)));
        *(u32x2*)(Z + row * DM + 1536 + h * 128 + e4) = w; }
}

__device__ __forceinline__ void phase_mixer(CArgs& a, int l, unsigned char* lds_g, LAS unsigned char* lds, int dup) {
    int tid = threadIdx.x; asm volatile("" : "+v"(tid));
    unsigned* ctr = (unsigned*)(a.ws + WS_CTL) + CW_QUEUE + 64 * l + 32 * dup;
    volatile LAS unsigned* qw = (volatile LAS unsigned*)(lds + LDS_QWORD);
    const bf16_t* PROJ = (const bf16_t*)(a.ws + WS_PROJ); const bf16_t* QB = (const bf16_t*)(a.ws + WS_QB); const bf16_t* KB = (const bf16_t*)(a.ws + WS_KB);
    const bf16_t* KVB = (const bf16_t*)(a.ws + WS_KVB); bf16_t* Z = (bf16_t*)(a.ws + WS_HZ);
    const int nG = (l == 0) ? NCHUNK * 4 : 256 * 4, nC = (l == 0) ? 48 : 0, total = 768 + nG + nC;
    for (;;) {
        __syncthreads();
        if (tid == 0) *qw = atomicAdd(ctr, 1u);
        __syncthreads();
        const int idx = (int)*qw;
        if (idx >= total) break;
        int kind, b, h, seq; size_t q0;
        if (idx < 256) { kind = 0; b = idx >> 6; h = (idx >> 4) & 3; q0 = (size_t)b * TOK + CTXL + (idx & 15) * 256; seq = TOK; }
        else if (idx < 768) { const int i = idx - 256; kind = 1; b = i >> 7; h = (i >> 4) & 7; q0 = (size_t)b * TOK + CTXL + (i & 15) * 256; seq = TOK; }
        else if (idx < 768 + nG) { kind = 2; b = 0; h = 0; q0 = 0; seq = 0; }
        else { const int i = idx - 768 - nG; seq = CTXL;
            if (i < 32) { kind = 1; b = i >> 3; h = i & 7; } else { kind = 0; b = (i - 32) >> 2; h = (i - 32) & 3; }
            q0 = (size_t)b * TOK; }
        const size_t r0 = (size_t)b * TOK;
        if (PROBE_KIND >= 0 && dup && kind != PROBE_KIND) continue;
        bf16_t* Zo = (PROBE_ATT && dup) ? (bf16_t*)((float*)a.out + (10u << 20)) : Z;
#ifndef NO_ATTB
        if (kind == 0)
            att::attn_body_s<192, 768, 768, 1024, DM>(QB + q0 * 768 + h * 192, KB + r0 * 768 + h * 192, KVB + r0 * 1024 + h * 256 + 128, Zo + q0 * DM + 1024 + h * 128, seq, (char*)lds_g, dup);
#endif
#ifndef NO_ATTA
        if (kind == 1)
            att::attn_body_s<128, INP, INP, INP, DM>(PROJ + q0 * INP + C_AQ + h * 128, PROJ + r0 * INP + C_AK + (h >> 2) * 128, PROJ + r0 * INP + C_AV + (h >> 2) * 128, Zo + q0 * DM + h * 128, seq, (char*)lds_g, dup);
#endif
#ifndef NO_GLA3
        if (kind == 2) {
            const int i = idx - 768; int cc; const int hh = i & 3;
            if (l == 0) cc = i >> 2; else { const int lc = i >> 2; cc = (lc >> 6) * 68 + (lc & 63) + 4; }
            gla_p3(a, l, cc, hh, (LAS float*)lds);
        }
#endif
    }
}

__device__ __forceinline__ void run_phase(CArgs& a, int ph, unsigned char* lds_g, LAS unsigned char* lds, int dup) {
    int tid = threadIdx.x; asm volatile("" : "+v"(tid));
    const int lane = tid & 63, wid = tid >> 6;
    const int G = gridDim.x, gw = blockIdx.x * 8 + wid, NGW = G * 8;
    if (ph == 0) { phase_prologue(a, lds); return; }
    const int l = (ph - 1) / 10, k = (ph - 1) % 10;
    unsigned char* wb = a.ws + WS_W + (size_t)l * W_LAYER;
    const float* MOD = (const float*)(a.ws + WS_MOD) + (size_t)l * 5 * 12288;
    if (k == 0 || k == 7) { phase_norm(a, l, k == 7); return; }
    if (k == 1 || k == 3) {
        const int ng = (k == 1) ? 1 : 2;
        for (int gi = 0; gi < ng; ++gi) {
            if (PROBE_DUP == 20 && dup) break;
            pg8::Gemm g; pg8::EpiStore E; E.skipctx = 0;
            if (k == 1) { g = pg8::Gemm{(const bf16_t*)(a.ws + WS_HZ), (const bf16_t*)(wb + WO_IN), NR, INP, DM, DM, 0, DM}; E.O = (bf16_t*)(a.ws + WS_PROJ); E.ldc = INP; }
            else if (gi == 0) { g = pg8::Gemm{(const bf16_t*)(a.ws + WS_PROJ) + C_BCQ, (const bf16_t*)(wb + WO_UQ), NR, 768, 512, INP, 0, 512}; E.O = (bf16_t*)(a.ws + WS_QB); E.ldc = 768; }
            else { g = pg8::Gemm{(const bf16_t*)(a.ws + WS_PROJ) + C_BCKV, (const bf16_t*)(wb + WO_UKV), NR, 1024, 256, INP, 0, 256}; E.O = (bf16_t*)(a.ws + WS_KVB); E.ldc = 1024; }
            pg8::StaticOrder S; S.init(g.M, g.N, G, (int)blockIdx.x);
            pg8::gemm_phase<pg8::EpiStore>(lds, g, S, E);
        }
        if (k == 3) gla_scan(a, dup);
        return;
    }
    if (k == 2) {
        if (!dup || PROBE_DUP == 20) for (int r = gw; r < NR; r += 2 * NGW) { const int r1 = r + NGW; const bool two = r1 < NR;
            E1Regs g0, g1; e1_load(a, r, lane, g0); e1_load(a, two ? r1 : r, lane, g1); asm volatile("" ::: "memory");
            e1_row(a, l, r, lane, dup, g0); if (two) e1_row(a, l, r1, lane, dup, g1); }
        if (!(dup && PROBE_DUP == 20)) { int hst = -1; for (int u = blockIdx.x; u < NCHUNK * 4; u += G) { const int h = u & 3; gla_p1(a, l, u >> 2, h, (LAS float*)lds, dup, h != hst); hst = h; } }
        return;
    }
    if (k == 4) { for (int r = gw; r < NR; r += 2 * NGW) { const int r1 = r + NGW; const bool two = r1 < NR;
            E2Regs g0, g1; e2_load(a, r, lane, g0); e2_load(a, two ? r1 : r, lane, g1); asm volatile("" ::: "memory");
            e2_row(a, l, r, lane, dup, g0); if (two) e2_row(a, l, r1, lane, dup, g1); }
        return; }
    if (k == 5) { phase_mixer(a, l, lds_g, lds, dup); return; }
    if (k == 6 || k == 9) {
        pg8::Gemm g; pg8::EpiResid E;
        if (k == 6) g = pg8::Gemm{(const bf16_t*)(a.ws + WS_HZ), (const bf16_t*)(wb + WO_OUT), NBATCH * SEQ, DM, DM, DM, 1, DM};
        else g = pg8::Gemm{(const bf16_t*)(a.ws + WS_ACT), (const bf16_t*)(wb + WO_DN), NBATCH * SEQ, DM, DFF, DFF, 1, DFF};
        E.xin = a.in[I_X]; E.ctxin = a.in[I_CTX]; E.xr_in = (const float*)(a.ws + WS_XR); E.xr_out = (float*)(a.ws + WS_XR); E.fin_out = a.out;
        E.gate = MOD + (k == 6 ? 2 : 5) * DM; E.in_split = (l == 0 && k == 6); E.out_final = (l == 1 && k == 9); E.skipctx = 1;
        pg8::StaticOrder S; S.init(g.M, g.N, G, (int)blockIdx.x);
        pg8::gemm_phase<pg8::EpiResid>(lds, g, S, E);
        if (l == 0) {
            const int ks = (k == 6) ? 8 : 4;
            pg8::Gemm g2 = g; g2.M = NBATCH * CTXL; g2.skipctx = 2; g2.kpart = g.K / ks;
            pg8::EpiPartial E2{(float*)a.out + PART_OFF};
            pg8::StaticOrder S2; S2.init(g2.M, g2.N, G, (int)blockIdx.x, ks);
            pg8::gemm_phase<pg8::EpiPartial>(lds, g2, S2, E2);
        }
        return;
    }
    if (k == 8) {
        const int skip = (l == 1);
        pg8::Gemm g{(const bf16_t*)(a.ws + WS_HZ), (const bf16_t*)(wb + WO_GU), skip ? NBATCH * SEQ : NR, 2 * DFF, DM, DM, skip, DM};
        pg8::EpiSwiGLU E{(bf16_t*)(a.ws + WS_ACT), skip};
        pg8::StaticOrder S; S.init(g.M, g.N, G, (int)blockIdx.x);
        pg8::gemm_phase<pg8::EpiSwiGLU>(lds, g, S, E);
        return;
    }
}

#define XB_TMO      128
#define XB_XCNT(j)  (256  + 64 * (j))
#define XB_XSUB(j)  (1280 + 64 * (j))
#define XB_XGEN(j)  (2304 + 64 * (j))
#define XB_TOP      3328
#define XB_TOPGEN   3392
#define XCD_BAR_WORDS 3456
#define XB_SPIN_CAP (1u << 22)
constexpr int CW_BAR = 4096;
__device__ __forceinline__ unsigned xb_ld(unsigned* p)              { return __hip_atomic_load(p, __ATOMIC_RELAXED, __HIP_MEMORY_SCOPE_AGENT); }
__device__ __forceinline__ unsigned xb_add(unsigned* p, unsigned v) { return __hip_atomic_fetch_add(p, v, __ATOMIC_RELAXED, __HIP_MEMORY_SCOPE_AGENT); }
__device__ __forceinline__ unsigned xb_xcc_id() { return (unsigned)__builtin_amdgcn_s_getreg((3 << 11) | 20) & 0xFu; }
#define XB_SPIN(cond, bar) do { unsigned _sp = 0; while (cond) { __builtin_amdgcn_s_sleep(1); \
    if ((++_sp & 255u) == 0u) { if (xb_ld(&(bar)[XB_TMO])) break; if (_sp > XB_SPIN_CAP) { atomicAdd(&(bar)[XB_TMO], 1u); break; } } } } while (0)
struct XcdBarrier { unsigned* bar; unsigned x; volatile LAS unsigned* st; };
__device__ __forceinline__ XcdBarrier xcd_barrier_post(unsigned* bar, volatile LAS unsigned* st) {
    XcdBarrier b; b.bar = bar; b.x = xb_xcc_id(); b.st = st;
    if (threadIdx.x == 0) (void)xb_add(&bar[XB_XCNT(b.x)], 1u);
    return b;
}
__device__ __forceinline__ void xcd_barrier_complete(unsigned* bar, unsigned x, unsigned& nloc, unsigned& nx) {
    const unsigned G = gridDim.x * gridDim.y * gridDim.z;
    unsigned sum, cnt, mine, sp = 0u;
    for (;;) {
        sum = 0u; cnt = 0u; mine = 0u;
#pragma unroll
        for (unsigned j = 0; j < 16; ++j) { const unsigned c = xb_ld(&bar[XB_XCNT(j)]); sum += c; cnt += (c > 0u) ? 1u : 0u; mine = (j == x) ? c : mine; }
        if (sum == G) break;
        __builtin_amdgcn_s_sleep(1);
        if ((++sp & 255u) == 0u) { if (xb_ld(&bar[XB_TMO])) break; if (sp > XB_SPIN_CAP) { atomicAdd(&bar[XB_TMO], 1u); break; } }
    }
    nloc = mine > 0u ? mine : 1u; nx = cnt > 0u ? cnt : 1u;
}
__device__ __forceinline__ void xcd_barrier(const XcdBarrier& b) {
    asm volatile("s_waitcnt vmcnt(0)" ::: "memory");
    __syncthreads();
    if (threadIdx.x == 0) {
        unsigned* bar = b.bar;
        __builtin_amdgcn_s_waitcnt(0);
        unsigned nloc = b.st[0], nx = b.st[1];
        if (nloc == 0u) { xcd_barrier_complete(bar, b.x, nloc, nx); b.st[0] = nloc; b.st[1] = nx; }
        const unsigned old = xb_add(&bar[XB_XSUB(b.x)], 1u);
        const unsigned gen = old / nloc;
        if (old + 1u == (gen + 1u) * nloc) {
            __builtin_amdgcn_fence(__ATOMIC_RELEASE, "agent");
            asm volatile("s_waitcnt vmcnt(0)" ::: "memory");
            const unsigned og = xb_add(&bar[XB_TOP], 1u);
            const unsigned tg = og / nx;
            if (og + 1u == (tg + 1u) * nx) xb_add(&bar[XB_TOPGEN], 1u);
            else XB_SPIN(xb_ld(&bar[XB_TOPGEN]) == tg, bar);
            __builtin_amdgcn_fence(__ATOMIC_ACQUIRE, "agent");
            xb_add(&bar[XB_XGEN(b.x)], 1u);
            asm volatile("s_waitcnt vmcnt(0)" ::: "memory");
        } else {
            XB_SPIN(xb_ld(&bar[XB_XGEN(b.x)]) == gen, bar);
            __builtin_amdgcn_fence(__ATOMIC_ACQUIRE, "agent");
            asm volatile("s_waitcnt vmcnt(0)" ::: "memory");
        }
    }
    __syncthreads();
}

__global__ void __launch_bounds__(512, 2) mega(Args a) {
    extern __shared__ __attribute__((aligned(16))) unsigned char lds_raw[];
    cg::grid_group grid = cg::this_grid();
    volatile LAS unsigned* bst = (volatile LAS unsigned*)((LAS unsigned char*)lds_raw + LDS_QWORD + 16);
    if (threadIdx.x < 2) bst[threadIdx.x] = 0u;
    __syncthreads();
    const XcdBarrier bar = xcd_barrier_post((unsigned*)(a.ws + WS_CTL) + CW_BAR, bst);
    if (a.coop == 0x7fffffff) grid.sync();
    int dup = 0;
    for (int ph = a.ph_lo; ph < a.ph_hi; ++ph) {
        CArgs* ap = (CArgs*)__builtin_amdgcn_kernarg_segment_ptr(); asm volatile("" : "+s"(ap));
        run_phase(*ap, ph, lds_raw, (LAS unsigned char*)lds_raw, dup);
        if (PROBE_DUP >= 0 && dup == 0 && ((ph > 0 && (ph - 1) % 10 == PROBE_DUP) || (ph == 0 && PROBE_DUP == 10) || (PROBE_DUP == 20 && ph > 0 && ((ph - 1) % 10 == 2 || (ph - 1) % 10 == 3 || (ph - 1) % 10 == 4)))) { dup = 1; --ph; } else dup = 0;
        if (ph + 1 < a.ph_hi) { xcd_barrier(bar); for (int q = 0; q < PROBE_SYNC; ++q) xcd_barrier(bar); }
    }
}

constexpr int NPHASE = 21;
extern "C" void kernel_launch(void* const* d_in, const int* in_sizes, int n_in, void* d_out, int out_size, void* d_ws, size_t ws_size, hipStream_t stream) {
    static int grid = 0;
    if (grid == 0) {
        if (n_in != 28 || ws_size < WS_END) { fprintf(stderr, "kernel_launch: unexpected n_in %d or ws %zu < %zu\n", n_in, ws_size, (size_t)WS_END); grid = -1; return; }
        int dev = 0, cus = 0, per_cu = 0;
        hipGetDevice(&dev); hipDeviceGetAttribute(&cus, hipDeviceAttributeMultiprocessorCount, dev);
        if (hipFuncSetAttribute((const void*)mega, hipFuncAttributeMaxDynamicSharedMemorySize, LDS_BYTES) != hipSuccess) { fprintf(stderr, "kernel_launch: hipFuncSetAttribute failed\n"); grid = -1; return; }
        if (hipOccupancyMaxActiveBlocksPerMultiprocessor(&per_cu, (const void*)mega, 512, LDS_BYTES) != hipSuccess || per_cu < 1) per_cu = 1;
        (void)hipGetLastError();
        grid = cus * per_cu;
    }
    if (grid < 0) return;
    hipMemsetAsync((char*)d_ws + WS_CTL, 0, CTL_BYTES, stream);
    Args a{};
    for (int i = 0; i < 28; ++i) a.in[i] = (const float*)d_in[i];
    a.out = (float*)d_out; a.ws = (unsigned char*)d_ws; a.coop = MK_COOP; a.pad = 0;
#if MK_COOP
    a.ph_lo = 0; a.ph_hi = NPHASE;
    void* args[] = {&a};
    hipError_t e = hipLaunchCooperativeKernel((const void*)mega, dim3(grid), dim3(512), args, LDS_BYTES, stream);
    if (e != hipSuccess) fprintf(stderr, "cooperative launch failed: %s (grid %d)\n", hipGetErrorString(e), grid);
#else
    for (int ph = 0; ph < NPHASE; ++ph) { a.ph_lo = ph; a.ph_hi = ph + 1; hipLaunchKernelGGL(mega, dim3(grid), dim3(512), LDS_BYTES, stream, a); }
#endif
}
```

```cpp
#include <hip/hip_runtime.h>
#include <hip/hip_cooperative_groups.h>
#include <hip/hip_bf16.h>
#include <cstdio>
#include <cstdint>
namespace cg = cooperative_groups;

#ifndef MK_COOP
#define MK_COOP 1
#endif
#define PROBE_DUP -1
#define PROBE_CUT 0
#define PROBE_ATT 0
#define PROBE_SYNC 0
#define PROBE_KIND -1

#define LAS __attribute__((address_space(3)))
typedef unsigned short bf16_t;
typedef short bf16x8 __attribute__((ext_vector_type(8)));
typedef short s16x4 __attribute__((ext_vector_type(4)));
typedef float f32x4 __attribute__((ext_vector_type(4)));
typedef float f32x2 __attribute__((ext_vector_type(2)));
typedef float f32x16 __attribute__((ext_vector_type(16)));
typedef unsigned u32x4 __attribute__((ext_vector_type(4)));
typedef unsigned u32x2 __attribute__((ext_vector_type(2)));

constexpr int DM = 2048, NBATCH = 4, SEQ = 4096, CTXL = 256, TOK = SEQ + CTXL  , NR = NBATCH * TOK  ;
constexpr int INC = 3936, INP = 4096, DFF = 5632;
constexpr int C_AQ = 0, C_AK = 1024, C_AV = 1280, C_BCQ = 1536, C_BCKV = 2048, C_BKR = 2304, C_CQ = 2368, C_CK = 2624, C_CV = 2880, C_CG = 3392, C_CGF = 3904, C_CGB = 3920;
constexpr float EPS = 1e-6f;
constexpr float QSCALE_A = 0.088388347648318440f * 1.4426950408889634f, QSCALE_B = 0.072168783648703220f * 1.4426950408889634f;
constexpr int NCHUNK = NR / 64;
constexpr size_t MiB = 1u << 20;
constexpr size_t WS_CTL = 0, CTL_BYTES = 1 * MiB;
constexpr size_t WS_MOD = 64 * 1024;
constexpr size_t WS_W = 1 * MiB, W_LAYER = 92 * MiB;
constexpr size_t WO_IN = 0, WO_UQ = 16 * MiB, WO_UKV = 17 * MiB, WO_OUT = 18 * MiB, WO_GU = 26 * MiB, WO_DN = 70 * MiB;
constexpr size_t WS_HZ = WS_W + 2 * W_LAYER;
constexpr size_t WS_XR = WS_HZ + 68 * MiB;
constexpr size_t WS_S = WS_XR + 136 * MiB;
constexpr size_t WS_PROJ = WS_S;
constexpr size_t WS_QB = WS_PROJ + 136 * MiB;
constexpr size_t WS_KVB = WS_QB + 26 * MiB;
constexpr size_t WS_KB = WS_KVB + 34 * MiB;
constexpr size_t WS_KVS = WS_KB + 26 * MiB;
constexpr size_t WS_DEC = WS_KVS + 68 * MiB;
constexpr size_t WS_ACT = WS_S;
constexpr size_t WS_END = WS_DEC + 1 * MiB;
constexpr int CW_QUEUE = 64;

constexpr size_t PART_OFF = 10u << 20;
constexpr int LDS_BYTES = 155648;
constexpr int LDS_QWORD = 153600;

__device__ __forceinline__ float bf2f(unsigned short x) { return __uint_as_float(((unsigned)x) << 16); }
__device__ __forceinline__ float bflo(unsigned w) { return __uint_as_float(w << 16); }
__device__ __forceinline__ float bfhi(unsigned w) { return __uint_as_float(w & 0xffff0000u); }
__device__ __forceinline__ unsigned cvt_pk_bf16(float lo, float hi) { unsigned r; asm volatile("v_cvt_pk_bf16_f32 %0, %1, %2" : "=v"(r) : "v"(lo), "v"(hi)); return r; }
__device__ __forceinline__ unsigned short f2bf(float f) { return (unsigned short)(cvt_pk_bf16(f, 0.f) & 0xffffu); }
__device__ __forceinline__ float wave_sum(float v) {
#pragma unroll
    for (int o = 1; o < 64; o <<= 1) v += __shfl_xor(v, o);
    return v;
}
__device__ __forceinline__ float silu_f(float g) { return g * __builtin_amdgcn_rcpf(1.f + __expf(-g)); }

namespace pg8 {
constexpr int BM = 256, BK = 64, HALF = 128, HTB = HALF * BK * 2, STAGE_BYTES = 8 * HTB, NXCD = 8, WGM = 8;
__host__ __device__ __forceinline__ int lds_byte(int r, int c) { const int st = (r >> 4) * 2 + (c >> 5), rr = r & 15, cc = c & 31, ob = rr * 64 + cc * 2; return st * 1024 + (ob ^ (((ob >> 9) & 1) << 5)); }
__host__ __device__ __forceinline__ void stage_rc(int b, int& R, int& C) { const int st = b / 1024, sb = b % 1024, swz = sb ^ (((sb >> 9) & 1) << 5); R = (st >> 1) * 16 + swz / 64; C = (st & 1) * 32 + (swz % 64) / 2; }
__host__ __device__ __forceinline__ int perm32(int rho) { const int n = rho >> 4, i = rho & 15; return 8 * (i >> 2) + 4 * n + (i & 3); }
struct Unit { int pm, pn, kp; };
struct Gemm { const bf16_t* A; const bf16_t* Bt; int M, N, K, lda, skipctx, kpart; };
__device__ __forceinline__ int phys_tile(int pm, int skip) { return skip == 1 ? pm + (pm >> 4) + 1 : (skip == 2 ? pm * 17 : pm); }
struct StaticOrder {
    int nM, nN, nwg, G, c, n2;
    __device__ void init(int M, int N, int G_, int c_, int ks = 1) { nM = M / BM; nN = N / BM; n2 = nM * nN; nwg = n2 * ks; G = G_; c = c_; }
    __device__ bool next(int i, Unit& u) const {
        const long L = (long)i * G + c; if (L >= nwg) return false;
        int wgid = (int)L; { const int q = nwg / NXCD, r = nwg % NXCD, xcd = wgid % NXCD, off = wgid / NXCD; wgid = (xcd < r ? xcd * (q + 1) : r * (q + 1) + (xcd - r) * q) + off; }
        u.kp = wgid / n2; wgid -= u.kp * n2;
        const int nig = WGM * nN, gid = wgid / nig, fm = gid * WGM, gsz = (nM - fm) < WGM ? (nM - fm) : WGM;
        u.pm = fm + ((wgid % nig) % gsz); u.pn = (wgid % nig) / gsz; return true;
    }
};
struct EpiStore {
    static constexpr bool PERM = true;
    bf16_t* O; int ldc; int skipctx;
    __device__ __forceinline__ void operator()(const f32x4 (&acc)[2][2][4][2], const Unit& u, int wr, int wc, int fr, int fq) const {
        const int row0 = phys_tile(u.pm, skipctx) * BM + wr * 64 + fr, col0 = u.pn * BM + wc * 32 + 8 * fq;
#pragma unroll
        for (int ai = 0; ai < 2; ++ai)
#pragma unroll
            for (int m = 0; m < 4; ++m) { bf16_t* rowp = O + (size_t)(row0 + ai * HALF + m * 16) * ldc + col0;
#pragma unroll
                for (int bj = 0; bj < 2; ++bj) { const f32x4 v0 = acc[ai][bj][m][0], v1 = acc[ai][bj][m][1];
                    u32x4 w; w.x = cvt_pk_bf16(v0[0], v0[1]); w.y = cvt_pk_bf16(v0[2], v0[3]); w.z = cvt_pk_bf16(v1[0], v1[1]); w.w = cvt_pk_bf16(v1[2], v1[3]);
                    *(u32x4*)(rowp + bj * HALF) = w; } }
    }
};
struct EpiSwiGLU {
    static constexpr bool PERM = true;
    bf16_t* O; int skipctx;
    __device__ __forceinline__ void operator()(const f32x4 (&acc)[2][2][4][2], const Unit& u, int wr, int wc, int fr, int fq) const {
        const int row0 = phys_tile(u.pm, skipctx) * BM + wr * 64 + fr, col0 = u.pn * HALF + wc * 32 + 8 * fq;
#pragma unroll
        for (int ai = 0; ai < 2; ++ai)
#pragma unroll
            for (int m = 0; m < 4; ++m) { bf16_t* rowp = O + (size_t)(row0 + ai * HALF + m * 16) * DFF + col0;
                float r[8];
#pragma unroll
                for (int n = 0; n < 2; ++n)
#pragma unroll
                    for (int e = 0; e < 4; ++e) r[n * 4 + e] = silu_f(acc[ai][0][m][n][e]) * acc[ai][1][m][n][e];
                u32x4 w; w.x = cvt_pk_bf16(r[0], r[1]); w.y = cvt_pk_bf16(r[2], r[3]); w.z = cvt_pk_bf16(r[4], r[5]); w.w = cvt_pk_bf16(r[6], r[7]);
                *(u32x4*)rowp = w; }
    }
};
struct EpiPartial {
    static constexpr bool PERM = false;
    float* P;
    __device__ __forceinline__ void operator()(const f32x4 (&acc)[2][2][4][2], const Unit& u, int wr, int wc, int fr, int fq) const {
        float* t = P + ((size_t)(u.kp * 32 + u.pm * 8 + u.pn) << 16); const int col0 = wc * 32 + 4 * fq;
#pragma unroll
        for (int ai = 0; ai < 2; ++ai)
#pragma unroll
            for (int m = 0; m < 4; ++m) { float* rp = t + (ai * HALF + wr * 64 + m * 16 + fr) * 256 + col0;
#pragma unroll
                for (int bj = 0; bj < 2; ++bj)
#pragma unroll
                    for (int n = 0; n < 2; ++n) *(f32x4*)(rp + bj * HALF + n * 16) = acc[ai][bj][m][n]; }
    }
};
struct EpiResid {
    static constexpr bool PERM = false;
    const float* xin; const float* ctxin; const float* xr_in; float* xr_out; float* fin_out; const float* gate; int in_split, out_final, skipctx;
    __device__ __forceinline__ void operator()(const f32x4 (&acc)[2][2][4][2], const Unit& u, int wr, int wc, int fr, int fq) const {
        const int pt = phys_tile(u.pm, skipctx), b = pt / 17, t = pt - b * 17, v = (t == 0) ? 4 : b;
        const float* inb = in_split ? (t == 0 ? ctxin + (size_t)b * CTXL * DM : xin + ((size_t)b * SEQ + (size_t)(t - 1) * 256) * DM) : xr_in + (size_t)pt * BM * DM;
        float* ob = out_final ? fin_out + ((size_t)b * SEQ + (size_t)(t - 1) * 256) * DM : xr_out + (size_t)pt * BM * DM;
        const int col0 = u.pn * BM + wc * 32 + 4 * fq;
        const float* gp = gate + (size_t)v * 12288 + col0;
        f32x4 gv[2][2];
#pragma unroll
        for (int bj = 0; bj < 2; ++bj)
#pragma unroll
            for (int n = 0; n < 2; ++n) gv[bj][n] = *(const f32x4*)(gp + bj * HALF + n * 16);
#pragma unroll
        for (int ai = 0; ai < 2; ++ai)
#pragma unroll
            for (int m = 0; m < 4; ++m) { const size_t off = (size_t)(ai * HALF + wr * 64 + m * 16 + fr) * DM + col0;
#pragma unroll
                for (int bj = 0; bj < 2; ++bj)
#pragma unroll
                    for (int n = 0; n < 2; ++n) { const f32x4 bs = *(const f32x4*)(inb + off + bj * HALF + n * 16);
                        *(f32x4*)(ob + off + bj * HALF + n * 16) = bs + gv[bj][n] * acc[ai][bj][m][n]; }
                if (m == 3) asm volatile("" ::: "memory"); }
    }
};

template <class Epi>
__device__ __forceinline__ void gemm_phase(LAS unsigned char* lds, const Gemm g, const StaticOrder& S, const Epi& E) {
    int tid_ = threadIdx.x; asm volatile("" : "+v"(tid_));
    const int tid = tid_, wid = __builtin_amdgcn_readfirstlane(tid >> 6), lane = tid & 63, wr = wid >> 2, wc = wid & 3, fr = lane & 15, fq = lane >> 4;
    const int K = g.K, nt = g.kpart / BK, lda = g.lda;
    unsigned voffA[2], voffB[2];
#pragma unroll
    for (int i = 0; i < 2; ++i) { int R, C; stage_rc(tid * 16 + i * 8192, R, C); const int Rb = Epi::PERM ? ((R & ~31) + perm32(R & 31)) : R;
        voffA[i] = (unsigned)(R * lda + C) * 2u; voffB[i] = (unsigned)(Rb * K + C) * 2u; }
    const size_t kstep = (size_t)(BK * 2);
    const size_t hstepA = (size_t)HALF * lda * 2, hstepB = (size_t)HALF * K * 2;
    const size_t tstepA = 2 * hstepA, tstepB = 2 * hstepB;
    const unsigned ldsw = (unsigned)wid * 1024u;
    const int aoff = lds_byte(wr * 64 + fr, fq * 8), boff = lds_byte(wc * 32 + fr, fq * 8);
#define PG8_SA(b, h) (((b) * 2 + (h)) * HTB)
#define PG8_SB(b, h) ((4 + (b) * 2 + (h)) * HTB)
#define PG8_STAGE(bufoff, gbase, voff) do { _Pragma("unroll") for (int _i = 0; _i < 2; ++_i) \
        __builtin_amdgcn_global_load_lds((const unsigned*)((const char*)(gbase) + (voff)[_i]), (LAS unsigned*)(lds + (bufoff) + ldsw + _i * 8192), 16, 0, 0); } while (0)
#define PG8_LDA(dst, b, h) do { _Pragma("unroll") for (int m = 0; m < 4; ++m) _Pragma("unroll") for (int k = 0; k < 2; ++k) dst[m][k] = *(const LAS bf16x8*)(lds + PG8_SA(b, h) + aoff + m * 2048 + k * 1024); } while (0)
#define PG8_LDB(dst, b, h) do { _Pragma("unroll") for (int n = 0; n < 2; ++n) _Pragma("unroll") for (int k = 0; k < 2; ++k) dst[n][k] = *(const LAS bf16x8*)(lds + PG8_SB(b, h) + boff + n * 2048 + k * 1024); } while (0)
#define PG8_MMA(ai, bj, At, Bt) do { __builtin_amdgcn_s_setprio(1); _Pragma("unroll") for (int m = 0; m < 4; ++m) _Pragma("unroll") for (int n = 0; n < 2; ++n) _Pragma("unroll") for (int k = 0; k < 2; ++k) \
        acc[ai][bj][m][n] = __builtin_amdgcn_mfma_f32_16x16x32_bf16(Bt[n][k], At[m][k], acc[ai][bj][m][n], 0, 0, 0); __builtin_amdgcn_s_setprio(0); } while (0)
#define PG8_WAIT_V(n) asm volatile("s_waitcnt vmcnt(" #n ")" ::: "memory")
#define PG8_WAIT_L(n) asm volatile("s_waitcnt lgkmcnt(" #n ")" ::: "memory")
#define PG8_BAR __builtin_amdgcn_s_barrier()
#define PG8_SCHED __builtin_amdgcn_sched_barrier(0)
    Unit cur, nxt; int ui = 0;
    if (!S.next(0, cur)) return;
    f32x4 acc[2][2][4][2];
#pragma unroll
    for (int a = 0; a < 2; ++a)
#pragma unroll
        for (int b = 0; b < 2; ++b)
#pragma unroll
            for (int m = 0; m < 4; ++m)
#pragma unroll
                for (int n = 0; n < 2; ++n) acc[a][b][m][n] = (f32x4){0.f, 0.f, 0.f, 0.f};
    bf16x8 At[4][2], B0[2][2], B1[2][2];
    const size_t kpb = (size_t)g.kpart * 2;
    const char* cA = (const char*)g.A + (size_t)phys_tile(cur.pm, g.skipctx) * tstepA + cur.kp * kpb; const char* cB = (const char*)g.Bt + (size_t)cur.pn * tstepB + cur.kp * kpb;
    PG8_STAGE(PG8_SB(0, 0), cB, voffB); PG8_STAGE(PG8_SB(0, 1), cB + hstepB, voffB); PG8_STAGE(PG8_SA(0, 0), cA, voffA); PG8_STAGE(PG8_SA(0, 1), cA + hstepA, voffA);
    if (wr == 1) PG8_BAR;
    PG8_WAIT_V(2); PG8_BAR;
    PG8_STAGE(PG8_SB(1, 0), cB + kstep, voffB); PG8_STAGE(PG8_SA(1, 0), cA + kstep, voffA); PG8_STAGE(PG8_SB(1, 1), cB + hstepB + kstep, voffB);
    PG8_WAIT_V(6); PG8_BAR;
    for (;;) {
        const bool has_next = S.next(ui + 1, nxt);
        const char* nA = has_next ? (const char*)g.A + (size_t)phys_tile(nxt.pm, g.skipctx) * tstepA + nxt.kp * kpb : cA; const char* nB = has_next ? (const char*)g.Bt + (size_t)nxt.pn * tstepB + nxt.kp * kpb : cB;
        for (int t = 0; t < nt; t += 2) {
            const bool last = (t == nt - 2);
            const char* a1 = cA + (size_t)(t + 1) * kstep;
            const char* a2 = last ? nA : cA + (size_t)(t + 2) * kstep; const char* b2 = last ? nB : cB + (size_t)(t + 2) * kstep;
            const char* a3 = a2 + kstep; const char* b3 = b2 + kstep;
            PG8_LDB(B0, 0, 0); PG8_LDB(B1, 0, 1); PG8_SCHED; PG8_LDA(At, 0, 0); PG8_STAGE(PG8_SA(1, 1), a1 + hstepA, voffA);
            PG8_WAIT_V(8); PG8_WAIT_L(0); PG8_BAR; PG8_MMA(0, 0, At, B0); PG8_MMA(0, 1, At, B1); PG8_BAR; PG8_SCHED;
            PG8_LDA(At, 0, 1); PG8_STAGE(PG8_SB(0, 0), b2, voffB); PG8_STAGE(PG8_SB(0, 1), b2 + hstepB, voffB); PG8_STAGE(PG8_SA(0, 0), a2, voffA);
            PG8_WAIT_V(8); PG8_WAIT_L(0); PG8_BAR; PG8_MMA(1, 0, At, B0); PG8_MMA(1, 1, At, B1); PG8_BAR; PG8_SCHED;
            PG8_LDB(B0, 1, 0); PG8_LDB(B1, 1, 1); PG8_SCHED; PG8_LDA(At, 1, 0); PG8_STAGE(PG8_SA(0, 1), a2 + hstepA, voffA);
            PG8_WAIT_V(8); PG8_WAIT_L(0); PG8_BAR; PG8_MMA(0, 0, At, B0); PG8_MMA(0, 1, At, B1); PG8_BAR; PG8_SCHED;
            PG8_LDA(At, 1, 1); PG8_STAGE(PG8_SB(1, 0), b3, voffB); PG8_STAGE(PG8_SB(1, 1), b3 + hstepB, voffB); PG8_STAGE(PG8_SA(1, 0), a3, voffA);
            PG8_WAIT_V(8); PG8_WAIT_L(0); PG8_BAR; PG8_MMA(1, 0, At, B0); PG8_MMA(1, 1, At, B1); PG8_BAR; PG8_SCHED;
        }
        if (wr == 0) PG8_BAR;
        E(acc, cur, wr, wc, fr, fq);
        if (!has_next) break;
#pragma unroll
        for (int a = 0; a < 2; ++a)
#pragma unroll
            for (int b = 0; b < 2; ++b)
#pragma unroll
                for (int m = 0; m < 4; ++m)
#pragma unroll
                    for (int n = 0; n < 2; ++n) acc[a][b][m][n] = (f32x4){0.f, 0.f, 0.f, 0.f};
        cur = nxt; cA = nA; cB = nB; ++ui;
        if (wr == 1) PG8_BAR;
    }
    PG8_WAIT_V(0);
    PG8_BAR;
#undef PG8_SA
#undef PG8_SB
#undef PG8_STAGE
#undef PG8_LDA
#undef PG8_LDB
#undef PG8_MMA
#undef PG8_WAIT_V
#undef PG8_WAIT_L
#undef PG8_BAR
#undef PG8_SCHED
}
}

namespace att {
using bf16 = bf16_t;
constexpr int NW = 8, QBLK = 32, KVBLK = 64;
constexpr float THR = 8.f;
#define SBAR() __builtin_amdgcn_sched_barrier(0)
__device__ __forceinline__ int crow(int r, int hi) { return (r & 3) + 8 * (r >> 2) + 4 * hi; }
template <int DQK> __device__ __forceinline__ int kswz(int r) { return DQK == 128 ? ((r & 15) << 4) : (((r >> 1) & 7) << 4); }
template <int DQK> struct Cfg {
    static constexpr int KCH = DQK / 8, NKC = 64 * KCH / 512, ROWB = DQK * 2;
    static constexpr int SHM_K = 64 * DQK * 2, SHM_V = 64 * 128 * 2;
    static constexpr float SCALE = DQK == 128 ? 0.088388347648318440f : 0.072168783648703220f;
};
template <int DQK> __device__ __forceinline__ void partialSM(f32x16& p0, f32x16& p1, float& m_reg, float& mn, float& alpha) {
    constexpr float SCALE = Cfg<DQK>::SCALE;
    constexpr float C = SCALE * 1.4426950408889634f;
    float pmax = p0[0];
#pragma unroll
    for (int r = 1; r < 16; ++r) pmax = fmaxf(pmax, p0[r]);
#pragma unroll
    for (int r = 0; r < 16; ++r) pmax = fmaxf(pmax, p1[r]);
    { auto rr = __builtin_amdgcn_permlane32_swap(__float_as_uint(pmax), __float_as_uint(pmax), false, false);
      pmax = fmaxf(__uint_as_float(rr[0]), __uint_as_float(rr[1])); }
    if (__builtin_expect(__all(pmax - m_reg <= THR / SCALE), 1)) { mn = m_reg; alpha = 1.f; }
    else { mn = fmaxf(m_reg, pmax); alpha = __builtin_amdgcn_exp2f((m_reg - mn) * C); m_reg = mn; }
    float mnC = -mn * C;
#pragma unroll
    for (int r = 0; r < 16; ++r) p0[r] = fmaf(p0[r], C, mnC);
#pragma unroll
    for (int r = 0; r < 16; ++r) p1[r] = fmaf(p1[r], C, mnC);
#pragma unroll
    for (int r = 0; r < 16; ++r) p0[r] = __builtin_amdgcn_exp2f(p0[r]);
}
__device__ __forceinline__ void finishSM(f32x16& p0, f32x16& p1, float alpha, float& l_reg, bf16x8& pa0, bf16x8& pa1, bf16x8& pa2, bf16x8& pa3) {
#pragma unroll
    for (int r = 0; r < 16; ++r) p1[r] = __builtin_amdgcn_exp2f(p1[r]);
    float ps = 0;
#pragma unroll
    for (int r = 0; r < 16; ++r) ps += p0[r];
#pragma unroll
    for (int r = 0; r < 16; ++r) ps += p1[r];
    { auto rr = __builtin_amdgcn_permlane32_swap(__float_as_uint(ps), __float_as_uint(ps), false, false);
      ps = __uint_as_float(rr[0]) + __uint_as_float(rr[1]); }
    l_reg = l_reg * alpha + ps;
#define PK4(P, BASE, OUT) do { unsigned a0 = cvt_pk_bf16(P[BASE + 0], P[BASE + 1]), a1 = cvt_pk_bf16(P[BASE + 2], P[BASE + 3]);   \
    unsigned b0 = cvt_pk_bf16(P[BASE + 4], P[BASE + 5]), b1 = cvt_pk_bf16(P[BASE + 6], P[BASE + 7]);                              \
    auto r0 = __builtin_amdgcn_permlane32_swap(a0, b0, false, false); auto r1 = __builtin_amdgcn_permlane32_swap(a1, b1, false, false); \
    u32x4 w = {r0[0], r1[0], r0[1], r1[1]}; OUT = *reinterpret_cast<bf16x8*>(&w); } while (0)
    PK4(p0, 0, pa0); PK4(p0, 8, pa1); PK4(p1, 0, pa2); PK4(p1, 8, pa3);
#undef PK4
}
constexpr float THR2 = 8.f;
__device__ __forceinline__ void partialSM2(f32x16& p0, f32x16& p1, float& m_hat, f32x16& negm, float& alpha) {
    float pmax = fmaxf(p0[0], p0[1]);
#pragma unroll
    for (int r = 2; r < 16; ++r) pmax = fmaxf(pmax, p0[r]);
#pragma unroll
    for (int r = 0; r < 16; ++r) pmax = fmaxf(pmax, p1[r]);
    { auto rr = __builtin_amdgcn_permlane32_swap(__float_as_uint(pmax), __float_as_uint(pmax), false, false);
      pmax = fmaxf(__uint_as_float(rr[0]), __uint_as_float(rr[1])); }
    if (__builtin_expect(__all(pmax <= THR2), 1)) { alpha = 1.f; }
    else { const float dl = fmaxf(pmax, 0.f); m_hat += dl; alpha = __builtin_amdgcn_exp2f(-dl);
#pragma unroll
        for (int r = 0; r < 16; ++r) { p0[r] -= dl; p1[r] -= dl; }
#pragma unroll
        for (int r = 0; r < 16; ++r) negm[r] = -m_hat; }
#pragma unroll
    for (int r = 0; r < 16; ++r) p0[r] = __builtin_amdgcn_exp2f(p0[r]);
}
__device__ __forceinline__ void finishSM2(f32x16& p0, f32x16& p1, bf16x8& pa0, bf16x8& pa1, bf16x8& pa2, bf16x8& pa3) {
#pragma unroll
    for (int r = 0; r < 16; ++r) p1[r] = __builtin_amdgcn_exp2f(p1[r]);
#define PK4(P, BASE, OUT) do { unsigned a0 = cvt_pk_bf16(P[BASE + 0], P[BASE + 1]), a1 = cvt_pk_bf16(P[BASE + 2], P[BASE + 3]);   \
    unsigned b0 = cvt_pk_bf16(P[BASE + 4], P[BASE + 5]), b1 = cvt_pk_bf16(P[BASE + 6], P[BASE + 7]);                              \
    auto r0 = __builtin_amdgcn_permlane32_swap(a0, b0, false, false); auto r1 = __builtin_amdgcn_permlane32_swap(a1, b1, false, false); \
    u32x4 w = {r0[0], r1[0], r0[1], r1[1]}; OUT = *reinterpret_cast<bf16x8*>(&w); } while (0)
    PK4(p0, 0, pa0); PK4(p0, 8, pa1); PK4(p1, 0, pa2); PK4(p1, 8, pa3);
#undef PK4
}
template <int DQK> __device__ __forceinline__ void qkt(f32x16& p0, f32x16& p1, const char* Ks, const bf16x8* qr, const char* qrl, int r32, int hi, const f32x16& c0) {
    constexpr int ROWB = Cfg<DQK>::ROWB;
    p0 = c0; p1 = c0;
#pragma unroll
    for (int d0 = 0; d0 < 8; ++d0) { const int cb = (d0 * 16 + hi * 8) * 2;
        bf16x8 b0 = *reinterpret_cast<const bf16x8*>(Ks + r32 * ROWB + (cb ^ kswz<DQK>(r32)));
        bf16x8 b1 = *reinterpret_cast<const bf16x8*>(Ks + (32 + r32) * ROWB + (cb ^ kswz<DQK>(r32)));
        p0 = __builtin_amdgcn_mfma_f32_32x32x16_bf16(b0, qr[d0], p0, 0, 0, 0);
        p1 = __builtin_amdgcn_mfma_f32_32x32x16_bf16(b1, qr[d0], p1, 0, 0, 0);
        if constexpr (DQK == 192) { if (d0 == 3 || d0 == 7) SBAR(); } }
    if constexpr (DQK == 192) {
#pragma unroll
        for (int d0 = 8; d0 < 12; ++d0) { const int cb = (d0 * 16 + hi * 8) * 2;
            const bf16x8 q = *reinterpret_cast<const bf16x8*>(qrl + (d0 - 8) * 1024);
            bf16x8 b0 = *reinterpret_cast<const bf16x8*>(Ks + r32 * ROWB + (cb ^ kswz<DQK>(r32)));
            bf16x8 b1 = *reinterpret_cast<const bf16x8*>(Ks + (32 + r32) * ROWB + (cb ^ kswz<DQK>(r32)));
            p0 = __builtin_amdgcn_mfma_f32_32x32x16_bf16(b0, q, p0, 0, 0, 0);
            p1 = __builtin_amdgcn_mfma_f32_32x32x16_bf16(b1, q, p1, 0, 0, 0); }
    }
}
__device__ __forceinline__ int v_st(int k, int c) { const int kk = (k & ~0xC) | ((k & 4) << 1) | ((k & 8) >> 1); return ((kk >> 3) * 4 + (c >> 5)) * 512 + ((kk & 7) * 32 + (c & 31)) * 2; }
__device__ __forceinline__ int v_rd_base(int lane) { return ((lane & 3) << 3) | (((lane >> 2) & 3) << 6) | (((lane >> 4) & 1) << 5) | (((lane >> 5) & 1) << 8); }
constexpr int v_rd_off(int d0, int ks, int half) { return d0 * 512 + ks * 4096 + half * 2048; }
template <int OFF> __device__ __forceinline__ s16x4 tr_read(int vb) {
    s16x4 r; asm volatile("ds_read_b64_tr_b16 %0, %1 offset:%2" : "=&v"(r) : "v"(vb), "i"(OFF) : "memory"); return r;
}
template <int D0> __device__ __forceinline__ void pv_one(f32x16& od, int vb, bf16x8 pa0, bf16x8 pa1, bf16x8 pa2, bf16x8 pa3) {
    const s16x4 l0 = tr_read<v_rd_off(D0, 0, 0)>(vb), h0 = tr_read<v_rd_off(D0, 0, 1)>(vb), l1 = tr_read<v_rd_off(D0, 1, 0)>(vb), h1 = tr_read<v_rd_off(D0, 1, 1)>(vb);
    const s16x4 l2 = tr_read<v_rd_off(D0, 2, 0)>(vb), h2 = tr_read<v_rd_off(D0, 2, 1)>(vb), l3 = tr_read<v_rd_off(D0, 3, 0)>(vb), h3 = tr_read<v_rd_off(D0, 3, 1)>(vb);
    asm volatile("s_waitcnt lgkmcnt(0)" ::: "memory"); SBAR();
#define PK(L, H) (bf16x8){L[0], L[1], L[2], L[3], H[0], H[1], H[2], H[3]}
    od = __builtin_amdgcn_mfma_f32_32x32x16_bf16(pa0, PK(l0, h0), od, 0, 0, 0);
    od = __builtin_amdgcn_mfma_f32_32x32x16_bf16(pa1, PK(l1, h1), od, 0, 0, 0);
    od = __builtin_amdgcn_mfma_f32_32x32x16_bf16(pa2, PK(l2, h2), od, 0, 0, 0);
    od = __builtin_amdgcn_mfma_f32_32x32x16_bf16(pa3, PK(l3, h3), od, 0, 0, 0);
#undef PK
}
__device__ __forceinline__ void pv_d0(f32x16* o, int vb, bf16x8 pa0, bf16x8 pa1, bf16x8 pa2, bf16x8 pa3) {
    pv_one<0>(o[0], vb, pa0, pa1, pa2, pa3); pv_one<1>(o[1], vb, pa0, pa1, pa2, pa3); pv_one<2>(o[2], vb, pa0, pa1, pa2, pa3); pv_one<3>(o[3], vb, pa0, pa1, pa2, pa3);
}
template <int DQK, int SDEPTH, int LDQ, int LDK, int LDV, int LDO>
__device__ __forceinline__ void attn_body(const bf16* __restrict__ Qb, const bf16* __restrict__ Kh, const bf16* __restrict__ Vh,
                                          bf16* __restrict__ Ob, int seq, char* lds) {
    using C = Cfg<DQK>;
    constexpr int SHM_K = C::SHM_K, SHM_V = C::SHM_V, NKC = C::NKC, KCH = C::KCH, ROWB = C::ROWB;
    int tid_ = threadIdx.x; asm volatile("" : "+v"(tid_));
    const int tid = tid_, wid = tid >> 6, lane = tid & 63, r32 = lane & 31, hi = lane >> 5;
    char* V_lds = lds; char* K_lds = lds + 2 * SHM_V;
    float* ws = (float*)(lds + 2 * SHM_V + 2 * SHM_K) + wid * 64; float* li_l = ws; float* al_l = ws + 32;
    char* QR_lds = lds + 2 * SHM_V + 2 * SHM_K + 2048 + wid * 4096 + lane * 16;
    float m_reg = -1e30f, l_reg = 0; f32x16 o[4] = {}; bf16x8 qr[8];
    const bf16* Qw = Qb + (long)(wid * QBLK + r32) * LDQ + hi * 8;
    __syncthreads();
#pragma unroll
    for (int d0 = 0; d0 < 8; ++d0) qr[d0] = *reinterpret_cast<const bf16x8*>(Qw + d0 * 16);
    if constexpr (DQK == 192) {
#pragma unroll
        for (int d0 = 8; d0 < 12; ++d0) *reinterpret_cast<bf16x8*>(QR_lds + (d0 - 8) * 1024) = *reinterpret_cast<const bf16x8*>(Qw + d0 * 16);
    }
    const int sr = tid >> 4, sc = (tid & 15) * 8, vst0 = v_st(sr, sc), vst1 = v_st(32 + sr, sc);
    int krow[NKC], kcol[NKC], kdst[NKC];
#pragma unroll
    for (int i = 0; i < NKC; ++i) { const int c = tid + 512 * i; krow[i] = c / KCH; kcol[i] = (c % KCH) * 8; kdst[i] = krow[i] * ROWB + ((kcol[i] * 2) ^ kswz<DQK>(krow[i])); }
    const int vb0 = (int)(uintptr_t)V_lds + v_rd_base(lane);
    struct { bf16x8 vs0, vs1, ks[NKC]; } sr_[SDEPTH];
#define SLOAD(i, k0) do { sr_[i].vs0 = *reinterpret_cast<const bf16x8*>(&Vh[(long)((k0) + sr) * LDV + sc]); sr_[i].vs1 = *reinterpret_cast<const bf16x8*>(&Vh[(long)((k0) + 32 + sr) * LDV + sc]); \
    _Pragma("unroll") for (int q_ = 0; q_ < NKC; ++q_) sr_[i].ks[q_] = *reinterpret_cast<const bf16x8*>(&Kh[(long)((k0) + krow[q_]) * LDK + kcol[q_]]); } while (0)
#define SWRITE(b, i) do { *(bf16x8*)(V_lds + (b) * SHM_V + vst0) = sr_[i].vs0; *(bf16x8*)(V_lds + (b) * SHM_V + vst1) = sr_[i].vs1; \
    _Pragma("unroll") for (int q_ = 0; q_ < NKC; ++q_) *(bf16x8*)(K_lds + (b) * SHM_K + kdst[q_]) = sr_[i].ks[q_]; } while (0)
#define SWAIT() do { if constexpr (SDEPTH == 2) { if constexpr (NKC == 2) asm volatile("s_waitcnt vmcnt(4)" ::: "memory"); else asm volatile("s_waitcnt vmcnt(5)" ::: "memory"); } else asm volatile("s_waitcnt vmcnt(0)" ::: "memory"); } while (0)
#define RESC(a) do { if (__any((a) < 1.f)) { if (hi == 0) al_l[r32] = (a); asm volatile("s_waitcnt lgkmcnt(0)" ::: "memory"); \
    _Pragma("unroll") for (int d = 0; d < 4; ++d) _Pragma("unroll") for (int r = 0; r < 16; ++r) o[d][r] *= al_l[crow(r, hi)]; } } while (0)
    f32x16 pA0, pA1, pB0, pB1; float mnA, mnB, alA, alB; bf16x8 pa0, pa1, pa2, pa3; const int NT = seq / KVBLK;
    constexpr int SE = 0, SO = SDEPTH - 1;
    SLOAD(SE, 0); asm volatile("s_waitcnt vmcnt(0)" ::: "memory"); SWRITE(0, SE); __syncthreads();
    qkt<DQK>(pA0, pA1, K_lds, qr, QR_lds, r32, hi, f32x16{}); partialSM<DQK>(pA0, pA1, m_reg, mnA, alA);
    SLOAD(SO, KVBLK); if constexpr (SDEPTH == 2) { if (2 < NT) SLOAD(SE, 2 * KVBLK); }
    SWAIT(); SWRITE(1, SO); __syncthreads();
    for (int j = 1; j + 1 < NT; j += 2) {
        SBAR(); qkt<DQK>(pB0, pB1, K_lds + SHM_K, qr, QR_lds, r32, hi, f32x16{});
        finishSM(pA0, pA1, alA, l_reg, pa0, pa1, pa2, pa3); SBAR();
        SLOAD(SO, (j + SDEPTH) * KVBLK); SBAR();
        pv_d0(o, vb0, pa0, pa1, pa2, pa3); partialSM<DQK>(pB0, pB1, m_reg, mnB, alB);
        __syncthreads(); SWAIT(); SWRITE(0, SE);
        RESC(alB); __syncthreads();
        SBAR(); qkt<DQK>(pA0, pA1, K_lds, qr, QR_lds, r32, hi, f32x16{});
        finishSM(pB0, pB1, alB, l_reg, pa0, pa1, pa2, pa3); SBAR();
        if (SDEPTH == 1 || j + 3 < NT) SLOAD(SE, (j + 1 + SDEPTH) * KVBLK); SBAR();
        pv_d0(o, vb0 + (int)SHM_V, pa0, pa1, pa2, pa3); partialSM<DQK>(pA0, pA1, m_reg, mnA, alA);
        __syncthreads(); SWAIT(); SWRITE(1, SO);
        RESC(alA); __syncthreads();
    }
    SBAR(); qkt<DQK>(pB0, pB1, K_lds + SHM_K, qr, QR_lds, r32, hi, f32x16{});
    finishSM(pA0, pA1, alA, l_reg, pa0, pa1, pa2, pa3); SBAR();
    pv_d0(o, vb0, pa0, pa1, pa2, pa3); partialSM<DQK>(pB0, pB1, m_reg, mnB, alB);
    __syncthreads(); RESC(alB);
    finishSM(pB0, pB1, alB, l_reg, pa0, pa1, pa2, pa3); SBAR();
    pv_d0(o, vb0 + (int)SHM_V, pa0, pa1, pa2, pa3);
    if (hi == 0) li_l[r32] = l_reg; asm volatile("s_waitcnt lgkmcnt(0)" ::: "memory");
    float rli[16];
#pragma unroll
    for (int r = 0; r < 16; ++r) rli[r] = __builtin_amdgcn_rcpf(li_l[crow(r, hi)]);
    bf16* Ow = Ob + (long)(wid * QBLK) * LDO;
#pragma unroll
    for (int r = 0; r < 16; ++r) { const int orow = crow(r, hi);
#pragma unroll
        for (int d0 = 0; d0 < 4; ++d0) Ow[(long)orow * LDO + d0 * 32 + r32] = f2bf(o[d0][r] * rli[r]); }
#undef SLOAD
#undef SWRITE
#undef SWAIT
#undef RESC
}

template <int DQK, int LDQ, int LDK, int LDV, int LDO>
__device__ __forceinline__ void attn_body_s(const bf16* __restrict__ Qb, const bf16* __restrict__ Kh, const bf16* __restrict__ Vh,
                                            bf16* __restrict__ Ob, int seq, char* lds, int dup) {
    using C = Cfg<DQK>;
    constexpr int SHM_K = C::SHM_K, SHM_V = C::SHM_V, NKC = C::NKC, KCH = C::KCH, ROWB = C::ROWB;
    int tid_ = threadIdx.x; asm volatile("" : "+v"(tid_));
    const int tid = tid_, wid = __builtin_amdgcn_readfirstlane(tid >> 6), lane = tid & 63, r32 = lane & 31, hi = lane >> 5;
    const bool late = false;
    char* V_lds = lds; char* K_lds = lds + 3 * SHM_V;
    float* ws = (float*)(lds + 3 * SHM_V + 2 * SHM_K) + wid * 64; float* li_l = ws; float* al_l = ws + 32;
    char* QR_lds = lds + 3 * SHM_V + 2 * SHM_K + 2048 + wid * 4096 + lane * 16;
    float m_reg = 0.f; f32x16 o[4] = {}; f32x16 negm = {}, lsum = {}; bf16x8 qr[8];
    const bf16x8 ones = {0x3F80, 0x3F80, 0x3F80, 0x3F80, 0x3F80, 0x3F80, 0x3F80, 0x3F80};
    const bf16* Qw = Qb + (long)(wid * QBLK + r32) * LDQ + hi * 8;
    __syncthreads();
#pragma unroll
    for (int d0 = 0; d0 < 8; ++d0) qr[d0] = *reinterpret_cast<const bf16x8*>(Qw + d0 * 16);
    if constexpr (DQK == 192) {
#pragma unroll
        for (int d0 = 8; d0 < 12; ++d0) *reinterpret_cast<bf16x8*>(QR_lds + (d0 - 8) * 1024) = *reinterpret_cast<const bf16x8*>(Qw + d0 * 16);
    }
    const int sr = tid >> 4, sc = (tid & 15) * 8, vst0 = v_st(sr, sc), vst1 = v_st(32 + sr, sc);
    int ksrc[NKC], kdst[NKC];
#pragma unroll
    for (int i = 0; i < NKC; ++i) { const int c = tid + 512 * i, kr = c / KCH, kc = (c % KCH) * 8; ksrc[i] = kr * LDK + kc; kdst[i] = kr * ROWB + ((kc * 2) ^ kswz<DQK>(kr)); }
    const int vb0 = (int)(uintptr_t)V_lds + v_rd_base(lane);
    bf16x8 vs0, vs1, ks[NKC];
#define SLOAD(k0) do { vs0 = *reinterpret_cast<const bf16x8*>(&Vh[(long)((k0) + sr) * LDV + sc]); vs1 = *reinterpret_cast<const bf16x8*>(&Vh[(long)((k0) + 32 + sr) * LDV + sc]); \
    _Pragma("unroll") for (int q_ = 0; q_ < NKC; ++q_) ks[q_] = *reinterpret_cast<const bf16x8*>(&Kh[(long)(k0) * LDK + ksrc[q_]]); } while (0)
#define SWRITE(kb, vslot) do { *(bf16x8*)(V_lds + (vslot) * SHM_V + vst0) = vs0; *(bf16x8*)(V_lds + (vslot) * SHM_V + vst1) = vs1; \
    _Pragma("unroll") for (int q_ = 0; q_ < NKC; ++q_) *(bf16x8*)(K_lds + (kb) * SHM_K + kdst[q_]) = ks[q_]; } while (0)
    const int NT = seq / KVBLK;
    SLOAD(0); SWRITE(0, 0); SLOAD(KVBLK);
    __syncthreads();
    int vcur = 0, vnext = 1, vprev = 2;
    bf16x8 pa0, pa1, pa2, pa3;
    pa0 = bf16x8{}; pa1 = bf16x8{}; pa2 = bf16x8{}; pa3 = bf16x8{};
    for (int j = 0; j < NT; ++j) {
        const int b = j & 1;
        f32x16 p0, p1; float mn, al;
        if (late && j > 0) { pv_d0(o, vb0 + vprev * (int)SHM_V, pa0, pa1, pa2, pa3); }
        SBAR(); qkt<DQK>(p0, p1, K_lds + b * SHM_K, qr, QR_lds, r32, hi, negm);
        if ((PROBE_ATT & 1) && dup) { mn = 0.f; al = 1.f; } else
        partialSM2(p0, p1, m_reg, negm, al); SBAR();
        if (!((PROBE_ATT & 4) && dup)) {
        if (j + 1 < NT) { SWRITE(b ^ 1, vnext); }
        if (j + 2 < NT) { SLOAD((j + 2) * KVBLK); } }
        SBAR();
        if (__any(al < 1.f)) { if (hi == 0) al_l[r32] = al; asm volatile("s_waitcnt lgkmcnt(0)" ::: "memory");
#pragma unroll
            for (int d = 0; d < 4; ++d)
#pragma unroll
                for (int r = 0; r < 16; ++r) o[d][r] *= al_l[crow(r, hi)];
#pragma unroll
            for (int r = 0; r < 16; ++r) lsum[r] *= al_l[crow(r, hi)]; }
        if ((PROBE_ATT & 1) && dup) { pa0 = __builtin_bit_cast(bf16x8, (u32x4){cvt_pk_bf16(p0[0], p0[1]), cvt_pk_bf16(p0[2], p0[3]), cvt_pk_bf16(p0[4], p0[5]), cvt_pk_bf16(p0[6], p0[7])});
            pa1 = __builtin_bit_cast(bf16x8, (u32x4){cvt_pk_bf16(p0[8], p0[9]), cvt_pk_bf16(p0[10], p0[11]), cvt_pk_bf16(p0[12], p0[13]), cvt_pk_bf16(p0[14], p0[15])});
            pa2 = __builtin_bit_cast(bf16x8, (u32x4){cvt_pk_bf16(p1[0], p1[1]), cvt_pk_bf16(p1[2], p1[3]), cvt_pk_bf16(p1[4], p1[5]), cvt_pk_bf16(p1[6], p1[7])});
            pa3 = __builtin_bit_cast(bf16x8, (u32x4){cvt_pk_bf16(p1[8], p1[9]), cvt_pk_bf16(p1[10], p1[11]), cvt_pk_bf16(p1[12], p1[13]), cvt_pk_bf16(p1[14], p1[15])}); } else
        finishSM2(p0, p1, pa0, pa1, pa2, pa3); SBAR();
        lsum = __builtin_amdgcn_mfma_f32_32x32x16_bf16(pa0, ones, lsum, 0, 0, 0); lsum = __builtin_amdgcn_mfma_f32_32x32x16_bf16(pa1, ones, lsum, 0, 0, 0);
        lsum = __builtin_amdgcn_mfma_f32_32x32x16_bf16(pa2, ones, lsum, 0, 0, 0); lsum = __builtin_amdgcn_mfma_f32_32x32x16_bf16(pa3, ones, lsum, 0, 0, 0);
        if (!late && !((PROBE_ATT & 2) && dup)) { pv_d0(o, vb0 + vcur * (int)SHM_V, pa0, pa1, pa2, pa3); }
        if (!((PROBE_ATT & 8) && dup)) __syncthreads();
        { const int t = vprev; vprev = vcur; vcur = vnext; vnext = t; }
    }
    if (late) { pv_d0(o, vb0 + vprev * (int)SHM_V, pa0, pa1, pa2, pa3); }
    float rli[16];
#pragma unroll
    for (int r = 0; r < 16; ++r) rli[r] = __builtin_amdgcn_rcpf(lsum[r]);
    bf16* Ow = Ob + (long)(wid * QBLK) * LDO;
#pragma unroll
    for (int r = 0; r < 16; ++r) { const int orow = crow(r, hi);
#pragma unroll
        for (int d0 = 0; d0 < 4; ++d0) Ow[(long)orow * LDO + d0 * 32 + r32] = f2bf(o[d0][r] * rli[r]); }
#undef SLOAD
#undef SWRITE
}
#undef SBAR
}

struct Args { const float* in[28]; float* out; unsigned char* ws; int ph_lo, ph_hi, coop, pad; };
typedef const __attribute__((address_space(4))) Args CArgs;
enum { I_X = 0, I_C, I_CTX, I_CCTX, I_WMOD, I_BMOD, I_N1G, I_N2G, I_WIN, I_AQN, I_AKN, I_BQLN, I_BKVLN, I_WUQ, I_WUKV, I_BQNN, I_BKNN, I_BQRN, I_BKRN,
       I_WGKF, I_BGKF, I_WGKB, I_BGKB, I_CON, I_WOUT, I_WGATE, I_WUP, I_WDOWN };

__device__ __forceinline__ unsigned pk2(float lo, float hi) { return cvt_pk_bf16(lo, hi); }
struct TrDesc { const float* W; bf16_t* WT; int K, N, grp, gstride, off, item; };
__device__ __forceinline__ void tr_load(const TrDesc& t, f32x4 (&v)[16], int lane) {
    const int nblk = (t.N + 63) / 64, kb = t.item / nblk, nb = t.item % nblk, k0 = 64 * kb, n0 = 64 * nb;
    const int kr = lane >> 4, c = lane & 15; const bool valid = n0 + 4 * c < t.N;
#pragma unroll
    for (int i = 0; i < 16; ++i) v[i] = valid ? *(const f32x4*)(t.W + (size_t)(k0 + 4 * i + kr) * t.N + n0 + 4 * c) : (f32x4){0.f, 0.f, 0.f, 0.f};
}
__device__ __forceinline__ void tr_store(const TrDesc& t, const f32x4 (&v)[16], LAS float* scr, int lane) {
    const int nblk = (t.N + 63) / 64, kb = t.item / nblk, nb = t.item % nblk, k0 = 64 * kb, n0 = 64 * nb;
    const int drow0 = (n0 / t.grp) * t.gstride + (n0 % t.grp) + t.off;
    const int kr = lane >> 4, c = lane & 15;
#pragma unroll
    for (int i = 0; i < 16; ++i) { LAS float* p = scr + (4 * i + kr) * 65 + 4 * c; p[0] = v[i].x; p[1] = v[i].y; p[2] = v[i].z; p[3] = v[i].w; }
    asm volatile("s_waitcnt lgkmcnt(0)" ::: "memory");
    const int c8 = lane & 7, nl = lane >> 3;
#pragma unroll
    for (int j = 0; j < 8; ++j) { const int n = nl + 8 * j; const LAS float* s = scr + (8 * c8) * 65 + n;
        u32x4 o; o.x = pk2(s[0 * 65], s[1 * 65]); o.y = pk2(s[2 * 65], s[3 * 65]); o.z = pk2(s[4 * 65], s[5 * 65]); o.w = pk2(s[6 * 65], s[7 * 65]);
        if (n0 + n < t.N) *(u32x4*)(t.WT + (size_t)(drow0 + n) * t.K + k0 + 8 * c8) = o; }
    asm volatile("s_waitcnt lgkmcnt(0)" ::: "memory");
}
constexpr int TR_IN = 32 * 62, TR_UQ = 8 * 12, TR_UKV = 4 * 16, TR_OUT = 32 * 32, TR_G = 32 * 88, TR_D = 88 * 32, TR_L = TR_IN + TR_UQ + TR_UKV + TR_OUT + 2 * TR_G + TR_D;
__device__ __forceinline__ TrDesc tr_decode(CArgs& a, int it) {
    constexpr int BIG = 1 << 30;
    const int l = it / TR_L; int r = it % TR_L;
    unsigned char* wb = a.ws + WS_W + (size_t)l * W_LAYER;
    if (r < TR_IN) return TrDesc{a.in[I_WIN] + (size_t)l * DM * INC, (bf16_t*)(wb + WO_IN), DM, INC, BIG, 0, 0, r}; r -= TR_IN;
    if (r < TR_UQ) return TrDesc{a.in[I_WUQ] + (size_t)l * 512 * 768, (bf16_t*)(wb + WO_UQ), 512, 768, BIG, 0, 0, r}; r -= TR_UQ;
    if (r < TR_UKV) return TrDesc{a.in[I_WUKV] + (size_t)l * 256 * 1024, (bf16_t*)(wb + WO_UKV), 256, 1024, BIG, 0, 0, r}; r -= TR_UKV;
    if (r < TR_OUT) return TrDesc{a.in[I_WOUT] + (size_t)l * DM * DM, (bf16_t*)(wb + WO_OUT), DM, DM, BIG, 0, 0, r}; r -= TR_OUT;
    if (r < TR_G) return TrDesc{a.in[I_WGATE] + (size_t)l * DM * DFF, (bf16_t*)(wb + WO_GU), DM, DFF, 128, 256, 0, r}; r -= TR_G;
    if (r < TR_G) return TrDesc{a.in[I_WUP] + (size_t)l * DM * DFF, (bf16_t*)(wb + WO_GU), DM, DFF, 128, 256, 128, r}; r -= TR_G;
    return TrDesc{a.in[I_WDOWN] + (size_t)l * DFF * DM, (bf16_t*)(wb + WO_DN), DFF, DM, BIG, 0, 0, r};
}
__device__ __forceinline__ void transposes_dynamic(CArgs& a, LAS unsigned char* lds, int layer) {
    int tid = threadIdx.x; asm volatile("" : "+v"(tid));
    const int lane = tid & 63, wid = tid >> 6;
    LAS float* scr = (LAS float*)(lds + wid * 16640);
    unsigned* ctr = (unsigned*)(a.ws + WS_CTL) + CW_QUEUE + 128 + 64 * layer;
    for (;;) {
        unsigned base = 0; if (lane == 0) base = atomicAdd(ctr, 2u);
        const int it = __builtin_amdgcn_readfirstlane(base);
        if (it >= TR_L) break;
        const bool two = it + 1 < TR_L;
        const TrDesc t0 = tr_decode(a, layer * TR_L + it), t1 = tr_decode(a, layer * TR_L + (two ? it + 1 : it));
        f32x4 v0[16], v1[16];
        tr_load(t0, v0, lane); tr_load(t1, v1, lane);
        tr_store(t0, v0, scr, lane);
        if (two) tr_store(t1, v1, scr, lane);
    }
}
__device__ __forceinline__ void phase_prologue(CArgs& a, LAS unsigned char* lds) {
    int tid = threadIdx.x; asm volatile("" : "+v"(tid));
    const int lane = tid & 63, wid = tid >> 6;
    LAS float* scr = (LAS float*)(lds + wid * 16384);
    const int gw = blockIdx.x * 8 + wid, NGW = gridDim.x * 8;
    float* MOD = (float*)(a.ws + WS_MOD);
    for (int it = blockIdx.x; it < 2 * 96; it += gridDim.x) {
        const int l = it / 96, jb = it % 96;
        __syncthreads();
#pragma unroll
        for (int q = 0; q < 4; ++q) { const int k = wid * 256 + q * 64 + lane;
#pragma unroll
            for (int v = 0; v < 5; ++v) { const float cv = (v < 4) ? a.in[I_C][v * DM + k] : a.in[I_CCTX][k]; scr[v * 256 + q * 64 + lane] = silu_f(cv); } }
        asm volatile("s_waitcnt lgkmcnt(0)" ::: "memory");
        const float* W = a.in[I_WMOD] + (size_t)l * DM * 12288 + (size_t)(wid * 256) * 12288 + jb * 128 + lane * 2;
        f32x2 acc[5];
#pragma unroll
        for (int v = 0; v < 5; ++v) acc[v] = (f32x2){0.f, 0.f};
        for (int k0 = 0; k0 < 256; k0 += 64) { f32x2 wv[64];
#pragma unroll
            for (int e = 0; e < 64; ++e) wv[e] = *(const f32x2*)(W + (size_t)(k0 + e) * 12288);
#pragma unroll
            for (int e = 0; e < 64; ++e) { const int kk = k0 + e; const f32x2 w = wv[e];
#pragma unroll
            for (int v = 0; v < 5; ++v) acc[v] += scr[v * 256 + kk] * w; } }
#pragma unroll
        for (int v = 0; v < 5; ++v) *(LAS f32x2*)(scr + 2048 + v * 128 + lane * 2) = acc[v];
        __syncthreads();
        if (wid < 5) { f32x2 sum = *(const f32x2*)(a.in[I_BMOD] + l * 12288 + jb * 128 + lane * 2);
#pragma unroll
            for (int w = 0; w < 8; ++w) sum += *(const LAS f32x2*)((LAS float*)(lds + w * 16384) + 2048 + wid * 128 + lane * 2);
            *(f32x2*)(MOD + (size_t)(l * 5 + wid) * 12288 + jb * 128 + lane * 2) = sum; }
    }
    __syncthreads();
    transposes_dynamic(a, lds, 0); transposes_dynamic(a, lds, 1);
    for (int l = 0; l < 2; ++l) { u32x4* z = (u32x4*)(a.ws + WS_W + (size_t)l * W_LAYER + WO_IN + (size_t)INC * DM * 2);
        for (int i = blockIdx.x * 512 + tid; i < (INP - INC) * DM * 2 / 16; i += gridDim.x * 512) z[i] = (u32x4){0u, 0u, 0u, 0u}; }
}

__device__ __forceinline__ void phase_norm(CArgs& a, int l, int which) {
    int tid = threadIdx.x; asm volatile("" : "+v"(tid));
    const int lane = tid & 63, wid = tid >> 6;
    const int gw = blockIdx.x * 8 + wid, NGW = gridDim.x * 8;
    const float* MOD = (const float*)(a.ws + WS_MOD) + (size_t)l * 5 * 12288;
    const float* MOD0 = (const float*)(a.ws + WS_MOD);
    const float* gn = a.in[which ? I_N2G : I_N1G] + l * DM;
    float* XR = (float*)(a.ws + WS_XR);
    const float* PART = (const float*)a.out + PART_OFF;
    bf16_t* H = (bf16_t*)(a.ws + WS_HZ);
    const bool skip = (l == 1 && which == 1);
    const int npart = (l == 0 && which == 1) ? 8 : ((l == 1 && which == 0) ? 4 : 0);
    for (int r0 = gw; r0 < NR; r0 += 2 * NGW) {
        f32x4 x[2][8]; const float* sh[2]; const float* sc[2]; bool ok[2];
#pragma unroll
        for (int u = 0; u < 2; ++u) { const int r = r0 + u * NGW; ok[u] = r < NR; const int rr = ok[u] ? r : r0;
            const int b = rr / TOK, i = rr - b * TOK, v = (i < CTXL) ? 4 : b;
            if (skip && i < CTXL) ok[u] = false;
            const bool first = (l == 0 && which == 0), ctxsplit = (npart == 8 && i < CTXL);
            const float* src = (first || ctxsplit) ? (i < CTXL ? a.in[I_CTX] + ((size_t)b * CTXL + i) * DM : a.in[I_X] + ((size_t)b * SEQ + (i - CTXL)) * DM) : XR + (size_t)rr * DM;
            sh[u] = MOD + (size_t)v * 12288 + (which * 3 + 0) * DM; sc[u] = MOD + (size_t)v * 12288 + (which * 3 + 1) * DM;
#pragma unroll
            for (int j = 0; j < 8; ++j) x[u][j] = *(const f32x4*)(src + 4 * lane + 256 * j);
            if (npart && i < CTXL) {
                const float* gt = MOD0 + (size_t)4 * 12288 + (npart == 8 ? 2 : 5) * DM;
                f32x4 ps[8];
#pragma unroll
                for (int j = 0; j < 8; ++j) ps[j] = (f32x4){0.f, 0.f, 0.f, 0.f};
                for (int p = 0; p < npart; ++p)
#pragma unroll
                    for (int j = 0; j < 8; ++j) ps[j] += *(const f32x4*)(PART + ((size_t)(p * 32 + b * 8 + j) << 16) + i * 256 + 4 * lane);
#pragma unroll
                for (int j = 0; j < 8; ++j) { x[u][j] += *(const f32x4*)(gt + 4 * lane + 256 * j) * ps[j]; *(f32x4*)(XR + (size_t)rr * DM + 4 * lane + 256 * j) = x[u][j]; }
            } }
#pragma unroll
        for (int u = 0; u < 2; ++u) { float ss = 0.f;
#pragma unroll
            for (int j = 0; j < 8; ++j) ss += (x[u][j].x * x[u][j].x + x[u][j].y * x[u][j].y) + (x[u][j].z * x[u][j].z + x[u][j].w * x[u][j].w);
            const float rs = rsqrtf(wave_sum(ss) * (1.f / DM) + EPS);
            if (!ok[u]) continue;
            bf16_t* o = H + (size_t)(r0 + u * NGW) * DM;
#pragma unroll
            for (int j = 0; j < 8; ++j) { const int c = 4 * lane + 256 * j; const f32x4 g = *(const f32x4*)(gn + c), s1 = *(const f32x4*)(sc[u] + c), s0 = *(const f32x4*)(sh[u] + c);
                const f32x4 y = (x[u][j] * rs) * g * (1.f + s1) + s0;
                u32x2 w; w.x = cvt_pk_bf16(y.x, y.y); w.y = cvt_pk_bf16(y.z, y.w); *(u32x2*)(o + c) = w; } }
    }
}

__device__ __forceinline__ void rope128(float& y0, float& y1, int lane, int prow, int pcol) {
    const float pos = (float)(lane < 32 ? prow : pcol);
    const int i0 = (2 * lane) & 31;
    const float f0 = __builtin_amdgcn_exp2f(-(float)i0 * (13.287712379549449f / 32.f)), f1 = __builtin_amdgcn_exp2f(-(float)(i0 + 1) * (13.287712379549449f / 32.f));
    const float a0 = pos * f0, a1 = pos * f1;
    const float c0 = __cosf(a0), s0 = __sinf(a0), c1 = __cosf(a1), s1 = __sinf(a1);
    const float p0 = __shfl_xor(y0, 16), p1 = __shfl_xor(y1, 16);
    if (((lane >> 4) & 1) == 0) { y0 = y0 * c0 - p0 * s0; y1 = y1 * c1 - p1 * s1; }
    else { y0 = p0 * s0 + y0 * c0; y1 = p1 * s1 + y1 * c1; }
}
__device__ __forceinline__ void rope64(float& y0, float& y1, int lane, int prow, int pcol) {
    const int l = lane & 31;
    const float pos = (float)(l < 16 ? prow : pcol);
    const int i0 = (2 * l) & 15;
    const float f0 = __builtin_amdgcn_exp2f(-(float)i0 * (13.287712379549449f / 16.f)), f1 = __builtin_amdgcn_exp2f(-(float)(i0 + 1) * (13.287712379549449f / 16.f));
    const float a0 = pos * f0, a1 = pos * f1;
    const float c0 = __cosf(a0), s0 = __sinf(a0), c1 = __cosf(a1), s1 = __sinf(a1);
    const float p0 = __shfl_xor(y0, 8), p1 = __shfl_xor(y1, 8);
    if (((l >> 3) & 1) == 0) { y0 = y0 * c0 - p0 * s0; y1 = y1 * c1 - p1 * s1; }
    else { y0 = p0 * s0 + y0 * c0; y1 = p1 * s1 + y1 * c1; }
}

struct E1Regs { u32x4 hq[3]; u32x4 cqw; u32x2 ckw; unsigned krw; };
__device__ __forceinline__ void e1_load(CArgs& a, int r, int lane, E1Regs& g) {
    const bf16_t* P0 = (const bf16_t*)(a.ws + WS_PROJ) + (size_t)r * INP;
#pragma unroll
    for (int t = 0; t < 3; ++t) g.hq[t] = *((const u32x4*)(P0 + t * 512) + lane);
    g.cqw = *((const u32x4*)(P0 + C_BCQ) + lane);
    g.ckw = *((const u32x2*)(P0 + C_BCKV) + lane);
    g.krw = *((const unsigned*)(P0 + C_BKR) + (lane & 31));
}
__device__ __forceinline__ void e1_row(CArgs& a, int l, int r, int lane, int dup, const E1Regs& g) {
    bf16_t* P0 = (bf16_t*)(a.ws + WS_PROJ) + (size_t)r * INP;
    bf16_t* P = dup ? (bf16_t*)((float*)a.out + (10u << 20)) + (size_t)r * 2368 : P0;
    const int i = r % TOK; const bool lat = i >= CTXL; const int n = i - CTXL, prow = n >> 6, pcol = n & 63;
    { const int li = lane & 15, hsub = lane >> 4;
      const float pos = (float)(li < 8 ? prow : pcol); const bool second = ((li >> 2) & 1) != 0;
      float cs[8], sn[8];
      if (lat) {
#pragma unroll
          for (int e = 0; e < 8; ++e) { const float ang = pos * __builtin_amdgcn_exp2f(-(float)(8 * (li & 3) + e) * (13.287712379549449f / 32.f)); cs[e] = __cosf(ang); sn[e] = __sinf(ang); } }
#pragma unroll
      for (int t = 0; t < 3; ++t) { const int hh = 4 * t + hsub; const u32x4 w = g.hq[t];
          float x[8] = {bflo(w.x), bfhi(w.x), bflo(w.y), bfhi(w.y), bflo(w.z), bfhi(w.z), bflo(w.w), bfhi(w.w)};
          float ss = 0.f;
#pragma unroll
          for (int e = 0; e < 8; ++e) ss += x[e] * x[e];
#pragma unroll
          for (int m = 1; m < 16; m <<= 1) ss += __shfl_xor(ss, m);
          const float rs = rsqrtf(ss * (1.f / 128.f) + EPS) * (hh < 8 ? QSCALE_A : 1.f);
          const float* gg = a.in[hh < 8 ? I_AQN : I_AKN] + l * 128 + 8 * li;
          const f32x4 ga = *(const f32x4*)gg, gb = *(const f32x4*)(gg + 4);
          float y[8] = {x[0] * rs * ga.x, x[1] * rs * ga.y, x[2] * rs * ga.z, x[3] * rs * ga.w, x[4] * rs * gb.x, x[5] * rs * gb.y, x[6] * rs * gb.z, x[7] * rs * gb.w};
          if (lat) {
#pragma unroll
              for (int e = 0; e < 8; ++e) { const float p = __shfl_xor(y[e], 4); y[e] = second ? (p * sn[e] + y[e] * cs[e]) : (y[e] * cs[e] - p * sn[e]); } }
          u32x4 o; o.x = cvt_pk_bf16(y[0], y[1]); o.y = cvt_pk_bf16(y[2], y[3]); o.z = cvt_pk_bf16(y[4], y[5]); o.w = cvt_pk_bf16(y[6], y[7]);
          if (hh < 10) *((u32x4*)(P + t * 512) + lane) = o; } }
    { const u32x4 w = g.cqw;
        float x[8] = {bflo(w.x), bfhi(w.x), bflo(w.y), bfhi(w.y), bflo(w.z), bfhi(w.z), bflo(w.w), bfhi(w.w)};
        float ss = 0.f;
#pragma unroll
        for (int e = 0; e < 8; ++e) ss += x[e] * x[e];
        const float rs = rsqrtf(wave_sum(ss) * (1.f / 512.f) + EPS);
        const float* gg = a.in[I_BQLN] + l * 512 + 8 * lane;
        u32x4 o; o.x = cvt_pk_bf16(x[0] * rs * gg[0], x[1] * rs * gg[1]); o.y = cvt_pk_bf16(x[2] * rs * gg[2], x[3] * rs * gg[3]);
        o.z = cvt_pk_bf16(x[4] * rs * gg[4], x[5] * rs * gg[5]); o.w = cvt_pk_bf16(x[6] * rs * gg[6], x[7] * rs * gg[7]); *((u32x4*)(P + C_BCQ) + lane) = o;
    }
    { const u32x2 w = g.ckw;
        float x[4] = {bflo(w.x), bfhi(w.x), bflo(w.y), bfhi(w.y)};
        const float rs = rsqrtf(wave_sum(x[0] * x[0] + x[1] * x[1] + x[2] * x[2] + x[3] * x[3]) * (1.f / 256.f) + EPS);
        const float* gg = a.in[I_BKVLN] + l * 256 + 4 * lane;
        u32x2 o; o.x = cvt_pk_bf16(x[0] * rs * gg[0], x[1] * rs * gg[1]); o.y = cvt_pk_bf16(x[2] * rs * gg[2], x[3] * rs * gg[3]); *((u32x2*)(P + C_BCKV) + lane) = o;
    }
    { const unsigned w = g.krw;
        float x0 = lane < 32 ? bflo(w) : 0.f, x1 = lane < 32 ? bfhi(w) : 0.f;
        const float rs = rsqrtf(wave_sum(x0 * x0 + x1 * x1) * (1.f / 64.f) + EPS);
        const float* gg = a.in[I_BKRN] + l * 64 + 2 * (lane & 31);
        float y0 = x0 * rs * gg[0], y1 = x1 * rs * gg[1];
        if (lat) rope64(y0, y1, lane, prow, pcol);
        if (lane < 32) *((unsigned*)(P + C_BKR) + lane) = cvt_pk_bf16(y0, y1);
    }
}
struct E2Regs { u32x4 qn, qr, kn, kr; };
__device__ __forceinline__ void e2_load(CArgs& a, int r, int lane, E2Regs& g) {
    const bf16_t* Q0 = (const bf16_t*)(a.ws + WS_QB) + (size_t)r * 768;
    const bf16_t* KV = (const bf16_t*)(a.ws + WS_KVB) + (size_t)r * 1024;
    const bf16_t* P = (const bf16_t*)(a.ws + WS_PROJ) + (size_t)r * INP;
    const int h16 = lane >> 4, li = lane & 15, h8 = (lane >> 3) & 3, li8 = lane & 7;
    g.qn = *(const u32x4*)(Q0 + h16 * 192 + 8 * li);
    g.qr = *(const u32x4*)(Q0 + h8 * 192 + 128 + 8 * li8);
    g.kn = *(const u32x4*)(KV + h16 * 256 + 8 * li);
    g.kr = *(const u32x4*)(P + C_BKR + 8 * li8);
}
__device__ __forceinline__ void e2_row(CArgs& a, int l, int r, int lane, int dup, const E2Regs& g) {
    bf16_t* Q = dup ? (bf16_t*)((float*)a.out + (10u << 20)) + (size_t)r * 768 : (bf16_t*)(a.ws + WS_QB) + (size_t)r * 768;
    bf16_t* KB = dup ? (bf16_t*)((float*)a.out + (18u << 20)) + (size_t)r * 768 : (bf16_t*)(a.ws + WS_KB) + (size_t)r * 768;
    const int i = r % TOK; const bool lat = i >= CTXL; const int n = i - CTXL, prow = n >> 6, pcol = n & 63;
    const int h16 = lane >> 4, li = lane & 15, h8 = (lane >> 3) & 3, li8 = lane & 7;
#define E2_UNPK(wv_, arr_) float arr_[8] = {bflo(wv_[0]), bfhi(wv_[0]), bflo(wv_[1]), bfhi(wv_[1]), bflo(wv_[2]), bfhi(wv_[2]), bflo(wv_[3]), bfhi(wv_[3])}
    { E2_UNPK(g.qn, x); float ss = 0.f;
#pragma unroll
      for (int e = 0; e < 8; ++e) ss += x[e] * x[e];
#pragma unroll
      for (int m = 1; m < 16; m <<= 1) ss += __shfl_xor(ss, m);
      const float rs = rsqrtf(ss * (1.f / 128.f) + EPS) * QSCALE_B;
      const float* gg = a.in[I_BQNN] + l * 128 + 8 * li; const f32x4 ga = *(const f32x4*)gg, gb = *(const f32x4*)(gg + 4);
      u32x4 o; o.x = cvt_pk_bf16(x[0] * rs * ga.x, x[1] * rs * ga.y); o.y = cvt_pk_bf16(x[2] * rs * ga.z, x[3] * rs * ga.w);
      o.z = cvt_pk_bf16(x[4] * rs * gb.x, x[5] * rs * gb.y); o.w = cvt_pk_bf16(x[6] * rs * gb.z, x[7] * rs * gb.w);
      *(u32x4*)(Q + h16 * 192 + 8 * li) = o; }
    { E2_UNPK(g.qr, x); float ss = 0.f;
#pragma unroll
      for (int e = 0; e < 8; ++e) ss += x[e] * x[e];
#pragma unroll
      for (int m = 1; m < 8; m <<= 1) ss += __shfl_xor(ss, m);
      const float rs = rsqrtf(ss * (1.f / 64.f) + EPS) * QSCALE_B;
      const float* gg = a.in[I_BQRN] + l * 64 + 8 * li8; const f32x4 ga = *(const f32x4*)gg, gb = *(const f32x4*)(gg + 4);
      float y[8] = {x[0] * rs * ga.x, x[1] * rs * ga.y, x[2] * rs * ga.z, x[3] * rs * ga.w, x[4] * rs * gb.x, x[5] * rs * gb.y, x[6] * rs * gb.z, x[7] * rs * gb.w};
      if (lat) { const float pos = (float)(li8 < 4 ? prow : pcol); const bool second = ((li8 >> 1) & 1) != 0;
#pragma unroll
          for (int e = 0; e < 8; ++e) { const float ang = pos * __builtin_amdgcn_exp2f(-(float)(8 * (li8 & 1) + e) * (13.287712379549449f / 16.f));
              const float c = __cosf(ang), sn = __sinf(ang), p = __shfl_xor(y[e], 2); y[e] = second ? (p * sn + y[e] * c) : (y[e] * c - p * sn); } }
      u32x4 o; o.x = cvt_pk_bf16(y[0], y[1]); o.y = cvt_pk_bf16(y[2], y[3]); o.z = cvt_pk_bf16(y[4], y[5]); o.w = cvt_pk_bf16(y[6], y[7]);
      if (lane < 32) { *(u32x4*)(Q + h8 * 192 + 128 + 8 * li8) = o; *(u32x4*)(KB + h8 * 192 + 128 + 8 * li8) = g.kr; } }
    { E2_UNPK(g.kn, x); float ss = 0.f;
#pragma unroll
      for (int e = 0; e < 8; ++e) ss += x[e] * x[e];
#pragma unroll
      for (int m = 1; m < 16; m <<= 1) ss += __shfl_xor(ss, m);
      const float rs = rsqrtf(ss * (1.f / 128.f) + EPS);
      const float* gg = a.in[I_BKNN] + l * 128 + 8 * li; const f32x4 ga = *(const f32x4*)gg, gb = *(const f32x4*)(gg + 4);
      u32x4 o; o.x = cvt_pk_bf16(x[0] * rs * ga.x, x[1] * rs * ga.y); o.y = cvt_pk_bf16(x[2] * rs * ga.z, x[3] * rs * ga.w);
      o.z = cvt_pk_bf16(x[4] * rs * gb.x, x[5] * rs * gb.y); o.w = cvt_pk_bf16(x[6] * rs * gb.z, x[7] * rs * gb.w);
      *(u32x4*)(KB + h16 * 192 + 8 * li) = o; }
#undef E2_UNPK
}

constexpr int GS = 65, GA = 64 * GS;
constexpr int GL_QF = 0, GL_QB = GA, GL_CGF = 33664, GL_CGB = 34688, GL_WF = 35712, GL_WB = 36736, GL_BF = 37760, GL_BB = 37824, GL_END = 37888;
constexpr int GB_QDF = 33280, GB_QDB = 42496, GB_KDF = 51712, GB_KDB = 60928, GB_VT = 70144, GB_ATT = 88576, GB_SFT = 97792, GB_SBT = 116224;
constexpr int HS = 72;
static_assert(GL_END * 4 <= LDS_QWORD && GB_SBT + 128 * HS * 2 <= GL_CGF * 4, "GLA LDS");
__device__ __forceinline__ bf16x8 ldfrag(const LAS unsigned char* base, int row, int ks, int hi) { return *(const LAS bf16x8*)(base + row * (HS * 2) + ks * 32 + hi * 16); }
__device__ __forceinline__ int crow16(int r, int hi) { return (r & 3) + 8 * (r >> 2) + 4 * hi; }
__device__ __forceinline__ float logsig(float x) { return fminf(x, 0.f) - __logf(1.f + __expf(-fabsf(x))); }
__device__ __forceinline__ float wave_incl_scan(float x, int lane) {
#pragma unroll
    for (int o = 1; o < 64; o <<= 1) { const float t = __shfl_up(x, o); if (lane >= o) x += t; }
    return x;
}
__device__ __forceinline__ void gla_store_vt(const u32x4 v0, const u32x4 v1, LAS unsigned char* B, int wid, int lane) {
    const unsigned w[8] = {v0.x, v0.y, v0.z, v0.w, v1.x, v1.y, v1.z, v1.w};
#pragma unroll
    for (int q = 0; q < 8; ++q) { const int e = 16 * wid + 2 * q;
        *(LAS unsigned short*)(B + GB_VT + (e * HS + lane) * 2) = (unsigned short)(w[q] & 0xffffu); *(LAS unsigned short*)(B + GB_VT + ((e + 1) * HS + lane) * 2) = (unsigned short)(w[q] >> 16); }
}
__device__ __forceinline__ void gla_p1(CArgs& a, int l, int cc, int h, LAS float* L, int dup, bool stagew) {
    int tid = threadIdx.x; asm volatile("" : "+v"(tid));
    LAS unsigned char* B = (LAS unsigned char*)L;
    const int wid = __builtin_amdgcn_readfirstlane(tid >> 6), lane = tid & 63;
    const bf16_t* Pj = (const bf16_t*)(a.ws + WS_PROJ) + (size_t)(cc * 64 + lane) * INP;
    float* KVS = (float*)(a.ws + WS_KVS); float* DEC = (float*)(a.ws + WS_DEC);
    bf16_t* GQ = (bf16_t*)a.out + (size_t)(cc * 4 + h) * 16384;
    const int slot = (cc * 4 + h) * 2;
    const bf16_t* Pw = (const bf16_t*)(a.ws + WS_PROJ) + (size_t)(cc * 64 + 8 * wid) * INP;
    const int lr8 = lane >> 3, lc8 = lane & 7;
    const u32x4 cgx = *(const u32x4*)(Pw + (size_t)((lane >> 2) & 7) * INP + C_CGF + (lane & 3) * 8);
    const u32x4 kx = *(const u32x4*)(Pw + (size_t)lr8 * INP + C_CK + h * 64 + lc8 * 8), qx = *(const u32x4*)(Pw + (size_t)lr8 * INP + C_CQ + h * 64 + lc8 * 8);
    const u32x4 v0 = *(const u32x4*)(Pj + C_CV + h * 128 + 16 * wid), v1 = *(const u32x4*)(Pj + C_CV + h * 128 + 16 * wid + 8);
    __syncthreads();
    { LAS unsigned char* S = B + GB_SFT;
      if (lane < 32) *(LAS u32x4*)(S + (8 * wid + (lane >> 2)) * 64 + (lane & 3) * 16) = cgx;
      *(LAS u32x4*)(S + 4096 + (8 * wid + lr8) * 128 + lc8 * 16) = kx; *(LAS u32x4*)(S + 12288 + (8 * wid + lr8) * 128 + lc8 * 16) = qx; }
    if (stagew) {
    for (int i = tid; i < 2048; i += 512) { const int dir = i >> 10, r = (i >> 6) & 15, d = i & 63; L[(dir ? GL_WB : GL_WF) + d * 16 + r] = a.in[dir ? I_WGKB : I_WGKF][(size_t)l * 16 * 256 + r * 256 + h * 64 + d]; }
    if (tid < 128) { const int dir = tid >> 6, d = tid & 63; L[(dir ? GL_BB : GL_BF) + d] = a.in[dir ? I_BGKB : I_BGKF][l * 256 + h * 64 + d]; } }
    gla_store_vt(v0, v1, B, wid, lane);
    __syncthreads();
    if (PROBE_CUT == 1 && dup) return;
    float cgf[16], cgb[16];
    const LAS unsigned char* S = B + GB_SFT;
    const u32x4 g0 = *(const LAS u32x4*)(S + lane * 64), g1 = *(const LAS u32x4*)(S + lane * 64 + 16), g2 = *(const LAS u32x4*)(S + lane * 64 + 32), g3 = *(const LAS u32x4*)(S + lane * 64 + 48);
    const u32x4 k8 = *(const LAS u32x4*)(S + 4096 + lane * 128 + wid * 16), q8 = *(const LAS u32x4*)(S + 12288 + lane * 128 + wid * 16);
    { const unsigned wf[8] = {g0.x, g0.y, g0.z, g0.w, g1.x, g1.y, g1.z, g1.w}, wb[8] = {g2.x, g2.y, g2.z, g2.w, g3.x, g3.y, g3.z, g3.w};
#pragma unroll
      for (int q = 0; q < 8; ++q) { cgf[2 * q] = bflo(wf[q]); cgf[2 * q + 1] = bfhi(wf[q]); cgb[2 * q] = bflo(wb[q]); cgb[2 * q + 1] = bfhi(wb[q]); } }
    const unsigned kw[4] = {k8.x, k8.y, k8.z, k8.w}, qw[4] = {q8.x, q8.y, q8.z, q8.w};
    float oqf[8], oqb[8], okf[8], okb[8];
#pragma unroll
    for (int dd = 0; dd < 8; ++dd) { const int d = 8 * wid + dd;
        float pf = L[GL_BF + d], pb = L[GL_BB + d];
#pragma unroll
        for (int q = 0; q < 4; ++q) { const f32x4 wf4 = *(const LAS f32x4*)(L + GL_WF + d * 16 + 4 * q), wb4 = *(const LAS f32x4*)(L + GL_WB + d * 16 + 4 * q);
#pragma unroll
            for (int e = 0; e < 4; ++e) { pf += cgf[4 * q + e] * wf4[e]; pb += cgb[4 * q + e] * wb4[e]; } }
        const float gf = logsig(pf) * (1.f / 16.f), gb = logsig(pb) * (1.f / 16.f);
        const float cf = wave_incl_scan(gf, lane), pbi = wave_incl_scan(gb, lane);
        const float totf = __shfl(cf, 63), totb = __shfl(pbi, 63);
        const float cb = totb - pbi + gb;
        const float k = (dd & 1) ? bfhi(kw[dd >> 1]) : bflo(kw[dd >> 1]), q = ((dd & 1) ? bfhi(qw[dd >> 1]) : bflo(qw[dd >> 1])) * 0.125f;
        oqf[dd] = q * __expf(cf); oqb[dd] = q * __expf(cb); okf[dd] = k * __expf(-cf); okb[dd] = k * __expf(-cb);
        *(LAS unsigned short*)(B + GB_QDF + (d * HS + lane) * 2) = f2bf(k * __expf(totf - cf));
        *(LAS unsigned short*)(B + GB_QDB + (d * HS + lane) * 2) = f2bf(k * __expf(totb - cb));
        if (lane == 0) { DEC[(size_t)slot * 64 + d] = __expf(totf); DEC[(size_t)(slot + 1) * 64 + d] = __expf(totb); } }
    { u32x4 w;
      w.x = cvt_pk_bf16(oqf[0], oqf[1]); w.y = cvt_pk_bf16(oqf[2], oqf[3]); w.z = cvt_pk_bf16(oqf[4], oqf[5]); w.w = cvt_pk_bf16(oqf[6], oqf[7]); *(u32x4*)(GQ + 0 * 4096 + lane * 64 + 8 * wid) = w;
      w.x = cvt_pk_bf16(oqb[0], oqb[1]); w.y = cvt_pk_bf16(oqb[2], oqb[3]); w.z = cvt_pk_bf16(oqb[4], oqb[5]); w.w = cvt_pk_bf16(oqb[6], oqb[7]); *(u32x4*)(GQ + 1 * 4096 + lane * 64 + 8 * wid) = w;
      w.x = cvt_pk_bf16(okf[0], okf[1]); w.y = cvt_pk_bf16(okf[2], okf[3]); w.z = cvt_pk_bf16(okf[4], okf[5]); w.w = cvt_pk_bf16(okf[6], okf[7]); *(u32x4*)(GQ + 2 * 4096 + lane * 64 + 8 * wid) = w;
      w.x = cvt_pk_bf16(okb[0], okb[1]); w.y = cvt_pk_bf16(okb[2], okb[3]); w.z = cvt_pk_bf16(okb[4], okb[5]); w.w = cvt_pk_bf16(okb[6], okb[7]); *(u32x4*)(GQ + 3 * 4096 + lane * 64 + 8 * wid) = w; }
    if (PROBE_CUT == 2 && dup) return;
    __syncthreads();
    { const int r32 = lane & 31, hi = lane >> 5, dir = wid >> 2, eb = wid & 3;
      const LAS unsigned char* X = B + GB_VT; const LAS unsigned char* Y = B + (dir ? GB_QDB : GB_QDF);
      f32x16 c0 = {}, c1 = {};
#pragma unroll
      for (int ks = 0; ks < 4; ++ks) { const bf16x8 av = ldfrag(X, 32 * eb + r32, ks, hi), b0 = ldfrag(Y, r32, ks, hi), b1 = ldfrag(Y, 32 + r32, ks, hi);
          c0 = __builtin_amdgcn_mfma_f32_32x32x16_bf16(av, b0, c0, 0, 0, 0); c1 = __builtin_amdgcn_mfma_f32_32x32x16_bf16(av, b1, c1, 0, 0, 0); }
      float* out = KVS + (size_t)(slot + dir) * 8192;
#pragma unroll
      for (int r = 0; r < 16; ++r) { const int e = 32 * eb + crow16(r, hi); out[e * 64 + r32] = c0[r]; out[e * 64 + 32 + r32] = c1[r]; } }
}
__device__ __forceinline__ void gla_scan(CArgs& a, int dup) {
    float* KVS = (float*)(a.ws + WS_KVS); float* KVO = dup ? (float*)a.out + (10u << 20) : KVS; const float* DEC = (const float*)(a.ws + WS_DEC);
    int tid = threadIdx.x; asm volatile("" : "+v"(tid));
    for (int g = blockIdx.x * 512 + tid; g < 32 * 2048; g += gridDim.x * 512) {
        const int seq = g >> 11, el = (g & 2047) * 4, d = el & 63, b = seq >> 3, h = (seq >> 1) & 3, dir = seq & 1;
        f32x4 carry = {0.f, 0.f, 0.f, 0.f};
        for (int s0 = 0; s0 < 68; s0 += 17) {
            f32x4 kv[17], dc[17]; size_t ad[17];
#pragma unroll
            for (int q = 0; q < 17; ++q) { const int s = s0 + q; const int c = dir == 0 ? s : (s < 4 ? 3 - s : 71 - s); const size_t slot = (size_t)((b * 68 + c) * 4 + h) * 2 + dir;
                ad[q] = slot * 8192 + el; kv[q] = *(const f32x4*)(KVS + ad[q]); dc[q] = *(const f32x4*)(DEC + slot * 64 + d); }
#pragma unroll
            for (int q = 0; q < 17; ++q) { *(f32x4*)(KVO + ad[q]) = carry; carry = dc[q] * carry + kv[q]; }
        }
    }
}
__device__ __forceinline__ void gla_p3(CArgs& a, int l, int cc, int h, LAS float* L) {
    int tid = threadIdx.x; asm volatile("" : "+v"(tid));
    LAS unsigned char* B = (LAS unsigned char*)L;
    const int wid = tid >> 6, lane = tid & 63, r32 = lane & 31, hi = lane >> 5;
    const bf16_t* P = (const bf16_t*)(a.ws + WS_PROJ) + (size_t)(cc * 64) * INP;
    const float* KVS = (const float*)(a.ws + WS_KVS);
    const bf16_t* GQ = (const bf16_t*)a.out + (size_t)(cc * 4 + h) * 16384;
    const int slot = (cc * 4 + h) * 2;
    u32x4 qk[4];
#pragma unroll
    for (int q = 0; q < 4; ++q) qk[q] = *(const u32x4*)(GQ + (size_t)(tid + 512 * q) * 8);
    const bf16_t* Pj = P + (size_t)lane * INP;
    const u32x4 v0 = *(const u32x4*)(Pj + C_CV + h * 128 + 16 * wid), v1 = *(const u32x4*)(Pj + C_CV + h * 128 + 16 * wid + 8);
    f32x4 sv[8];
#pragma unroll
    for (int q = 0; q < 8; ++q) sv[q] = *(const f32x4*)(KVS + (size_t)slot * 8192 + (size_t)(tid + 512 * q) * 4);
    __syncthreads();
#pragma unroll
    for (int q = 0; q < 4; ++q) { const int idx = tid + 512 * q, arr = idx >> 9, rem = idx & 511, j = rem >> 3, c = rem & 7; *(LAS u32x4*)(B + GB_QDF + arr * 9216 + (j * HS + c * 8) * 2) = qk[q]; }
    gla_store_vt(v0, v1, B, wid, lane);
#pragma unroll
    for (int q = 0; q < 8; ++q) { const int idx = tid + 512 * q, dir = idx >> 11, i = idx & 2047, e = i >> 4, d4 = (i & 15) * 4;
        u32x2 w; w.x = cvt_pk_bf16(sv[q].x, sv[q].y); w.y = cvt_pk_bf16(sv[q].z, sv[q].w); *(LAS u32x2*)(B + (dir ? GB_SBT : GB_SFT) + (e * HS + d4) * 2) = w; }
    __syncthreads();
    if (wid < 4) { const int ib = wid >> 1, jb = wid & 1; f32x16 cf = {}, cb = {};
#pragma unroll
        for (int ks = 0; ks < 4; ++ks) {
            cf = __builtin_amdgcn_mfma_f32_32x32x16_bf16(ldfrag(B + GB_QDF, 32 * ib + r32, ks, hi), ldfrag(B + GB_KDF, 32 * jb + r32, ks, hi), cf, 0, 0, 0);
            cb = __builtin_amdgcn_mfma_f32_32x32x16_bf16(ldfrag(B + GB_QDB, 32 * ib + r32, ks, hi), ldfrag(B + GB_KDB, 32 * jb + r32, ks, hi), cb, 0, 0, 0); }
#pragma unroll
        for (int r = 0; r < 16; ++r) { const int i = 32 * ib + crow16(r, hi), j = 32 * jb + r32;
            const float v = (j <= i ? cf[r] : 0.f) + (j >= i ? cb[r] : 0.f);
            *(LAS unsigned short*)(B + GB_ATT + (i * HS + j) * 2) = f2bf(v); } }
    __syncthreads();
    { const int ib = wid >> 2, eb = wid & 3; f32x16 acc = {};
#pragma unroll
      for (int ks = 0; ks < 4; ++ks) {
          acc = __builtin_amdgcn_mfma_f32_32x32x16_bf16(ldfrag(B + GB_ATT, 32 * ib + r32, ks, hi), ldfrag(B + GB_VT, 32 * eb + r32, ks, hi), acc, 0, 0, 0);
          acc = __builtin_amdgcn_mfma_f32_32x32x16_bf16(ldfrag(B + GB_QDF, 32 * ib + r32, ks, hi), ldfrag(B + GB_SFT, 32 * eb + r32, ks, hi), acc, 0, 0, 0);
          acc = __builtin_amdgcn_mfma_f32_32x32x16_bf16(ldfrag(B + GB_QDB, 32 * ib + r32, ks, hi), ldfrag(B + GB_SBT, 32 * eb + r32, ks, hi), acc, 0, 0, 0); }
#pragma unroll
      for (int r = 0; r < 16; ++r) L[(32 * ib + crow16(r, hi)) * 128 + 32 * eb + r32] = acc[r]; }
    __syncthreads();
    const int i0 = (tid >> 5) * 4, e4 = (tid & 31) * 4;
    bf16_t* Z = (bf16_t*)(a.ws + WS_HZ);
    const f32x4 gn = *(const f32x4*)(a.in[I_CON] + l * 128 + e4);
#pragma unroll
    for (int r = 0; r < 4; ++r) { const f32x4 o = *(const LAS f32x4*)(L + (i0 + r) * 128 + e4);
        float ss = (o.x * o.x + o.y * o.y) + (o.z * o.z + o.w * o.w);
#pragma unroll
        for (int m = 1; m < 32; m <<= 1) ss += __shfl_xor(ss, m);
        const float rs = rsqrtf(ss * (1.f / 128.f) + EPS);
        const size_t row = (size_t)cc * 64 + i0 + r;
        const u32x2 gw = *(const u32x2*)(P + (size_t)(i0 + r) * INP + C_CG + h * 128 + e4);
        const f32x4 y = o * rs * gn;
        u32x2 w; w.x = cvt_pk_bf16(y.x * silu_f(bflo(gw.x)), y.y * silu_f(bfhi(gw.x))); w.y = cvt_pk_bf16(y.z * silu_f(bflo(gw.y)), y.w * silu_f(bfhi(gw.y)));
        *(u32x2*)(Z + row * DM + 1536 + h * 128 + e4) = w; }
}

__device__ __forceinline__ void phase_mixer(CArgs& a, int l, unsigned char* lds_g, LAS unsigned char* lds, int dup) {
    int tid = threadIdx.x; asm volatile("" : "+v"(tid));
    unsigned* ctr = (unsigned*)(a.ws + WS_CTL) + CW_QUEUE + 64 * l + 32 * dup;
    volatile LAS unsigned* qw = (volatile LAS unsigned*)(lds + LDS_QWORD);
    const bf16_t* PROJ = (const bf16_t*)(a.ws + WS_PROJ); const bf16_t* QB = (const bf16_t*)(a.ws + WS_QB); const bf16_t* KB = (const bf16_t*)(a.ws + WS_KB);
    const bf16_t* KVB = (const bf16_t*)(a.ws + WS_KVB); bf16_t* Z = (bf16_t*)(a.ws + WS_HZ);
    const int nG = (l == 0) ? NCHUNK * 4 : 256 * 4, nC = (l == 0) ? 48 : 0, total = 768 + nG + nC;
    for (;;) {
        __syncthreads();
        if (tid == 0) *qw = atomicAdd(ctr, 1u);
        __syncthreads();
        const int idx = (int)*qw;
        if (idx >= total) break;
        int kind, b, h, seq; size_t q0;
        if (idx < 256) { kind = 0; b = idx >> 6; h = (idx >> 4) & 3; q0 = (size_t)b * TOK + CTXL + (idx & 15) * 256; seq = TOK; }
        else if (idx < 768) { const int i = idx - 256; kind = 1; b = i >> 7; h = (i >> 4) & 7; q0 = (size_t)b * TOK + CTXL + (i & 15) * 256; seq = TOK; }
        else if (idx < 768 + nG) { kind = 2; b = 0; h = 0; q0 = 0; seq = 0; }
        else { const int i = idx - 768 - nG; seq = CTXL;
            if (i < 32) { kind = 1; b = i >> 3; h = i & 7; } else { kind = 0; b = (i - 32) >> 2; h = (i - 32) & 3; }
            q0 = (size_t)b * TOK; }
        const size_t r0 = (size_t)b * TOK;
        if (PROBE_KIND >= 0 && dup && kind != PROBE_KIND) continue;
        bf16_t* Zo = (PROBE_ATT && dup) ? (bf16_t*)((float*)a.out + (10u << 20)) : Z;
#ifndef NO_ATTB
        if (kind == 0)
            att::attn_body_s<192, 768, 768, 1024, DM>(QB + q0 * 768 + h * 192, KB + r0 * 768 + h * 192, KVB + r0 * 1024 + h * 256 + 128, Zo + q0 * DM + 1024 + h * 128, seq, (char*)lds_g, dup);
#endif
#ifndef NO_ATTA
        if (kind == 1)
            att::attn_body_s<128, INP, INP, INP, DM>(PROJ + q0 * INP + C_AQ + h * 128, PROJ + r0 * INP + C_AK + (h >> 2) * 128, PROJ + r0 * INP + C_AV + (h >> 2) * 128, Zo + q0 * DM + h * 128, seq, (char*)lds_g, dup);
#endif
#ifndef NO_GLA3
        if (kind == 2) {
            const int i = idx - 768; int cc; const int hh = i & 3;
            if (l == 0) cc = i >> 2; else { const int lc = i >> 2; cc = (lc >> 6) * 68 + (lc & 63) + 4; }
            gla_p3(a, l, cc, hh, (LAS float*)lds);
        }
#endif
    }
}

__device__ __forceinline__ void run_phase(CArgs& a, int ph, unsigned char* lds_g, LAS unsigned char* lds, int dup) {
    int tid = threadIdx.x; asm volatile("" : "+v"(tid));
    const int lane = tid & 63, wid = tid >> 6;
    const int G = gridDim.x, gw = blockIdx.x * 8 + wid, NGW = G * 8;
    if (ph == 0) { phase_prologue(a, lds); return; }
    const int l = (ph - 1) / 10, k = (ph - 1) % 10;
    unsigned char* wb = a.ws + WS_W + (size_t)l * W_LAYER;
    const float* MOD = (const float*)(a.ws + WS_MOD) + (size_t)l * 5 * 12288;
    if (k == 0 || k == 7) { phase_norm(a, l, k == 7); return; }
    if (k == 1 || k == 3) {
        const int ng = (k == 1) ? 1 : 2;
        for (int gi = 0; gi < ng; ++gi) {
            if (PROBE_DUP == 20 && dup) break;
            pg8::Gemm g; pg8::EpiStore E; E.skipctx = 0;
            if (k == 1) { g = pg8::Gemm{(const bf16_t*)(a.ws + WS_HZ), (const bf16_t*)(wb + WO_IN), NR, INP, DM, DM, 0, DM}; E.O = (bf16_t*)(a.ws + WS_PROJ); E.ldc = INP; }
            else if (gi == 0) { g = pg8::Gemm{(const bf16_t*)(a.ws + WS_PROJ) + C_BCQ, (const bf16_t*)(wb + WO_UQ), NR, 768, 512, INP, 0, 512}; E.O = (bf16_t*)(a.ws + WS_QB); E.ldc = 768; }
            else { g = pg8::Gemm{(const bf16_t*)(a.ws + WS_PROJ) + C_BCKV, (const bf16_t*)(wb + WO_UKV), NR, 1024, 256, INP, 0, 256}; E.O = (bf16_t*)(a.ws + WS_KVB); E.ldc = 1024; }
            pg8::StaticOrder S; S.init(g.M, g.N, G, (int)blockIdx.x);
            pg8::gemm_phase<pg8::EpiStore>(lds, g, S, E);
        }
        if (k == 3) gla_scan(a, dup);
        return;
    }
    if (k == 2) {
        if (!dup || PROBE_DUP == 20) for (int r = gw; r < NR; r += 3 * NGW) { const int r1 = r + NGW, r2 = r + 2 * NGW; const bool two = r1 < NR, three = r2 < NR;
            E1Regs g0, g1, g2; e1_load(a, r, lane, g0); e1_load(a, two ? r1 : r, lane, g1); e1_load(a, three ? r2 : r, lane, g2); asm volatile("" ::: "memory");
            e1_row(a, l, r, lane, dup, g0); if (two) e1_row(a, l, r1, lane, dup, g1); if (three) e1_row(a, l, r2, lane, dup, g2); }
        if (!(dup && PROBE_DUP == 20)) { int hst = -1; for (int u = blockIdx.x; u < NCHUNK * 4; u += G) { const int h = u & 3; gla_p1(a, l, u >> 2, h, (LAS float*)lds, dup, h != hst); hst = h; } }
        return;
    }
    if (k == 4) { for (int r = gw; r < NR; r += 3 * NGW) { const int r1 = r + NGW, r2 = r + 2 * NGW; const bool two = r1 < NR, three = r2 < NR;
            E2Regs g0, g1, g2; e2_load(a, r, lane, g0); e2_load(a, two ? r1 : r, lane, g1); e2_load(a, three ? r2 : r, lane, g2); asm volatile("" ::: "memory");
            e2_row(a, l, r, lane, dup, g0); if (two) e2_row(a, l, r1, lane, dup, g1); if (three) e2_row(a, l, r2, lane, dup, g2); }
        return; }
    if (k == 5) { phase_mixer(a, l, lds_g, lds, dup); return; }
    if (k == 6 || k == 9) {
        pg8::Gemm g; pg8::EpiResid E;
        if (k == 6) g = pg8::Gemm{(const bf16_t*)(a.ws + WS_HZ), (const bf16_t*)(wb + WO_OUT), NBATCH * SEQ, DM, DM, DM, 1, DM};
        else g = pg8::Gemm{(const bf16_t*)(a.ws + WS_ACT), (const bf16_t*)(wb + WO_DN), NBATCH * SEQ, DM, DFF, DFF, 1, DFF};
        E.xin = a.in[I_X]; E.ctxin = a.in[I_CTX]; E.xr_in = (const float*)(a.ws + WS_XR); E.xr_out = (float*)(a.ws + WS_XR); E.fin_out = a.out;
        E.gate = MOD + (k == 6 ? 2 : 5) * DM; E.in_split = (l == 0 && k == 6); E.out_final = (l == 1 && k == 9); E.skipctx = 1;
        pg8::StaticOrder S; S.init(g.M, g.N, G, (int)blockIdx.x);
        pg8::gemm_phase<pg8::EpiResid>(lds, g, S, E);
        if (l == 0) {
            const int ks = (k == 6) ? 8 : 4;
            pg8::Gemm g2 = g; g2.M = NBATCH * CTXL; g2.skipctx = 2; g2.kpart = g.K / ks;
            pg8::EpiPartial E2{(float*)a.out + PART_OFF};
            pg8::StaticOrder S2; S2.init(g2.M, g2.N, G, (int)blockIdx.x, ks);
            pg8::gemm_phase<pg8::EpiPartial>(lds, g2, S2, E2);
        }
        return;
    }
    if (k == 8) {
        const int skip = (l == 1);
        pg8::Gemm g{(const bf16_t*)(a.ws + WS_HZ), (const bf16_t*)(wb + WO_GU), skip ? NBATCH * SEQ : NR, 2 * DFF, DM, DM, skip, DM};
        pg8::EpiSwiGLU E{(bf16_t*)(a.ws + WS_ACT), skip};
        pg8::StaticOrder S; S.init(g.M, g.N, G, (int)blockIdx.x);
        pg8::gemm_phase<pg8::EpiSwiGLU>(lds, g, S, E);
        return;
    }
}

#define XB_TMO      128
#define XB_XCNT(j)  (256  + 64 * (j))
#define XB_XSUB(j)  (1280 + 64 * (j))
#define XB_XGEN(j)  (2304 + 64 * (j))
#define XB_TOP      3328
#define XB_TOPGEN   3392
#define XCD_BAR_WORDS 3456
#define XB_SPIN_CAP (1u << 22)
constexpr int CW_BAR = 4096;
__device__ __forceinline__ unsigned xb_ld(unsigned* p)              { return __hip_atomic_load(p, __ATOMIC_RELAXED, __HIP_MEMORY_SCOPE_AGENT); }
__device__ __forceinline__ unsigned xb_add(unsigned* p, unsigned v) { return __hip_atomic_fetch_add(p, v, __ATOMIC_RELAXED, __HIP_MEMORY_SCOPE_AGENT); }
__device__ __forceinline__ unsigned xb_xcc_id() { return (unsigned)__builtin_amdgcn_s_getreg((3 << 11) | 20) & 0xFu; }
#define XB_SPIN(cond, bar) do { unsigned _sp = 0; while (cond) { __builtin_amdgcn_s_sleep(1); \
    if ((++_sp & 255u) == 0u) { if (xb_ld(&(bar)[XB_TMO])) break; if (_sp > XB_SPIN_CAP) { atomicAdd(&(bar)[XB_TMO], 1u); break; } } } } while (0)
struct XcdBarrier { unsigned* bar; unsigned x; volatile LAS unsigned* st; };
__device__ __forceinline__ XcdBarrier xcd_barrier_post(unsigned* bar, volatile LAS unsigned* st) {
    XcdBarrier b; b.bar = bar; b.x = xb_xcc_id(); b.st = st;
    if (threadIdx.x == 0) (void)xb_add(&bar[XB_XCNT(b.x)], 1u);
    return b;
}
__device__ __forceinline__ void xcd_barrier_complete(unsigned* bar, unsigned x, unsigned& nloc, unsigned& nx) {
    const unsigned G = gridDim.x * gridDim.y * gridDim.z;
    unsigned sum, cnt, mine, sp = 0u;
    for (;;) {
        sum = 0u; cnt = 0u; mine = 0u;
#pragma unroll
        for (unsigned j = 0; j < 16; ++j) { const unsigned c = xb_ld(&bar[XB_XCNT(j)]); sum += c; cnt += (c > 0u) ? 1u : 0u; mine = (j == x) ? c : mine; }
        if (sum == G) break;
        __builtin_amdgcn_s_sleep(1);
        if ((++sp & 255u) == 0u) { if (xb_ld(&bar[XB_TMO])) break; if (sp > XB_SPIN_CAP) { atomicAdd(&bar[XB_TMO], 1u); break; } }
    }
    nloc = mine > 0u ? mine : 1u; nx = cnt > 0u ? cnt : 1u;
}
__device__ __forceinline__ void xcd_barrier(const XcdBarrier& b) {
    asm volatile("s_waitcnt vmcnt(0)" ::: "memory");
    __syncthreads();
    if (threadIdx.x == 0) {
        unsigned* bar = b.bar;
        __builtin_amdgcn_s_waitcnt(0);
        unsigned nloc = b.st[0], nx = b.st[1];
        if (nloc == 0u) { xcd_barrier_complete(bar, b.x, nloc, nx); b.st[0] = nloc; b.st[1] = nx; }
        const unsigned old = xb_add(&bar[XB_XSUB(b.x)], 1u);
        const unsigned gen = old / nloc;
        if (old + 1u == (gen + 1u) * nloc) {
            __builtin_amdgcn_fence(__ATOMIC_RELEASE, "agent");
            asm volatile("s_waitcnt vmcnt(0)" ::: "memory");
            const unsigned og = xb_add(&bar[XB_TOP], 1u);
            const unsigned tg = og / nx;
            if (og + 1u == (tg + 1u) * nx) xb_add(&bar[XB_TOPGEN], 1u);
            else XB_SPIN(xb_ld(&bar[XB_TOPGEN]) == tg, bar);
            __builtin_amdgcn_fence(__ATOMIC_ACQUIRE, "agent");
            xb_add(&bar[XB_XGEN(b.x)], 1u);
            asm volatile("s_waitcnt vmcnt(0)" ::: "memory");
        } else {
            XB_SPIN(xb_ld(&bar[XB_XGEN(b.x)]) == gen, bar);
            __builtin_amdgcn_fence(__ATOMIC_ACQUIRE, "agent");
            asm volatile("s_waitcnt vmcnt(0)" ::: "memory");
        }
    }
    __syncthreads();
}

__global__ void __launch_bounds__(512, 2) mega(Args a) {
    extern __shared__ __attribute__((aligned(16))) unsigned char lds_raw[];
    cg::grid_group grid = cg::this_grid();
    volatile LAS unsigned* bst = (volatile LAS unsigned*)((LAS unsigned char*)lds_raw + LDS_QWORD + 16);
    if (threadIdx.x < 2) bst[threadIdx.x] = 0u;
    __syncthreads();
    const XcdBarrier bar = xcd_barrier_post((unsigned*)(a.ws + WS_CTL) + CW_BAR, bst);
    if (a.coop == 0x7fffffff) grid.sync();
    int dup = 0;
    for (int ph = a.ph_lo; ph < a.ph_hi; ++ph) {
        CArgs* ap = (CArgs*)__builtin_amdgcn_kernarg_segment_ptr(); asm volatile("" : "+s"(ap));
        run_phase(*ap, ph, lds_raw, (LAS unsigned char*)lds_raw, dup);
        if (PROBE_DUP >= 0 && dup == 0 && ((ph > 0 && (ph - 1) % 10 == PROBE_DUP) || (ph == 0 && PROBE_DUP == 10) || (PROBE_DUP == 20 && ph > 0 && ((ph - 1) % 10 == 2 || (ph - 1) % 10 == 3 || (ph - 1) % 10 == 4)))) { dup = 1; --ph; } else dup = 0;
        if (ph + 1 < a.ph_hi) { xcd_barrier(bar); for (int q = 0; q < PROBE_SYNC; ++q) xcd_barrier(bar); }
    }
}

constexpr int NPHASE = 21;
extern "C" void kernel_launch(void* const* d_in, const int* in_sizes, int n_in, void* d_out, int out_size, void* d_ws, size_t ws_size, hipStream_t stream) {
    static int grid = 0;
    if (grid == 0) {
        if (n_in != 28 || ws_size < WS_END) { fprintf(stderr, "kernel_launch: unexpected n_in %d or ws %zu < %zu\n", n_in, ws_size, (size_t)WS_END); grid = -1; return; }
        int dev = 0, cus = 0, per_cu = 0;
        hipGetDevice(&dev); hipDeviceGetAttribute(&cus, hipDeviceAttributeMultiprocessorCount, dev);
        if (hipFuncSetAttribute((const void*)mega, hipFuncAttributeMaxDynamicSharedMemorySize, LDS_BYTES) != hipSuccess) { fprintf(stderr, "kernel_launch: hipFuncSetAttribute failed\n"); grid = -1; return; }
        if (hipOccupancyMaxActiveBlocksPerMultiprocessor(&per_cu, (const void*)mega, 512, LDS_BYTES) != hipSuccess || per_cu < 1) per_cu = 1;
        (void)hipGetLastError();
        grid = cus * per_cu;
    }
    if (grid < 0) return;
    hipMemsetAsync((char*)d_ws + WS_CTL, 0, CTL_BYTES, stream);
    Args a{};
    for (int i = 0; i < 28; ++i) a.in[i] = (const float*)d_in[i];
    a.out = (float*)d_out; a.ws = (unsigned char*)d_ws; a.coop = MK_COOP; a.pad = 0;
#if MK_COOP
    a.ph_lo = 0; a.ph_hi = NPHASE;
    void* args[] = {&a};
    hipError_t e = hipLaunchCooperativeKernel((const void*)mega, dim3(grid), dim3(512), args, LDS_BYTES, stream);
    if (e != hipSuccess) fprintf(stderr, "cooperative launch failed: %s (grid %d)\n", hipGetErrorString(e), grid);
#else
    for (int ph = 0; ph < NPHASE; ++ph) { a.ph_lo = ph; a.ph_hi = ph + 1; hipLaunchKernelGGL(mega, dim3(grid), dim3(512), LDS_BYTES, stream, a); }
#endif
}
```

```cpp
#include <hip/hip_runtime.h>
#include <hip/hip_cooperative_groups.h>
#include <hip/hip_bf16.h>
#include <cstdio>
#include <cstdint>
namespace cg = cooperative_groups;

#ifndef MK_COOP
#define MK_COOP 1
#endif
#define PROBE_DUP -1
#define PROBE_CUT 0
#define PROBE_ATT 0
#define PROBE_SYNC 0
#define PROBE_KIND -1

#define LAS __attribute__((address_space(3)))
typedef unsigned short bf16_t;
typedef short bf16x8 __attribute__((ext_vector_type(8)));
typedef short s16x4 __attribute__((ext_vector_type(4)));
typedef float f32x4 __attribute__((ext_vector_type(4)));
typedef float f32x2 __attribute__((ext_vector_type(2)));
typedef float f32x16 __attribute__((ext_vector_type(16)));
typedef unsigned u32x4 __attribute__((ext_vector_type(4)));
typedef unsigned u32x2 __attribute__((ext_vector_type(2)));

constexpr int DM = 2048, NBATCH = 4, SEQ = 4096, CTXL = 256, TOK = SEQ + CTXL  , NR = NBATCH * TOK  ;
constexpr int INC = 3936, INP = 4096, DFF = 5632;
constexpr int C_AQ = 0, C_AK = 1024, C_AV = 1280, C_BCQ = 1536, C_BCKV = 2048, C_BKR = 2304, C_CQ = 2368, C_CK = 2624, C_CV = 2880, C_CG = 3392, C_CGF = 3904, C_CGB = 3920;
constexpr float EPS = 1e-6f;
constexpr float QSCALE_A = 0.088388347648318440f * 1.4426950408889634f, QSCALE_B = 0.072168783648703220f * 1.4426950408889634f;
constexpr int NCHUNK = NR / 64;
constexpr size_t MiB = 1u << 20;
constexpr size_t WS_CTL = 0, CTL_BYTES = 1 * MiB;
constexpr size_t WS_MOD = 64 * 1024;
constexpr size_t WS_W = 1 * MiB, W_LAYER = 92 * MiB;
constexpr size_t WO_IN = 0, WO_UQ = 16 * MiB, WO_UKV = 17 * MiB, WO_OUT = 18 * MiB, WO_GU = 26 * MiB, WO_DN = 70 * MiB;
constexpr size_t WS_HZ = WS_W + 2 * W_LAYER;
constexpr size_t WS_XR = WS_HZ + 68 * MiB;
constexpr size_t WS_S = WS_XR + 136 * MiB;
constexpr size_t WS_PROJ = WS_S;
constexpr size_t WS_QB = WS_PROJ + 136 * MiB;
constexpr size_t WS_KVB = WS_QB + 26 * MiB;
constexpr size_t WS_KB = WS_KVB + 34 * MiB;
constexpr size_t WS_KVS = WS_KB + 26 * MiB;
constexpr size_t WS_DEC = WS_KVS + 68 * MiB;
constexpr size_t WS_ACT = WS_S;
constexpr size_t WS_END = WS_DEC + 1 * MiB;
constexpr int CW_QUEUE = 64;

constexpr size_t PART_OFF = 10u << 20;
constexpr int LDS_BYTES = 155648;
constexpr int LDS_QWORD = 153600;

__device__ __forceinline__ float bf2f(unsigned short x) { return __uint_as_float(((unsigned)x) << 16); }
__device__ __forceinline__ float bflo(unsigned w) { return __uint_as_float(w << 16); }
__device__ __forceinline__ float bfhi(unsigned w) { return __uint_as_float(w & 0xffff0000u); }
__device__ __forceinline__ unsigned cvt_pk_bf16(float lo, float hi) { unsigned r; asm volatile("v_cvt_pk_bf16_f32 %0, %1, %2" : "=v"(r) : "v"(lo), "v"(hi)); return r; }
__device__ __forceinline__ unsigned short f2bf(float f) { return (unsigned short)(cvt_pk_bf16(f, 0.f) & 0xffffu); }
__device__ __forceinline__ float wave_sum(float v) {
#pragma unroll
    for (int o = 1; o < 64; o <<= 1) v += __shfl_xor(v, o);
    return v;
}
__device__ __forceinline__ float silu_f(float g) { return g * __builtin_amdgcn_rcpf(1.f + __expf(-g)); }

namespace pg8 {
constexpr int BM = 256, BK = 64, HALF = 128, HTB = HALF * BK * 2, STAGE_BYTES = 8 * HTB, NXCD = 8, WGM = 8;
__host__ __device__ __forceinline__ int lds_byte(int r, int c) { const int st = (r >> 4) * 2 + (c >> 5), rr = r & 15, cc = c & 31, ob = rr * 64 + cc * 2; return st * 1024 + (ob ^ (((ob >> 9) & 1) << 5)); }
__host__ __device__ __forceinline__ void stage_rc(int b, int& R, int& C) { const int st = b / 1024, sb = b % 1024, swz = sb ^ (((sb >> 9) & 1) << 5); R = (st >> 1) * 16 + swz / 64; C = (st & 1) * 32 + (swz % 64) / 2; }
__host__ __device__ __forceinline__ int perm32(int rho) { const int n = rho >> 4, i = rho & 15; return 8 * (i >> 2) + 4 * n + (i & 3); }
struct Unit { int pm, pn, kp; };
struct Gemm { const bf16_t* A; const bf16_t* Bt; int M, N, K, lda, skipctx, kpart; };
__device__ __forceinline__ int phys_tile(int pm, int skip) { return skip == 1 ? pm + (pm >> 4) + 1 : (skip == 2 ? pm * 17 : pm); }
struct StaticOrder {
    int nM, nN, nwg, G, c, n2;
    __device__ void init(int M, int N, int G_, int c_, int ks = 1) { nM = M / BM; nN = N / BM; n2 = nM * nN; nwg = n2 * ks; G = G_; c = c_; }
    __device__ bool next(int i, Unit& u) const {
        const long L = (long)i * G + c; if (L >= nwg) return false;
        int wgid = (int)L; { const int q = nwg / NXCD, r = nwg % NXCD, xcd = wgid % NXCD, off = wgid / NXCD; wgid = (xcd < r ? xcd * (q + 1) : r * (q + 1) + (xcd - r) * q) + off; }
        u.kp = wgid / n2; wgid -= u.kp * n2;
        const int nig = WGM * nN, gid = wgid / nig, fm = gid * WGM, gsz = (nM - fm) < WGM ? (nM - fm) : WGM;
        u.pm = fm + ((wgid % nig) % gsz); u.pn = (wgid % nig) / gsz; return true;
    }
};
struct EpiStore {
    static constexpr bool PERM = true;
    bf16_t* O; int ldc; int skipctx;
    __device__ __forceinline__ void operator()(const f32x4 (&acc)[2][2][4][2], const Unit& u, int wr, int wc, int fr, int fq) const {
        const int row0 = phys_tile(u.pm, skipctx) * BM + wr * 64 + fr, col0 = u.pn * BM + wc * 32 + 8 * fq;
#pragma unroll
        for (int ai = 0; ai < 2; ++ai)
#pragma unroll
            for (int m = 0; m < 4; ++m) { bf16_t* rowp = O + (size_t)(row0 + ai * HALF + m * 16) * ldc + col0;
#pragma unroll
                for (int bj = 0; bj < 2; ++bj) { const f32x4 v0 = acc[ai][bj][m][0], v1 = acc[ai][bj][m][1];
                    u32x4 w; w.x = cvt_pk_bf16(v0[0], v0[1]); w.y = cvt_pk_bf16(v0[2], v0[3]); w.z = cvt_pk_bf16(v1[0], v1[1]); w.w = cvt_pk_bf16(v1[2], v1[3]);
                    *(u32x4*)(rowp + bj * HALF) = w; } }
    }
};
struct EpiSwiGLU {
    static constexpr bool PERM = true;
    bf16_t* O; int skipctx;
    __device__ __forceinline__ void operator()(const f32x4 (&acc)[2][2][4][2], const Unit& u, int wr, int wc, int fr, int fq) const {
        const int row0 = phys_tile(u.pm, skipctx) * BM + wr * 64 + fr, col0 = u.pn * HALF + wc * 32 + 8 * fq;
#pragma unroll
        for (int ai = 0; ai < 2; ++ai)
#pragma unroll
            for (int m = 0; m < 4; ++m) { bf16_t* rowp = O + (size_t)(row0 + ai * HALF + m * 16) * DFF + col0;
                float r[8];
#pragma unroll
                for (int n = 0; n < 2; ++n)
#pragma unroll
                    for (int e = 0; e < 4; ++e) r[n * 4 + e] = silu_f(acc[ai][0][m][n][e]) * acc[ai][1][m][n][e];
                u32x4 w; w.x = cvt_pk_bf16(r[0], r[1]); w.y = cvt_pk_bf16(r[2], r[3]); w.z = cvt_pk_bf16(r[4], r[5]); w.w = cvt_pk_bf16(r[6], r[7]);
                *(u32x4*)rowp = w; }
    }
};
struct EpiPartial {
    static constexpr bool PERM = false;
    float* P;
    __device__ __forceinline__ void operator()(const f32x4 (&acc)[2][2][4][2], const Unit& u, int wr, int wc, int fr, int fq) const {
        float* t = P + ((size_t)(u.kp * 32 + u.pm * 8 + u.pn) << 16); const int col0 = wc * 32 + 4 * fq;
#pragma unroll
        for (int ai = 0; ai < 2; ++ai)
#pragma unroll
            for (int m = 0; m < 4; ++m) { float* rp = t + (ai * HALF + wr * 64 + m * 16 + fr) * 256 + col0;
#pragma unroll
                for (int bj = 0; bj < 2; ++bj)
#pragma unroll
                    for (int n = 0; n < 2; ++n) *(f32x4*)(rp + bj * HALF + n * 16) = acc[ai][bj][m][n]; }
    }
};
struct EpiResid {
    static constexpr bool PERM = false;
    const float* xin; const float* ctxin; const float* xr_in; float* xr_out; float* fin_out; const float* gate; int in_split, out_final, skipctx;
    __device__ __forceinline__ void operator()(const f32x4 (&acc)[2][2][4][2], const Unit& u, int wr, int wc, int fr, int fq) const {
        const int pt = phys_tile(u.pm, skipctx), b = pt / 17, t = pt - b * 17, v = (t == 0) ? 4 : b;
        const float* inb = in_split ? (t == 0 ? ctxin + (size_t)b * CTXL * DM : xin + ((size_t)b * SEQ + (size_t)(t - 1) * 256) * DM) : xr_in + (size_t)pt * BM * DM;
        float* ob = out_final ? fin_out + ((size_t)b * SEQ + (size_t)(t - 1) * 256) * DM : xr_out + (size_t)pt * BM * DM;
        const int col0 = u.pn * BM + wc * 32 + 4 * fq;
        const float* gp = gate + (size_t)v * 12288 + col0;
        f32x4 gv[2][2];
#pragma unroll
        for (int bj = 0; bj < 2; ++bj)
#pragma unroll
            for (int n = 0; n < 2; ++n) gv[bj][n] = *(const f32x4*)(gp + bj * HALF + n * 16);
#pragma unroll
        for (int ai = 0; ai < 2; ++ai)
#pragma unroll
            for (int m = 0; m < 4; ++m) { const size_t off = (size_t)(ai * HALF + wr * 64 + m * 16 + fr) * DM + col0;
#pragma unroll
                for (int bj = 0; bj < 2; ++bj)
#pragma unroll
                    for (int n = 0; n < 2; ++n) { const f32x4 bs = *(const f32x4*)(inb + off + bj * HALF + n * 16);
                        *(f32x4*)(ob + off + bj * HALF + n * 16) = bs + gv[bj][n] * acc[ai][bj][m][n]; }
                if (m == 3) asm volatile("" ::: "memory"); }
    }
};

template <class Epi>
__device__ __forceinline__ void gemm_phase(LAS unsigned char* lds, const Gemm g, const StaticOrder& S, const Epi& E) {
    int tid_ = threadIdx.x; asm volatile("" : "+v"(tid_));
    const int tid = tid_, wid = __builtin_amdgcn_readfirstlane(tid >> 6), lane = tid & 63, wr = wid >> 2, wc = wid & 3, fr = lane & 15, fq = lane >> 4;
    const int K = g.K, nt = g.kpart / BK, lda = g.lda;
    unsigned voffA[2], voffB[2];
#pragma unroll
    for (int i = 0; i < 2; ++i) { int R, C; stage_rc(tid * 16 + i * 8192, R, C); const int Rb = Epi::PERM ? ((R & ~31) + perm32(R & 31)) : R;
        voffA[i] = (unsigned)(R * lda + C) * 2u; voffB[i] = (unsigned)(Rb * K + C) * 2u; }
    const size_t kstep = (size_t)(BK * 2);
    const size_t hstepA = (size_t)HALF * lda * 2, hstepB = (size_t)HALF * K * 2;
    const size_t tstepA = 2 * hstepA, tstepB = 2 * hstepB;
    const unsigned ldsw = (unsigned)wid * 1024u;
    const int aoff = lds_byte(wr * 64 + fr, fq * 8), boff = lds_byte(wc * 32 + fr, fq * 8);
#define PG8_SA(b, h) (((b) * 2 + (h)) * HTB)
#define PG8_SB(b, h) ((4 + (b) * 2 + (h)) * HTB)
#define PG8_STAGE(bufoff, gbase, voff) do { _Pragma("unroll") for (int _i = 0; _i < 2; ++_i) \
        __builtin_amdgcn_global_load_lds((const unsigned*)((const char*)(gbase) + (voff)[_i]), (LAS unsigned*)(lds + (bufoff) + ldsw + _i * 8192), 16, 0, 0); } while (0)
#define PG8_LDA(dst, b, h) do { _Pragma("unroll") for (int m = 0; m < 4; ++m) _Pragma("unroll") for (int k = 0; k < 2; ++k) dst[m][k] = *(const LAS bf16x8*)(lds + PG8_SA(b, h) + aoff + m * 2048 + k * 1024); } while (0)
#define PG8_LDB(dst, b, h) do { _Pragma("unroll") for (int n = 0; n < 2; ++n) _Pragma("unroll") for (int k = 0; k < 2; ++k) dst[n][k] = *(const LAS bf16x8*)(lds + PG8_SB(b, h) + boff + n * 2048 + k * 1024); } while (0)
#define PG8_MMA(ai, bj, At, Bt) do { __builtin_amdgcn_s_setprio(1); _Pragma("unroll") for (int m = 0; m < 4; ++m) _Pragma("unroll") for (int n = 0; n < 2; ++n) _Pragma("unroll") for (int k = 0; k < 2; ++k) \
        acc[ai][bj][m][n] = __builtin_amdgcn_mfma_f32_16x16x32_bf16(Bt[n][k], At[m][k], acc[ai][bj][m][n], 0, 0, 0); __builtin_amdgcn_s_setprio(0); } while (0)
#define PG8_WAIT_V(n) asm volatile("s_waitcnt vmcnt(" #n ")" ::: "memory")
#define PG8_WAIT_L(n) asm volatile("s_waitcnt lgkmcnt(" #n ")" ::: "memory")
#define PG8_BAR __builtin_amdgcn_s_barrier()
#define PG8_SCHED __builtin_amdgcn_sched_barrier(0)
    Unit cur, nxt; int ui = 0;
    if (!S.next(0, cur)) return;
    f32x4 acc[2][2][4][2];
#pragma unroll
    for (int a = 0; a < 2; ++a)
#pragma unroll
        for (int b = 0; b < 2; ++b)
#pragma unroll
            for (int m = 0; m < 4; ++m)
#pragma unroll
                for (int n = 0; n < 2; ++n) acc[a][b][m][n] = (f32x4){0.f, 0.f, 0.f, 0.f};
    bf16x8 At[4][2], B0[2][2], B1[2][2];
    const size_t kpb = (size_t)g.kpart * 2;
    const char* cA = (const char*)g.A + (size_t)phys_tile(cur.pm, g.skipctx) * tstepA + cur.kp * kpb; const char* cB = (const char*)g.Bt + (size_t)cur.pn * tstepB + cur.kp * kpb;
    PG8_STAGE(PG8_SB(0, 0), cB, voffB); PG8_STAGE(PG8_SB(0, 1), cB + hstepB, voffB); PG8_STAGE(PG8_SA(0, 0), cA, voffA); PG8_STAGE(PG8_SA(0, 1), cA + hstepA, voffA);
    if (wr == 1) PG8_BAR;
    PG8_WAIT_V(2); PG8_BAR;
    PG8_STAGE(PG8_SB(1, 0), cB + kstep, voffB); PG8_STAGE(PG8_SA(1, 0), cA + kstep, voffA); PG8_STAGE(PG8_SB(1, 1), cB + hstepB + kstep, voffB);
    PG8_WAIT_V(6); PG8_BAR;
    for (;;) {
        const bool has_next = S.next(ui + 1, nxt);
        const char* nA = has_next ? (const char*)g.A + (size_t)phys_tile(nxt.pm, g.skipctx) * tstepA + nxt.kp * kpb : cA; const char* nB = has_next ? (const char*)g.Bt + (size_t)nxt.pn * tstepB + nxt.kp * kpb : cB;
        for (int t = 0; t < nt; t += 2) {
            const bool last = (t == nt - 2);
            const char* a1 = cA + (size_t)(t + 1) * kstep;
            const char* a2 = last ? nA : cA + (size_t)(t + 2) * kstep; const char* b2 = last ? nB : cB + (size_t)(t + 2) * kstep;
            const char* a3 = a2 + kstep; const char* b3 = b2 + kstep;
            PG8_LDB(B0, 0, 0); PG8_LDB(B1, 0, 1); PG8_SCHED; PG8_LDA(At, 0, 0); PG8_STAGE(PG8_SA(1, 1), a1 + hstepA, voffA);
            PG8_WAIT_V(8); PG8_WAIT_L(0); PG8_BAR; PG8_MMA(0, 0, At, B0); PG8_MMA(0, 1, At, B1); PG8_BAR; PG8_SCHED;
            PG8_LDA(At, 0, 1); PG8_STAGE(PG8_SB(0, 0), b2, voffB); PG8_STAGE(PG8_SB(0, 1), b2 + hstepB, voffB); PG8_STAGE(PG8_SA(0, 0), a2, voffA);
            PG8_WAIT_V(8); PG8_WAIT_L(0); PG8_BAR; PG8_MMA(1, 0, At, B0); PG8_MMA(1, 1, At, B1); PG8_BAR; PG8_SCHED;
            PG8_LDB(B0, 1, 0); PG8_LDB(B1, 1, 1); PG8_SCHED; PG8_LDA(At, 1, 0); PG8_STAGE(PG8_SA(0, 1), a2 + hstepA, voffA);
            PG8_WAIT_V(8); PG8_WAIT_L(0); PG8_BAR; PG8_MMA(0, 0, At, B0); PG8_MMA(0, 1, At, B1); PG8_BAR; PG8_SCHED;
            PG8_LDA(At, 1, 1); PG8_STAGE(PG8_SB(1, 0), b3, voffB); PG8_STAGE(PG8_SB(1, 1), b3 + hstepB, voffB); PG8_STAGE(PG8_SA(1, 0), a3, voffA);
            PG8_WAIT_V(8); PG8_WAIT_L(0); PG8_BAR; PG8_MMA(1, 0, At, B0); PG8_MMA(1, 1, At, B1); PG8_BAR; PG8_SCHED;
        }
        if (wr == 0) PG8_BAR;
        E(acc, cur, wr, wc, fr, fq);
        if (!has_next) break;
#pragma unroll
        for (int a = 0; a < 2; ++a)
#pragma unroll
            for (int b = 0; b < 2; ++b)
#pragma unroll
                for (int m = 0; m < 4; ++m)
#pragma unroll
                    for (int n = 0; n < 2; ++n) acc[a][b][m][n] = (f32x4){0.f, 0.f, 0.f, 0.f};
        cur = nxt; cA = nA; cB = nB; ++ui;
        if (wr == 1) PG8_BAR;
    }
    PG8_WAIT_V(0);
    PG8_BAR;
#undef PG8_SA
#undef PG8_SB
#undef PG8_STAGE
#undef PG8_LDA
#undef PG8_LDB
#undef PG8_MMA
#undef PG8_WAIT_V
#undef PG8_WAIT_L
#undef PG8_BAR
#undef PG8_SCHED
}
}

namespace att {
using bf16 = bf16_t;
constexpr int NW = 8, QBLK = 32, KVBLK = 64;
constexpr float THR = 8.f;
#define SBAR() __builtin_amdgcn_sched_barrier(0)
__device__ __forceinline__ int crow(int r, int hi) { return (r & 3) + 8 * (r >> 2) + 4 * hi; }
template <int DQK> __device__ __forceinline__ int kswz(int r) { return DQK == 128 ? ((r & 15) << 4) : (((r >> 1) & 7) << 4); }
template <int DQK> struct Cfg {
    static constexpr int KCH = DQK / 8, NKC = 64 * KCH / 512, ROWB = DQK * 2;
    static constexpr int SHM_K = 64 * DQK * 2, SHM_V = 64 * 128 * 2;
    static constexpr float SCALE = DQK == 128 ? 0.088388347648318440f : 0.072168783648703220f;
};
template <int DQK> __device__ __forceinline__ void partialSM(f32x16& p0, f32x16& p1, float& m_reg, float& mn, float& alpha) {
    constexpr float SCALE = Cfg<DQK>::SCALE;
    constexpr float C = SCALE * 1.4426950408889634f;
    float pmax = p0[0];
#pragma unroll
    for (int r = 1; r < 16; ++r) pmax = fmaxf(pmax, p0[r]);
#pragma unroll
    for (int r = 0; r < 16; ++r) pmax = fmaxf(pmax, p1[r]);
    { auto rr = __builtin_amdgcn_permlane32_swap(__float_as_uint(pmax), __float_as_uint(pmax), false, false);
      pmax = fmaxf(__uint_as_float(rr[0]), __uint_as_float(rr[1])); }
    if (__builtin_expect(__all(pmax - m_reg <= THR / SCALE), 1)) { mn = m_reg; alpha = 1.f; }
    else { mn = fmaxf(m_reg, pmax); alpha = __builtin_amdgcn_exp2f((m_reg - mn) * C); m_reg = mn; }
    float mnC = -mn * C;
#pragma unroll
    for (int r = 0; r < 16; ++r) p0[r] = fmaf(p0[r], C, mnC);
#pragma unroll
    for (int r = 0; r < 16; ++r) p1[r] = fmaf(p1[r], C, mnC);
#pragma unroll
    for (int r = 0; r < 16; ++r) p0[r] = __builtin_amdgcn_exp2f(p0[r]);
}
__device__ __forceinline__ void finishSM(f32x16& p0, f32x16& p1, float alpha, float& l_reg, bf16x8& pa0, bf16x8& pa1, bf16x8& pa2, bf16x8& pa3) {
#pragma unroll
    for (int r = 0; r < 16; ++r) p1[r] = __builtin_amdgcn_exp2f(p1[r]);
    float ps = 0;
#pragma unroll
    for (int r = 0; r < 16; ++r) ps += p0[r];
#pragma unroll
    for (int r = 0; r < 16; ++r) ps += p1[r];
    { auto rr = __builtin_amdgcn_permlane32_swap(__float_as_uint(ps), __float_as_uint(ps), false, false);
      ps = __uint_as_float(rr[0]) + __uint_as_float(rr[1]); }
    l_reg = l_reg * alpha + ps;
#define PK4(P, BASE, OUT) do { unsigned a0 = cvt_pk_bf16(P[BASE + 0], P[BASE + 1]), a1 = cvt_pk_bf16(P[BASE + 2], P[BASE + 3]);   \
    unsigned b0 = cvt_pk_bf16(P[BASE + 4], P[BASE + 5]), b1 = cvt_pk_bf16(P[BASE + 6], P[BASE + 7]);                              \
    auto r0 = __builtin_amdgcn_permlane32_swap(a0, b0, false, false); auto r1 = __builtin_amdgcn_permlane32_swap(a1, b1, false, false); \
    u32x4 w = {r0[0], r1[0], r0[1], r1[1]}; OUT = *reinterpret_cast<bf16x8*>(&w); } while (0)
    PK4(p0, 0, pa0); PK4(p0, 8, pa1); PK4(p1, 0, pa2); PK4(p1, 8, pa3);
#undef PK4
}
constexpr float THR2 = 8.f;
__device__ __forceinline__ void partialSM2(f32x16& p0, f32x16& p1, float& m_hat, f32x16& negm, float& alpha) {
    float pmax = fmaxf(p0[0], p0[1]);
#pragma unroll
    for (int r = 2; r < 16; ++r) pmax = fmaxf(pmax, p0[r]);
#pragma unroll
    for (int r = 0; r < 16; ++r) pmax = fmaxf(pmax, p1[r]);
    { auto rr = __builtin_amdgcn_permlane32_swap(__float_as_uint(pmax), __float_as_uint(pmax), false, false);
      pmax = fmaxf(__uint_as_float(rr[0]), __uint_as_float(rr[1])); }
    if (__builtin_expect(__all(pmax <= THR2), 1)) { alpha = 1.f; }
    else { const float dl = fmaxf(pmax, 0.f); m_hat += dl; alpha = __builtin_amdgcn_exp2f(-dl);
#pragma unroll
        for (int r = 0; r < 16; ++r) { p0[r] -= dl; p1[r] -= dl; }
#pragma unroll
        for (int r = 0; r < 16; ++r) negm[r] = -m_hat; }
#pragma unroll
    for (int r = 0; r < 16; ++r) p0[r] = __builtin_amdgcn_exp2f(p0[r]);
}
__device__ __forceinline__ void finishSM2(f32x16& p0, f32x16& p1, bf16x8& pa0, bf16x8& pa1, bf16x8& pa2, bf16x8& pa3) {
#pragma unroll
    for (int r = 0; r < 16; ++r) p1[r] = __builtin_amdgcn_exp2f(p1[r]);
#define PK4(P, BASE, OUT) do { unsigned a0 = cvt_pk_bf16(P[BASE + 0], P[BASE + 1]), a1 = cvt_pk_bf16(P[BASE + 2], P[BASE + 3]);   \
    unsigned b0 = cvt_pk_bf16(P[BASE + 4], P[BASE + 5]), b1 = cvt_pk_bf16(P[BASE + 6], P[BASE + 7]);                              \
    auto r0 = __builtin_amdgcn_permlane32_swap(a0, b0, false, false); auto r1 = __builtin_amdgcn_permlane32_swap(a1, b1, false, false); \
    u32x4 w = {r0[0], r1[0], r0[1], r1[1]}; OUT = *reinterpret_cast<bf16x8*>(&w); } while (0)
    PK4(p0, 0, pa0); PK4(p0, 8, pa1); PK4(p1, 0, pa2); PK4(p1, 8, pa3);
#undef PK4
}
template <int DQK> __device__ __forceinline__ void qkt(f32x16& p0, f32x16& p1, const char* Ks, const bf16x8* qr, const char* qrl, int r32, int hi, const f32x16& c0) {
    constexpr int ROWB = Cfg<DQK>::ROWB;
    p0 = c0; p1 = c0;
#pragma unroll
    for (int d0 = 0; d0 < 8; ++d0) { const int cb = (d0 * 16 + hi * 8) * 2;
        bf16x8 b0 = *reinterpret_cast<const bf16x8*>(Ks + r32 * ROWB + (cb ^ kswz<DQK>(r32)));
        bf16x8 b1 = *reinterpret_cast<const bf16x8*>(Ks + (32 + r32) * ROWB + (cb ^ kswz<DQK>(r32)));
        p0 = __builtin_amdgcn_mfma_f32_32x32x16_bf16(b0, qr[d0], p0, 0, 0, 0);
        p1 = __builtin_amdgcn_mfma_f32_32x32x16_bf16(b1, qr[d0], p1, 0, 0, 0);
        if constexpr (DQK == 192) { if (d0 == 3 || d0 == 7) SBAR(); } }
    if constexpr (DQK == 192) {
#pragma unroll
        for (int d0 = 8; d0 < 12; ++d0) { const int cb = (d0 * 16 + hi * 8) * 2;
            const bf16x8 q = *reinterpret_cast<const bf16x8*>(qrl + (d0 - 8) * 1024);
            bf16x8 b0 = *reinterpret_cast<const bf16x8*>(Ks + r32 * ROWB + (cb ^ kswz<DQK>(r32)));
            bf16x8 b1 = *reinterpret_cast<const bf16x8*>(Ks + (32 + r32) * ROWB + (cb ^ kswz<DQK>(r32)));
            p0 = __builtin_amdgcn_mfma_f32_32x32x16_bf16(b0, q, p0, 0, 0, 0);
            p1 = __builtin_amdgcn_mfma_f32_32x32x16_bf16(b1, q, p1, 0, 0, 0); }
    }
}
__device__ __forceinline__ int v_st(int k, int c) { const int kk = (k & ~0xC) | ((k & 4) << 1) | ((k & 8) >> 1); return ((kk >> 3) * 4 + (c >> 5)) * 512 + ((kk & 7) * 32 + (c & 31)) * 2; }
__device__ __forceinline__ int v_rd_base(int lane) { return ((lane & 3) << 3) | (((lane >> 2) & 3) << 6) | (((lane >> 4) & 1) << 5) | (((lane >> 5) & 1) << 8); }
constexpr int v_rd_off(int d0, int ks, int half) { return d0 * 512 + ks * 4096 + half * 2048; }
template <int OFF> __device__ __forceinline__ s16x4 tr_read(int vb) {
    s16x4 r; asm volatile("ds_read_b64_tr_b16 %0, %1 offset:%2" : "=&v"(r) : "v"(vb), "i"(OFF) : "memory"); return r;
}
template <int D0> __device__ __forceinline__ void pv_one(f32x16& od, int vb, bf16x8 pa0, bf16x8 pa1, bf16x8 pa2, bf16x8 pa3) {
    const s16x4 l0 = tr_read<v_rd_off(D0, 0, 0)>(vb), h0 = tr_read<v_rd_off(D0, 0, 1)>(vb), l1 = tr_read<v_rd_off(D0, 1, 0)>(vb), h1 = tr_read<v_rd_off(D0, 1, 1)>(vb);
    const s16x4 l2 = tr_read<v_rd_off(D0, 2, 0)>(vb), h2 = tr_read<v_rd_off(D0, 2, 1)>(vb), l3 = tr_read<v_rd_off(D0, 3, 0)>(vb), h3 = tr_read<v_rd_off(D0, 3, 1)>(vb);
    asm volatile("s_waitcnt lgkmcnt(0)" ::: "memory"); SBAR();
#define PK(L, H) (bf16x8){L[0], L[1], L[2], L[3], H[0], H[1], H[2], H[3]}
    od = __builtin_amdgcn_mfma_f32_32x32x16_bf16(pa0, PK(l0, h0), od, 0, 0, 0);
    od = __builtin_amdgcn_mfma_f32_32x32x16_bf16(pa1, PK(l1, h1), od, 0, 0, 0);
    od = __builtin_amdgcn_mfma_f32_32x32x16_bf16(pa2, PK(l2, h2), od, 0, 0, 0);
    od = __builtin_amdgcn_mfma_f32_32x32x16_bf16(pa3, PK(l3, h3), od, 0, 0, 0);
#undef PK
}
__device__ __forceinline__ void pv_d0(f32x16* o, int vb, bf16x8 pa0, bf16x8 pa1, bf16x8 pa2, bf16x8 pa3) {
    pv_one<0>(o[0], vb, pa0, pa1, pa2, pa3); pv_one<1>(o[1], vb, pa0, pa1, pa2, pa3); pv_one<2>(o[2], vb, pa0, pa1, pa2, pa3); pv_one<3>(o[3], vb, pa0, pa1, pa2, pa3);
}
template <int DQK, int SDEPTH, int LDQ, int LDK, int LDV, int LDO>
__device__ __forceinline__ void attn_body(const bf16* __restrict__ Qb, const bf16* __restrict__ Kh, const bf16* __restrict__ Vh,
                                          bf16* __restrict__ Ob, int seq, char* lds) {
    using C = Cfg<DQK>;
    constexpr int SHM_K = C::SHM_K, SHM_V = C::SHM_V, NKC = C::NKC, KCH = C::KCH, ROWB = C::ROWB;
    int tid_ = threadIdx.x; asm volatile("" : "+v"(tid_));
    const int tid = tid_, wid = tid >> 6, lane = tid & 63, r32 = lane & 31, hi = lane >> 5;
    char* V_lds = lds; char* K_lds = lds + 2 * SHM_V;
    float* ws = (float*)(lds + 2 * SHM_V + 2 * SHM_K) + wid * 64; float* li_l = ws; float* al_l = ws + 32;
    char* QR_lds = lds + 2 * SHM_V + 2 * SHM_K + 2048 + wid * 4096 + lane * 16;
    float m_reg = -1e30f, l_reg = 0; f32x16 o[4] = {}; bf16x8 qr[8];
    const bf16* Qw = Qb + (long)(wid * QBLK + r32) * LDQ + hi * 8;
    __syncthreads();
#pragma unroll
    for (int d0 = 0; d0 < 8; ++d0) qr[d0] = *reinterpret_cast<const bf16x8*>(Qw + d0 * 16);
    if constexpr (DQK == 192) {
#pragma unroll
        for (int d0 = 8; d0 < 12; ++d0) *reinterpret_cast<bf16x8*>(QR_lds + (d0 - 8) * 1024) = *reinterpret_cast<const bf16x8*>(Qw + d0 * 16);
    }
    const int sr = tid >> 4, sc = (tid & 15) * 8, vst0 = v_st(sr, sc), vst1 = v_st(32 + sr, sc);
    int krow[NKC], kcol[NKC], kdst[NKC];
#pragma unroll
    for (int i = 0; i < NKC; ++i) { const int c = tid + 512 * i; krow[i] = c / KCH; kcol[i] = (c % KCH) * 8; kdst[i] = krow[i] * ROWB + ((kcol[i] * 2) ^ kswz<DQK>(krow[i])); }
    const int vb0 = (int)(uintptr_t)V_lds + v_rd_base(lane);
    struct { bf16x8 vs0, vs1, ks[NKC]; } sr_[SDEPTH];
#define SLOAD(i, k0) do { sr_[i].vs0 = *reinterpret_cast<const bf16x8*>(&Vh[(long)((k0) + sr) * LDV + sc]); sr_[i].vs1 = *reinterpret_cast<const bf16x8*>(&Vh[(long)((k0) + 32 + sr) * LDV + sc]); \
    _Pragma("unroll") for (int q_ = 0; q_ < NKC; ++q_) sr_[i].ks[q_] = *reinterpret_cast<const bf16x8*>(&Kh[(long)((k0) + krow[q_]) * LDK + kcol[q_]]); } while (0)
#define SWRITE(b, i) do { *(bf16x8*)(V_lds + (b) * SHM_V + vst0) = sr_[i].vs0; *(bf16x8*)(V_lds + (b) * SHM_V + vst1) = sr_[i].vs1; \
    _Pragma("unroll") for (int q_ = 0; q_ < NKC; ++q_) *(bf16x8*)(K_lds + (b) * SHM_K + kdst[q_]) = sr_[i].ks[q_]; } while (0)
#define SWAIT() do { if constexpr (SDEPTH == 2) { if constexpr (NKC == 2) asm volatile("s_waitcnt vmcnt(4)" ::: "memory"); else asm volatile("s_waitcnt vmcnt(5)" ::: "memory"); } else asm volatile("s_waitcnt vmcnt(0)" ::: "memory"); } while (0)
#define RESC(a) do { if (__any((a) < 1.f)) { if (hi == 0) al_l[r32] = (a); asm volatile("s_waitcnt lgkmcnt(0)" ::: "memory"); \
    _Pragma("unroll") for (int d = 0; d < 4; ++d) _Pragma("unroll") for (int r = 0; r < 16; ++r) o[d][r] *= al_l[crow(r, hi)]; } } while (0)
    f32x16 pA0, pA1, pB0, pB1; float mnA, mnB, alA, alB; bf16x8 pa0, pa1, pa2, pa3; const int NT = seq / KVBLK;
    constexpr int SE = 0, SO = SDEPTH - 1;
    SLOAD(SE, 0); asm volatile("s_waitcnt vmcnt(0)" ::: "memory"); SWRITE(0, SE); __syncthreads();
    qkt<DQK>(pA0, pA1, K_lds, qr, QR_lds, r32, hi, f32x16{}); partialSM<DQK>(pA0, pA1, m_reg, mnA, alA);
    SLOAD(SO, KVBLK); if constexpr (SDEPTH == 2) { if (2 < NT) SLOAD(SE, 2 * KVBLK); }
    SWAIT(); SWRITE(1, SO); __syncthreads();
    for (int j = 1; j + 1 < NT; j += 2) {
        SBAR(); qkt<DQK>(pB0, pB1, K_lds + SHM_K, qr, QR_lds, r32, hi, f32x16{});
        finishSM(pA0, pA1, alA, l_reg, pa0, pa1, pa2, pa3); SBAR();
        SLOAD(SO, (j + SDEPTH) * KVBLK); SBAR();
        pv_d0(o, vb0, pa0, pa1, pa2, pa3); partialSM<DQK>(pB0, pB1, m_reg, mnB, alB);
        __syncthreads(); SWAIT(); SWRITE(0, SE);
        RESC(alB); __syncthreads();
        SBAR(); qkt<DQK>(pA0, pA1, K_lds, qr, QR_lds, r32, hi, f32x16{});
        finishSM(pB0, pB1, alB, l_reg, pa0, pa1, pa2, pa3); SBAR();
        if (SDEPTH == 1 || j + 3 < NT) SLOAD(SE, (j + 1 + SDEPTH) * KVBLK); SBAR();
        pv_d0(o, vb0 + (int)SHM_V, pa0, pa1, pa2, pa3); partialSM<DQK>(pA0, pA1, m_reg, mnA, alA);
        __syncthreads(); SWAIT(); SWRITE(1, SO);
        RESC(alA); __syncthreads();
    }
    SBAR(); qkt<DQK>(pB0, pB1, K_lds + SHM_K, qr, QR_lds, r32, hi, f32x16{});
    finishSM(pA0, pA1, alA, l_reg, pa0, pa1, pa2, pa3); SBAR();
    pv_d0(o, vb0, pa0, pa1, pa2, pa3); partialSM<DQK>(pB0, pB1, m_reg, mnB, alB);
    __syncthreads(); RESC(alB);
    finishSM(pB0, pB1, alB, l_reg, pa0, pa1, pa2, pa3); SBAR();
    pv_d0(o, vb0 + (int)SHM_V, pa0, pa1, pa2, pa3);
    if (hi == 0) li_l[r32] = l_reg; asm volatile("s_waitcnt lgkmcnt(0)" ::: "memory");
    float rli[16];
#pragma unroll
    for (int r = 0; r < 16; ++r) rli[r] = __builtin_amdgcn_rcpf(li_l[crow(r, hi)]);
    bf16* Ow = Ob + (long)(wid * QBLK) * LDO;
#pragma unroll
    for (int r = 0; r < 16; ++r) { const int orow = crow(r, hi);
#pragma unroll
        for (int d0 = 0; d0 < 4; ++d0) Ow[(long)orow * LDO + d0 * 32 + r32] = f2bf(o[d0][r] * rli[r]); }
#undef SLOAD
#undef SWRITE
#undef SWAIT
#undef RESC
}

template <int DQK, int LDQ, int LDK, int LDV, int LDO>
__device__ __forceinline__ void attn_body_s(const bf16* __restrict__ Qb, const bf16* __restrict__ Kh, const bf16* __restrict__ Vh,
                                            bf16* __restrict__ Ob, int seq, char* lds, int dup) {
    using C = Cfg<DQK>;
    constexpr int SHM_K = C::SHM_K, SHM_V = C::SHM_V, NKC = C::NKC, KCH = C::KCH, ROWB = C::ROWB;
    int tid_ = threadIdx.x; asm volatile("" : "+v"(tid_));
    const int tid = tid_, wid = __builtin_amdgcn_readfirstlane(tid >> 6), lane = tid & 63, r32 = lane & 31, hi = lane >> 5;
    const bool late = false;
    char* V_lds = lds; char* K_lds = lds + 3 * SHM_V;
    float* ws = (float*)(lds + 3 * SHM_V + 2 * SHM_K) + wid * 64; float* li_l = ws; float* al_l = ws + 32;
    char* QR_lds = lds + 3 * SHM_V + 2 * SHM_K + 2048 + wid * 4096 + lane * 16;
    float m_reg = 0.f; f32x16 o[4] = {}; f32x16 negm = {}, lsum = {}; bf16x8 qr[8];
    const bf16x8 ones = {0x3F80, 0x3F80, 0x3F80, 0x3F80, 0x3F80, 0x3F80, 0x3F80, 0x3F80};
    const bf16* Qw = Qb + (long)(wid * QBLK + r32) * LDQ + hi * 8;
    __syncthreads();
#pragma unroll
    for (int d0 = 0; d0 < 8; ++d0) qr[d0] = *reinterpret_cast<const bf16x8*>(Qw + d0 * 16);
    if constexpr (DQK == 192) {
#pragma unroll
        for (int d0 = 8; d0 < 12; ++d0) *reinterpret_cast<bf16x8*>(QR_lds + (d0 - 8) * 1024) = *reinterpret_cast<const bf16x8*>(Qw + d0 * 16);
    }
    const int sr = tid >> 4, sc = (tid & 15) * 8, vst0 = v_st(sr, sc), vst1 = v_st(32 + sr, sc);
    int ksrc[NKC], kdst[NKC];
#pragma unroll
    for (int i = 0; i < NKC; ++i) { const int c = tid + 512 * i, kr = c / KCH, kc = (c % KCH) * 8; ksrc[i] = kr * LDK + kc; kdst[i] = kr * ROWB + ((kc * 2) ^ kswz<DQK>(kr)); }
    const int vb0 = (int)(uintptr_t)V_lds + v_rd_base(lane);
    bf16x8 vs0, vs1, ks[NKC];
#define SLOAD(k0) do { vs0 = *reinterpret_cast<const bf16x8*>(&Vh[(long)((k0) + sr) * LDV + sc]); vs1 = *reinterpret_cast<const bf16x8*>(&Vh[(long)((k0) + 32 + sr) * LDV + sc]); \
    _Pragma("unroll") for (int q_ = 0; q_ < NKC; ++q_) ks[q_] = *reinterpret_cast<const bf16x8*>(&Kh[(long)(k0) * LDK + ksrc[q_]]); } while (0)
#define SWRITE(kb, vslot) do { *(bf16x8*)(V_lds + (vslot) * SHM_V + vst0) = vs0; *(bf16x8*)(V_lds + (vslot) * SHM_V + vst1) = vs1; \
    _Pragma("unroll") for (int q_ = 0; q_ < NKC; ++q_) *(bf16x8*)(K_lds + (kb) * SHM_K + kdst[q_]) = ks[q_]; } while (0)
    const int NT = seq / KVBLK;
    SLOAD(0); SWRITE(0, 0); SLOAD(KVBLK);
    __syncthreads();
    int vcur = 0, vnext = 1, vprev = 2;
    bf16x8 pa0, pa1, pa2, pa3;
    pa0 = bf16x8{}; pa1 = bf16x8{}; pa2 = bf16x8{}; pa3 = bf16x8{};
    for (int j = 0; j < NT; ++j) {
        const int b = j & 1;
        f32x16 p0, p1; float mn, al;
        if (late && j > 0) { pv_d0(o, vb0 + vprev * (int)SHM_V, pa0, pa1, pa2, pa3); }
        SBAR(); qkt<DQK>(p0, p1, K_lds + b * SHM_K, qr, QR_lds, r32, hi, negm);
        if ((PROBE_ATT & 1) && dup) { mn = 0.f; al = 1.f; } else
        partialSM2(p0, p1, m_reg, negm, al); SBAR();
        if (!((PROBE_ATT & 4) && dup)) {
        if (j + 1 < NT) { SWRITE(b ^ 1, vnext); }
        if (j + 2 < NT) { SLOAD((j + 2) * KVBLK); } }
        SBAR();
        if (__any(al < 1.f)) { if (hi == 0) al_l[r32] = al; asm volatile("s_waitcnt lgkmcnt(0)" ::: "memory");
#pragma unroll
            for (int d = 0; d < 4; ++d)
#pragma unroll
                for (int r = 0; r < 16; ++r) o[d][r] *= al_l[crow(r, hi)];
#pragma unroll
            for (int r = 0; r < 16; ++r) lsum[r] *= al_l[crow(r, hi)]; }
        if ((PROBE_ATT & 1) && dup) { pa0 = __builtin_bit_cast(bf16x8, (u32x4){cvt_pk_bf16(p0[0], p0[1]), cvt_pk_bf16(p0[2], p0[3]), cvt_pk_bf16(p0[4], p0[5]), cvt_pk_bf16(p0[6], p0[7])});
            pa1 = __builtin_bit_cast(bf16x8, (u32x4){cvt_pk_bf16(p0[8], p0[9]), cvt_pk_bf16(p0[10], p0[11]), cvt_pk_bf16(p0[12], p0[13]), cvt_pk_bf16(p0[14], p0[15])});
            pa2 = __builtin_bit_cast(bf16x8, (u32x4){cvt_pk_bf16(p1[0], p1[1]), cvt_pk_bf16(p1[2], p1[3]), cvt_pk_bf16(p1[4], p1[5]), cvt_pk_bf16(p1[6], p1[7])});
            pa3 = __builtin_bit_cast(bf16x8, (u32x4){cvt_pk_bf16(p1[8], p1[9]), cvt_pk_bf16(p1[10], p1[11]), cvt_pk_bf16(p1[12], p1[13]), cvt_pk_bf16(p1[14], p1[15])}); } else
        finishSM2(p0, p1, pa0, pa1, pa2, pa3); SBAR();
        lsum = __builtin_amdgcn_mfma_f32_32x32x16_bf16(pa0, ones, lsum, 0, 0, 0); lsum = __builtin_amdgcn_mfma_f32_32x32x16_bf16(pa1, ones, lsum, 0, 0, 0);
        lsum = __builtin_amdgcn_mfma_f32_32x32x16_bf16(pa2, ones, lsum, 0, 0, 0); lsum = __builtin_amdgcn_mfma_f32_32x32x16_bf16(pa3, ones, lsum, 0, 0, 0);
        if (!late && !((PROBE_ATT & 2) && dup)) { pv_d0(o, vb0 + vcur * (int)SHM_V, pa0, pa1, pa2, pa3); }
        if (!((PROBE_ATT & 8) && dup)) __syncthreads();
        { const int t = vprev; vprev = vcur; vcur = vnext; vnext = t; }
    }
    if (late) { pv_d0(o, vb0 + vprev * (int)SHM_V, pa0, pa1, pa2, pa3); }
    float rli[16];
#pragma unroll
    for (int r = 0; r < 16; ++r) rli[r] = __builtin_amdgcn_rcpf(lsum[r]);
    bf16* Ow = Ob + (long)(wid * QBLK) * LDO;
    char* stg = lds + wid * (32 * 272);
#pragma unroll
    for (int r = 0; r < 16; ++r) { const int orow = crow(r, hi);
#pragma unroll
        for (int d0 = 0; d0 < 4; ++d0) *reinterpret_cast<unsigned short*>(stg + orow * 272 + (d0 * 32 + r32) * 2) = f2bf(o[d0][r] * rli[r]); }
    asm volatile("s_waitcnt lgkmcnt(0)" ::: "memory");
#pragma unroll
    for (int it = 0; it < 8; ++it) { const int row = it * 4 + (lane >> 4), ch = lane & 15;
        const u32x4 v = *reinterpret_cast<const u32x4*>(stg + row * 272 + ch * 16);
        *reinterpret_cast<u32x4*>(Ow + (long)row * LDO + ch * 8) = v; }
#undef SLOAD
#undef SWRITE
}
#undef SBAR
}

struct Args { const float* in[28]; float* out; unsigned char* ws; int ph_lo, ph_hi, coop, pad; };
typedef const __attribute__((address_space(4))) Args CArgs;
enum { I_X = 0, I_C, I_CTX, I_CCTX, I_WMOD, I_BMOD, I_N1G, I_N2G, I_WIN, I_AQN, I_AKN, I_BQLN, I_BKVLN, I_WUQ, I_WUKV, I_BQNN, I_BKNN, I_BQRN, I_BKRN,
       I_WGKF, I_BGKF, I_WGKB, I_BGKB, I_CON, I_WOUT, I_WGATE, I_WUP, I_WDOWN };

__device__ __forceinline__ unsigned pk2(float lo, float hi) { return cvt_pk_bf16(lo, hi); }
struct TrDesc { const float* W; bf16_t* WT; int K, N, grp, gstride, off, item; };
__device__ __forceinline__ void tr_load(const TrDesc& t, f32x4 (&v)[16], int lane) {
    const int nblk = (t.N + 63) / 64, kb = t.item / nblk, nb = t.item % nblk, k0 = 64 * kb, n0 = 64 * nb;
    const int kr = lane >> 4, c = lane & 15; const bool valid = n0 + 4 * c < t.N;
#pragma unroll
    for (int i = 0; i < 16; ++i) v[i] = valid ? *(const f32x4*)(t.W + (size_t)(k0 + 4 * i + kr) * t.N + n0 + 4 * c) : (f32x4){0.f, 0.f, 0.f, 0.f};
}
__device__ __forceinline__ void tr_store(const TrDesc& t, const f32x4 (&v)[16], LAS float* scr, int lane) {
    const int nblk = (t.N + 63) / 64, kb = t.item / nblk, nb = t.item % nblk, k0 = 64 * kb, n0 = 64 * nb;
    const int drow0 = (n0 / t.grp) * t.gstride + (n0 % t.grp) + t.off;
    const int kr = lane >> 4, c = lane & 15;
#pragma unroll
    for (int i = 0; i < 16; ++i) { LAS float* p = scr + (4 * i + kr) * 65 + 4 * c; p[0] = v[i].x; p[1] = v[i].y; p[2] = v[i].z; p[3] = v[i].w; }
    asm volatile("s_waitcnt lgkmcnt(0)" ::: "memory");
    const int c8 = lane & 7, nl = lane >> 3;
#pragma unroll
    for (int j = 0; j < 8; ++j) { const int n = nl + 8 * j; const LAS float* s = scr + (8 * c8) * 65 + n;
        u32x4 o; o.x = pk2(s[0 * 65], s[1 * 65]); o.y = pk2(s[2 * 65], s[3 * 65]); o.z = pk2(s[4 * 65], s[5 * 65]); o.w = pk2(s[6 * 65], s[7 * 65]);
        if (n0 + n < t.N) *(u32x4*)(t.WT + (size_t)(drow0 + n) * t.K + k0 + 8 * c8) = o; }
    asm volatile("s_waitcnt lgkmcnt(0)" ::: "memory");
}
constexpr int TR_IN = 32 * 62, TR_UQ = 8 * 12, TR_UKV = 4 * 16, TR_OUT = 32 * 32, TR_G = 32 * 88, TR_D = 88 * 32, TR_L = TR_IN + TR_UQ + TR_UKV + TR_OUT + 2 * TR_G + TR_D;
__device__ __forceinline__ TrDesc tr_decode(CArgs& a, int it) {
    constexpr int BIG = 1 << 30;
    const int l = it / TR_L; int r = it % TR_L;
    unsigned char* wb = a.ws + WS_W + (size_t)l * W_LAYER;
    if (r < TR_IN) return TrDesc{a.in[I_WIN] + (size_t)l * DM * INC, (bf16_t*)(wb + WO_IN), DM, INC, BIG, 0, 0, r}; r -= TR_IN;
    if (r < TR_UQ) return TrDesc{a.in[I_WUQ] + (size_t)l * 512 * 768, (bf16_t*)(wb + WO_UQ), 512, 768, BIG, 0, 0, r}; r -= TR_UQ;
    if (r < TR_UKV) return TrDesc{a.in[I_WUKV] + (size_t)l * 256 * 1024, (bf16_t*)(wb + WO_UKV), 256, 1024, BIG, 0, 0, r}; r -= TR_UKV;
    if (r < TR_OUT) return TrDesc{a.in[I_WOUT] + (size_t)l * DM * DM, (bf16_t*)(wb + WO_OUT), DM, DM, BIG, 0, 0, r}; r -= TR_OUT;
    if (r < TR_G) return TrDesc{a.in[I_WGATE] + (size_t)l * DM * DFF, (bf16_t*)(wb + WO_GU), DM, DFF, 128, 256, 0, r}; r -= TR_G;
    if (r < TR_G) return TrDesc{a.in[I_WUP] + (size_t)l * DM * DFF, (bf16_t*)(wb + WO_GU), DM, DFF, 128, 256, 128, r}; r -= TR_G;
    return TrDesc{a.in[I_WDOWN] + (size_t)l * DFF * DM, (bf16_t*)(wb + WO_DN), DFF, DM, BIG, 0, 0, r};
}
__device__ __forceinline__ void transposes_dynamic(CArgs& a, LAS unsigned char* lds, int layer) {
    int tid = threadIdx.x; asm volatile("" : "+v"(tid));
    const int lane = tid & 63, wid = tid >> 6;
    LAS float* scr = (LAS float*)(lds + wid * 16640);
    unsigned* ctr = (unsigned*)(a.ws + WS_CTL) + CW_QUEUE + 128 + 64 * layer;
    for (;;) {
        unsigned base = 0; if (lane == 0) base = atomicAdd(ctr, 2u);
        const int it = __builtin_amdgcn_readfirstlane(base);
        if (it >= TR_L) break;
        const bool two = it + 1 < TR_L;
        const TrDesc t0 = tr_decode(a, layer * TR_L + it), t1 = tr_decode(a, layer * TR_L + (two ? it + 1 : it));
        f32x4 v0[16], v1[16];
        tr_load(t0, v0, lane); tr_load(t1, v1, lane);
        tr_store(t0, v0, scr, lane);
        if (two) tr_store(t1, v1, scr, lane);
    }
}
__device__ __forceinline__ void phase_prologue(CArgs& a, LAS unsigned char* lds) {
    int tid = threadIdx.x; asm volatile("" : "+v"(tid));
    const int lane = tid & 63, wid = tid >> 6;
    LAS float* scr = (LAS float*)(lds + wid * 16384);
    const int gw = blockIdx.x * 8 + wid, NGW = gridDim.x * 8;
    float* MOD = (float*)(a.ws + WS_MOD);
    for (int it = blockIdx.x; it < 2 * 96; it += gridDim.x) {
        const int l = it / 96, jb = it % 96;
        __syncthreads();
#pragma unroll
        for (int q = 0; q < 4; ++q) { const int k = wid * 256 + q * 64 + lane;
#pragma unroll
            for (int v = 0; v < 5; ++v) { const float cv = (v < 4) ? a.in[I_C][v * DM + k] : a.in[I_CCTX][k]; scr[v * 256 + q * 64 + lane] = silu_f(cv); } }
        asm volatile("s_waitcnt lgkmcnt(0)" ::: "memory");
        const float* W = a.in[I_WMOD] + (size_t)l * DM * 12288 + (size_t)(wid * 256) * 12288 + jb * 128 + lane * 2;
        f32x2 acc[5];
#pragma unroll
        for (int v = 0; v < 5; ++v) acc[v] = (f32x2){0.f, 0.f};
        for (int k0 = 0; k0 < 256; k0 += 64) { f32x2 wv[64];
#pragma unroll
            for (int e = 0; e < 64; ++e) wv[e] = *(const f32x2*)(W + (size_t)(k0 + e) * 12288);
#pragma unroll
            for (int e = 0; e < 64; ++e) { const int kk = k0 + e; const f32x2 w = wv[e];
#pragma unroll
            for (int v = 0; v < 5; ++v) acc[v] += scr[v * 256 + kk] * w; } }
#pragma unroll
        for (int v = 0; v < 5; ++v) *(LAS f32x2*)(scr + 2048 + v * 128 + lane * 2) = acc[v];
        __syncthreads();
        if (wid < 5) { f32x2 sum = *(const f32x2*)(a.in[I_BMOD] + l * 12288 + jb * 128 + lane * 2);
#pragma unroll
            for (int w = 0; w < 8; ++w) sum += *(const LAS f32x2*)((LAS float*)(lds + w * 16384) + 2048 + wid * 128 + lane * 2);
            *(f32x2*)(MOD + (size_t)(l * 5 + wid) * 12288 + jb * 128 + lane * 2) = sum; }
    }
    __syncthreads();
    transposes_dynamic(a, lds, 0); transposes_dynamic(a, lds, 1);
    for (int l = 0; l < 2; ++l) { u32x4* z = (u32x4*)(a.ws + WS_W + (size_t)l * W_LAYER + WO_IN + (size_t)INC * DM * 2);
        for (int i = blockIdx.x * 512 + tid; i < (INP - INC) * DM * 2 / 16; i += gridDim.x * 512) z[i] = (u32x4){0u, 0u, 0u, 0u}; }
}

__device__ __forceinline__ void phase_norm(CArgs& a, int l, int which) {
    int tid = threadIdx.x; asm volatile("" : "+v"(tid));
    const int lane = tid & 63, wid = tid >> 6;
    const int gw = blockIdx.x * 8 + wid, NGW = gridDim.x * 8;
    const float* MOD = (const float*)(a.ws + WS_MOD) + (size_t)l * 5 * 12288;
    const float* MOD0 = (const float*)(a.ws + WS_MOD);
    const float* gn = a.in[which ? I_N2G : I_N1G] + l * DM;
    float* XR = (float*)(a.ws + WS_XR);
    const float* PART = (const float*)a.out + PART_OFF;
    bf16_t* H = (bf16_t*)(a.ws + WS_HZ);
    const bool skip = (l == 1 && which == 1);
    const int npart = (l == 0 && which == 1) ? 8 : ((l == 1 && which == 0) ? 4 : 0);
    for (int r0 = gw; r0 < NR; r0 += 2 * NGW) {
        f32x4 x[2][8]; const float* sh[2]; const float* sc[2]; bool ok[2];
#pragma unroll
        for (int u = 0; u < 2; ++u) { const int r = r0 + u * NGW; ok[u] = r < NR; const int rr = ok[u] ? r : r0;
            const int b = rr / TOK, i = rr - b * TOK, v = (i < CTXL) ? 4 : b;
            if (skip && i < CTXL) ok[u] = false;
            const bool first = (l == 0 && which == 0), ctxsplit = (npart == 8 && i < CTXL);
            const float* src = (first || ctxsplit) ? (i < CTXL ? a.in[I_CTX] + ((size_t)b * CTXL + i) * DM : a.in[I_X] + ((size_t)b * SEQ + (i - CTXL)) * DM) : XR + (size_t)rr * DM;
            sh[u] = MOD + (size_t)v * 12288 + (which * 3 + 0) * DM; sc[u] = MOD + (size_t)v * 12288 + (which * 3 + 1) * DM;
#pragma unroll
            for (int j = 0; j < 8; ++j) x[u][j] = *(const f32x4*)(src + 4 * lane + 256 * j);
            if (npart && i < CTXL) {
                const float* gt = MOD0 + (size_t)4 * 12288 + (npart == 8 ? 2 : 5) * DM;
                f32x4 ps[8];
#pragma unroll
                for (int j = 0; j < 8; ++j) ps[j] = (f32x4){0.f, 0.f, 0.f, 0.f};
                for (int p = 0; p < npart; ++p)
#pragma unroll
                    for (int j = 0; j < 8; ++j) ps[j] += *(const f32x4*)(PART + ((size_t)(p * 32 + b * 8 + j) << 16) + i * 256 + 4 * lane);
#pragma unroll
                for (int j = 0; j < 8; ++j) { x[u][j] += *(const f32x4*)(gt + 4 * lane + 256 * j) * ps[j]; *(f32x4*)(XR + (size_t)rr * DM + 4 * lane + 256 * j) = x[u][j]; }
            } }
#pragma unroll
        for (int u = 0; u < 2; ++u) { float ss = 0.f;
#pragma unroll
            for (int j = 0; j < 8; ++j) ss += (x[u][j].x * x[u][j].x + x[u][j].y * x[u][j].y) + (x[u][j].z * x[u][j].z + x[u][j].w * x[u][j].w);
            const float rs = rsqrtf(wave_sum(ss) * (1.f / DM) + EPS);
            if (!ok[u]) continue;
            bf16_t* o = H + (size_t)(r0 + u * NGW) * DM;
#pragma unroll
            for (int j = 0; j < 8; ++j) { const int c = 4 * lane + 256 * j; const f32x4 g = *(const f32x4*)(gn + c), s1 = *(const f32x4*)(sc[u] + c), s0 = *(const f32x4*)(sh[u] + c);
                const f32x4 y = (x[u][j] * rs) * g * (1.f + s1) + s0;
                u32x2 w; w.x = cvt_pk_bf16(y.x, y.y); w.y = cvt_pk_bf16(y.z, y.w); *(u32x2*)(o + c) = w; } }
    }
}

__device__ __forceinline__ void rope128(float& y0, float& y1, int lane, int prow, int pcol) {
    const float pos = (float)(lane < 32 ? prow : pcol);
    const int i0 = (2 * lane) & 31;
    const float f0 = __builtin_amdgcn_exp2f(-(float)i0 * (13.287712379549449f / 32.f)), f1 = __builtin_amdgcn_exp2f(-(float)(i0 + 1) * (13.287712379549449f / 32.f));
    const float a0 = pos * f0, a1 = pos * f1;
    const float c0 = __cosf(a0), s0 = __sinf(a0), c1 = __cosf(a1), s1 = __sinf(a1);
    const float p0 = __shfl_xor(y0, 16), p1 = __shfl_xor(y1, 16);
    if (((lane >> 4) & 1) == 0) { y0 = y0 * c0 - p0 * s0; y1 = y1 * c1 - p1 * s1; }
    else { y0 = p0 * s0 + y0 * c0; y1 = p1 * s1 + y1 * c1; }
}
__device__ __forceinline__ void rope64(float& y0, float& y1, int lane, int prow, int pcol) {
    const int l = lane & 31;
    const float pos = (float)(l < 16 ? prow : pcol);
    const int i0 = (2 * l) & 15;
    const float f0 = __builtin_amdgcn_exp2f(-(float)i0 * (13.287712379549449f / 16.f)), f1 = __builtin_amdgcn_exp2f(-(float)(i0 + 1) * (13.287712379549449f / 16.f));
    const float a0 = pos * f0, a1 = pos * f1;
    const float c0 = __cosf(a0), s0 = __sinf(a0), c1 = __cosf(a1), s1 = __sinf(a1);
    const float p0 = __shfl_xor(y0, 8), p1 = __shfl_xor(y1, 8);
    if (((l >> 3) & 1) == 0) { y0 = y0 * c0 - p0 * s0; y1 = y1 * c1 - p1 * s1; }
    else { y0 = p0 * s0 + y0 * c0; y1 = p1 * s1 + y1 * c1; }
}

struct E1Regs { u32x4 hq[3]; u32x4 cqw; u32x2 ckw; unsigned krw; };
__device__ __forceinline__ void e1_load(CArgs& a, int r, int lane, E1Regs& g) {
    const bf16_t* P0 = (const bf16_t*)(a.ws + WS_PROJ) + (size_t)r * INP;
#pragma unroll
    for (int t = 0; t < 3; ++t) g.hq[t] = *((const u32x4*)(P0 + t * 512) + lane);
    g.cqw = *((const u32x4*)(P0 + C_BCQ) + lane);
    g.ckw = *((const u32x2*)(P0 + C_BCKV) + lane);
    g.krw = *((const unsigned*)(P0 + C_BKR) + (lane & 31));
}
__device__ __forceinline__ void e1_row(CArgs& a, int l, int r, int lane, int dup, const E1Regs& g) {
    bf16_t* P0 = (bf16_t*)(a.ws + WS_PROJ) + (size_t)r * INP;
    bf16_t* P = dup ? (bf16_t*)((float*)a.out + (10u << 20)) + (size_t)r * 2368 : P0;
    const int i = r % TOK; const bool lat = i >= CTXL; const int n = i - CTXL, prow = n >> 6, pcol = n & 63;
    { const int li = lane & 15, hsub = lane >> 4;
      const float pos = (float)(li < 8 ? prow : pcol); const bool second = ((li >> 2) & 1) != 0;
      float cs[8], sn[8];
      if (lat) {
#pragma unroll
          for (int e = 0; e < 8; ++e) { const float ang = pos * __builtin_amdgcn_exp2f(-(float)(8 * (li & 3) + e) * (13.287712379549449f / 32.f)); cs[e] = __cosf(ang); sn[e] = __sinf(ang); } }
#pragma unroll
      for (int t = 0; t < 3; ++t) { const int hh = 4 * t + hsub; const u32x4 w = g.hq[t];
          float x[8] = {bflo(w.x), bfhi(w.x), bflo(w.y), bfhi(w.y), bflo(w.z), bfhi(w.z), bflo(w.w), bfhi(w.w)};
          float ss = 0.f;
#pragma unroll
          for (int e = 0; e < 8; ++e) ss += x[e] * x[e];
#pragma unroll
          for (int m = 1; m < 16; m <<= 1) ss += __shfl_xor(ss, m);
          const float rs = rsqrtf(ss * (1.f / 128.f) + EPS) * (hh < 8 ? QSCALE_A : 1.f);
          const float* gg = a.in[hh < 8 ? I_AQN : I_AKN] + l * 128 + 8 * li;
          const f32x4 ga = *(const f32x4*)gg, gb = *(const f32x4*)(gg + 4);
          float y[8] = {x[0] * rs * ga.x, x[1] * rs * ga.y, x[2] * rs * ga.z, x[3] * rs * ga.w, x[4] * rs * gb.x, x[5] * rs * gb.y, x[6] * rs * gb.z, x[7] * rs * gb.w};
          if (lat) {
#pragma unroll
              for (int e = 0; e < 8; ++e) { const float p = __shfl_xor(y[e], 4); y[e] = second ? (p * sn[e] + y[e] * cs[e]) : (y[e] * cs[e] - p * sn[e]); } }
          u32x4 o; o.x = cvt_pk_bf16(y[0], y[1]); o.y = cvt_pk_bf16(y[2], y[3]); o.z = cvt_pk_bf16(y[4], y[5]); o.w = cvt_pk_bf16(y[6], y[7]);
          if (hh < 10) *((u32x4*)(P + t * 512) + lane) = o; } }
    { const u32x4 w = g.cqw;
        float x[8] = {bflo(w.x), bfhi(w.x), bflo(w.y), bfhi(w.y), bflo(w.z), bfhi(w.z), bflo(w.w), bfhi(w.w)};
        float ss = 0.f;
#pragma unroll
        for (int e = 0; e < 8; ++e) ss += x[e] * x[e];
        const float rs = rsqrtf(wave_sum(ss) * (1.f / 512.f) + EPS);
        const float* gg = a.in[I_BQLN] + l * 512 + 8 * lane;
        u32x4 o; o.x = cvt_pk_bf16(x[0] * rs * gg[0], x[1] * rs * gg[1]); o.y = cvt_pk_bf16(x[2] * rs * gg[2], x[3] * rs * gg[3]);
        o.z = cvt_pk_bf16(x[4] * rs * gg[4], x[5] * rs * gg[5]); o.w = cvt_pk_bf16(x[6] * rs * gg[6], x[7] * rs * gg[7]); *((u32x4*)(P + C_BCQ) + lane) = o;
    }
    { const u32x2 w = g.ckw;
        float x[4] = {bflo(w.x), bfhi(w.x), bflo(w.y), bfhi(w.y)};
        const float rs = rsqrtf(wave_sum(x[0] * x[0] + x[1] * x[1] + x[2] * x[2] + x[3] * x[3]) * (1.f / 256.f) + EPS);
        const float* gg = a.in[I_BKVLN] + l * 256 + 4 * lane;
        u32x2 o; o.x = cvt_pk_bf16(x[0] * rs * gg[0], x[1] * rs * gg[1]); o.y = cvt_pk_bf16(x[2] * rs * gg[2], x[3] * rs * gg[3]); *((u32x2*)(P + C_BCKV) + lane) = o;
    }
    { const unsigned w = g.krw;
        float x0 = lane < 32 ? bflo(w) : 0.f, x1 = lane < 32 ? bfhi(w) : 0.f;
        const float rs = rsqrtf(wave_sum(x0 * x0 + x1 * x1) * (1.f / 64.f) + EPS);
        const float* gg = a.in[I_BKRN] + l * 64 + 2 * (lane & 31);
        float y0 = x0 * rs * gg[0], y1 = x1 * rs * gg[1];
        if (lat) rope64(y0, y1, lane, prow, pcol);
        if (lane < 32) *((unsigned*)(P + C_BKR) + lane) = cvt_pk_bf16(y0, y1);
    }
}
struct E2Regs { u32x4 qn, qr, kn, kr; };
__device__ __forceinline__ void e2_load(CArgs& a, int r, int lane, E2Regs& g) {
    const bf16_t* Q0 = (const bf16_t*)(a.ws + WS_QB) + (size_t)r * 768;
    const bf16_t* KV = (const bf16_t*)(a.ws + WS_KVB) + (size_t)r * 1024;
    const bf16_t* P = (const bf16_t*)(a.ws + WS_PROJ) + (size_t)r * INP;
    const int h16 = lane >> 4, li = lane & 15, h8 = (lane >> 3) & 3, li8 = lane & 7;
    g.qn = *(const u32x4*)(Q0 + h16 * 192 + 8 * li);
    g.qr = *(const u32x4*)(Q0 + h8 * 192 + 128 + 8 * li8);
    g.kn = *(const u32x4*)(KV + h16 * 256 + 8 * li);
    g.kr = *(const u32x4*)(P + C_BKR + 8 * li8);
}
__device__ __forceinline__ void e2_row(CArgs& a, int l, int r, int lane, int dup, const E2Regs& g) {
    bf16_t* Q = dup ? (bf16_t*)((float*)a.out + (10u << 20)) + (size_t)r * 768 : (bf16_t*)(a.ws + WS_QB) + (size_t)r * 768;
    bf16_t* KB = dup ? (bf16_t*)((float*)a.out + (18u << 20)) + (size_t)r * 768 : (bf16_t*)(a.ws + WS_KB) + (size_t)r * 768;
    const int i = r % TOK; const bool lat = i >= CTXL; const int n = i - CTXL, prow = n >> 6, pcol = n & 63;
    const int h16 = lane >> 4, li = lane & 15, h8 = (lane >> 3) & 3, li8 = lane & 7;
#define E2_UNPK(wv_, arr_) float arr_[8] = {bflo(wv_[0]), bfhi(wv_[0]), bflo(wv_[1]), bfhi(wv_[1]), bflo(wv_[2]), bfhi(wv_[2]), bflo(wv_[3]), bfhi(wv_[3])}
    { E2_UNPK(g.qn, x); float ss = 0.f;
#pragma unroll
      for (int e = 0; e < 8; ++e) ss += x[e] * x[e];
#pragma unroll
      for (int m = 1; m < 16; m <<= 1) ss += __shfl_xor(ss, m);
      const float rs = rsqrtf(ss * (1.f / 128.f) + EPS) * QSCALE_B;
      const float* gg = a.in[I_BQNN] + l * 128 + 8 * li; const f32x4 ga = *(const f32x4*)gg, gb = *(const f32x4*)(gg + 4);
      u32x4 o; o.x = cvt_pk_bf16(x[0] * rs * ga.x, x[1] * rs * ga.y); o.y = cvt_pk_bf16(x[2] * rs * ga.z, x[3] * rs * ga.w);
      o.z = cvt_pk_bf16(x[4] * rs * gb.x, x[5] * rs * gb.y); o.w = cvt_pk_bf16(x[6] * rs * gb.z, x[7] * rs * gb.w);
      *(u32x4*)(Q + h16 * 192 + 8 * li) = o; }
    { E2_UNPK(g.qr, x); float ss = 0.f;
#pragma unroll
      for (int e = 0; e < 8; ++e) ss += x[e] * x[e];
#pragma unroll
      for (int m = 1; m < 8; m <<= 1) ss += __shfl_xor(ss, m);
      const float rs = rsqrtf(ss * (1.f / 64.f) + EPS) * QSCALE_B;
      const float* gg = a.in[I_BQRN] + l * 64 + 8 * li8; const f32x4 ga = *(const f32x4*)gg, gb = *(const f32x4*)(gg + 4);
      float y[8] = {x[0] * rs * ga.x, x[1] * rs * ga.y, x[2] * rs * ga.z, x[3] * rs * ga.w, x[4] * rs * gb.x, x[5] * rs * gb.y, x[6] * rs * gb.z, x[7] * rs * gb.w};
      if (lat) { const float pos = (float)(li8 < 4 ? prow : pcol); const bool second = ((li8 >> 1) & 1) != 0;
#pragma unroll
          for (int e = 0; e < 8; ++e) { const float ang = pos * __builtin_amdgcn_exp2f(-(float)(8 * (li8 & 1) + e) * (13.287712379549449f / 16.f));
              const float c = __cosf(ang), sn = __sinf(ang), p = __shfl_xor(y[e], 2); y[e] = second ? (p * sn + y[e] * c) : (y[e] * c - p * sn); } }
      u32x4 o; o.x = cvt_pk_bf16(y[0], y[1]); o.y = cvt_pk_bf16(y[2], y[3]); o.z = cvt_pk_bf16(y[4], y[5]); o.w = cvt_pk_bf16(y[6], y[7]);
      if (lane < 32) { *(u32x4*)(Q + h8 * 192 + 128 + 8 * li8) = o; *(u32x4*)(KB + h8 * 192 + 128 + 8 * li8) = g.kr; } }
    { E2_UNPK(g.kn, x); float ss = 0.f;
#pragma unroll
      for (int e = 0; e < 8; ++e) ss += x[e] * x[e];
#pragma unroll
      for (int m = 1; m < 16; m <<= 1) ss += __shfl_xor(ss, m);
      const float rs = rsqrtf(ss * (1.f / 128.f) + EPS);
      const float* gg = a.in[I_BKNN] + l * 128 + 8 * li; const f32x4 ga = *(const f32x4*)gg, gb = *(const f32x4*)(gg + 4);
      u32x4 o; o.x = cvt_pk_bf16(x[0] * rs * ga.x, x[1] * rs * ga.y); o.y = cvt_pk_bf16(x[2] * rs * ga.z, x[3] * rs * ga.w);
      o.z = cvt_pk_bf16(x[4] * rs * gb.x, x[5] * rs * gb.y); o.w = cvt_pk_bf16(x[6] * rs * gb.z, x[7] * rs * gb.w);
      *(u32x4*)(KB + h16 * 192 + 8 * li) = o; }
#undef E2_UNPK
}

constexpr int GS = 65, GA = 64 * GS;
constexpr int GL_QF = 0, GL_QB = GA, GL_CGF = 33664, GL_CGB = 34688, GL_WF = 35712, GL_WB = 36736, GL_BF = 37760, GL_BB = 37824, GL_END = 37888;
constexpr int GB_QDF = 33280, GB_QDB = 42496, GB_KDF = 51712, GB_KDB = 60928, GB_VT = 70144, GB_ATT = 88576, GB_SFT = 97792, GB_SBT = 116224;
constexpr int HS = 72;
static_assert(GL_END * 4 <= LDS_QWORD && GB_SBT + 128 * HS * 2 <= GL_CGF * 4, "GLA LDS");
__device__ __forceinline__ bf16x8 ldfrag(const LAS unsigned char* base, int row, int ks, int hi) { return *(const LAS bf16x8*)(base + row * (HS * 2) + ks * 32 + hi * 16); }
__device__ __forceinline__ int crow16(int r, int hi) { return (r & 3) + 8 * (r >> 2) + 4 * hi; }
__device__ __forceinline__ float logsig(float x) { return fminf(x, 0.f) - __logf(1.f + __expf(-fabsf(x))); }
__device__ __forceinline__ float wave_incl_scan(float x, int lane) {
#pragma unroll
    for (int o = 1; o < 64; o <<= 1) { const float t = __shfl_up(x, o); if (lane >= o) x += t; }
    return x;
}
__device__ __forceinline__ void gla_store_vt(const u32x4 v0, const u32x4 v1, LAS unsigned char* B, int wid, int lane) {
    const unsigned w[8] = {v0.x, v0.y, v0.z, v0.w, v1.x, v1.y, v1.z, v1.w};
#pragma unroll
    for (int q = 0; q < 8; ++q) { const int e = 16 * wid + 2 * q;
        *(LAS unsigned short*)(B + GB_VT + (e * HS + lane) * 2) = (unsigned short)(w[q] & 0xffffu); *(LAS unsigned short*)(B + GB_VT + ((e + 1) * HS + lane) * 2) = (unsigned short)(w[q] >> 16); }
}
__device__ __forceinline__ void gla_p1(CArgs& a, int l, int cc, int h, LAS float* L, int dup, bool stagew) {
    int tid = threadIdx.x; asm volatile("" : "+v"(tid));
    LAS unsigned char* B = (LAS unsigned char*)L;
    const int wid = __builtin_amdgcn_readfirstlane(tid >> 6), lane = tid & 63;
    const bf16_t* Pj = (const bf16_t*)(a.ws + WS_PROJ) + (size_t)(cc * 64 + lane) * INP;
    float* KVS = (float*)(a.ws + WS_KVS); float* DEC = (float*)(a.ws + WS_DEC);
    bf16_t* GQ = (bf16_t*)a.out + (size_t)(cc * 4 + h) * 16384;
    const int slot = (cc * 4 + h) * 2;
    const bf16_t* Pw = (const bf16_t*)(a.ws + WS_PROJ) + (size_t)(cc * 64 + 8 * wid) * INP;
    const int lr8 = lane >> 3, lc8 = lane & 7;
    const u32x4 cgx = *(const u32x4*)(Pw + (size_t)((lane >> 2) & 7) * INP + C_CGF + (lane & 3) * 8);
    const u32x4 kx = *(const u32x4*)(Pw + (size_t)lr8 * INP + C_CK + h * 64 + lc8 * 8), qx = *(const u32x4*)(Pw + (size_t)lr8 * INP + C_CQ + h * 64 + lc8 * 8);
    const u32x4 v0 = *(const u32x4*)(Pj + C_CV + h * 128 + 16 * wid), v1 = *(const u32x4*)(Pj + C_CV + h * 128 + 16 * wid + 8);
    __syncthreads();
    { LAS unsigned char* S = B + GB_SFT;
      if (lane < 32) *(LAS u32x4*)(S + (8 * wid + (lane >> 2)) * 64 + (lane & 3) * 16) = cgx;
      *(LAS u32x4*)(S + 4096 + (8 * wid + lr8) * 128 + lc8 * 16) = kx; *(LAS u32x4*)(S + 12288 + (8 * wid + lr8) * 128 + lc8 * 16) = qx; }
    if (stagew) {
    for (int i = tid; i < 2048; i += 512) { const int dir = i >> 10, r = (i >> 6) & 15, d = i & 63; L[(dir ? GL_WB : GL_WF) + d * 16 + r] = a.in[dir ? I_WGKB : I_WGKF][(size_t)l * 16 * 256 + r * 256 + h * 64 + d]; }
    if (tid < 128) { const int dir = tid >> 6, d = tid & 63; L[(dir ? GL_BB : GL_BF) + d] = a.in[dir ? I_BGKB : I_BGKF][l * 256 + h * 64 + d]; } }
    gla_store_vt(v0, v1, B, wid, lane);
    __syncthreads();
    if (PROBE_CUT == 1 && dup) return;
    float cgf[16], cgb[16];
    const LAS unsigned char* S = B + GB_SFT;
    const u32x4 g0 = *(const LAS u32x4*)(S + lane * 64), g1 = *(const LAS u32x4*)(S + lane * 64 + 16), g2 = *(const LAS u32x4*)(S + lane * 64 + 32), g3 = *(const LAS u32x4*)(S + lane * 64 + 48);
    const u32x4 k8 = *(const LAS u32x4*)(S + 4096 + lane * 128 + wid * 16), q8 = *(const LAS u32x4*)(S + 12288 + lane * 128 + wid * 16);
    { const unsigned wf[8] = {g0.x, g0.y, g0.z, g0.w, g1.x, g1.y, g1.z, g1.w}, wb[8] = {g2.x, g2.y, g2.z, g2.w, g3.x, g3.y, g3.z, g3.w};
#pragma unroll
      for (int q = 0; q < 8; ++q) { cgf[2 * q] = bflo(wf[q]); cgf[2 * q + 1] = bfhi(wf[q]); cgb[2 * q] = bflo(wb[q]); cgb[2 * q + 1] = bfhi(wb[q]); } }
    const unsigned kw[4] = {k8.x, k8.y, k8.z, k8.w}, qw[4] = {q8.x, q8.y, q8.z, q8.w};
    float oqf[8], oqb[8], okf[8], okb[8];
#pragma unroll
    for (int dd = 0; dd < 8; ++dd) { const int d = 8 * wid + dd;
        float pf = L[GL_BF + d], pb = L[GL_BB + d];
#pragma unroll
        for (int q = 0; q < 4; ++q) { const f32x4 wf4 = *(const LAS f32x4*)(L + GL_WF + d * 16 + 4 * q), wb4 = *(const LAS f32x4*)(L + GL_WB + d * 16 + 4 * q);
#pragma unroll
            for (int e = 0; e < 4; ++e) { pf += cgf[4 * q + e] * wf4[e]; pb += cgb[4 * q + e] * wb4[e]; } }
        const float gf = logsig(pf) * (1.f / 16.f), gb = logsig(pb) * (1.f / 16.f);
        const float cf = wave_incl_scan(gf, lane), pbi = wave_incl_scan(gb, lane);
        const float totf = __shfl(cf, 63), totb = __shfl(pbi, 63);
        const float cb = totb - pbi + gb;
        const float k = (dd & 1) ? bfhi(kw[dd >> 1]) : bflo(kw[dd >> 1]), q = ((dd & 1) ? bfhi(qw[dd >> 1]) : bflo(qw[dd >> 1])) * 0.125f;
        oqf[dd] = q * __expf(cf); oqb[dd] = q * __expf(cb); okf[dd] = k * __expf(-cf); okb[dd] = k * __expf(-cb);
        *(LAS unsigned short*)(B + GB_QDF + (d * HS + lane) * 2) = f2bf(k * __expf(totf - cf));
        *(LAS unsigned short*)(B + GB_QDB + (d * HS + lane) * 2) = f2bf(k * __expf(totb - cb));
        if (lane == 0) { DEC[(size_t)slot * 64 + d] = __expf(totf); DEC[(size_t)(slot + 1) * 64 + d] = __expf(totb); } }
    { u32x4 w;
      w.x = cvt_pk_bf16(oqf[0], oqf[1]); w.y = cvt_pk_bf16(oqf[2], oqf[3]); w.z = cvt_pk_bf16(oqf[4], oqf[5]); w.w = cvt_pk_bf16(oqf[6], oqf[7]); *(u32x4*)(GQ + 0 * 4096 + lane * 64 + 8 * wid) = w;
      w.x = cvt_pk_bf16(oqb[0], oqb[1]); w.y = cvt_pk_bf16(oqb[2], oqb[3]); w.z = cvt_pk_bf16(oqb[4], oqb[5]); w.w = cvt_pk_bf16(oqb[6], oqb[7]); *(u32x4*)(GQ + 1 * 4096 + lane * 64 + 8 * wid) = w;
      w.x = cvt_pk_bf16(okf[0], okf[1]); w.y = cvt_pk_bf16(okf[2], okf[3]); w.z = cvt_pk_bf16(okf[4], okf[5]); w.w = cvt_pk_bf16(okf[6], okf[7]); *(u32x4*)(GQ + 2 * 4096 + lane * 64 + 8 * wid) = w;
      w.x = cvt_pk_bf16(okb[0], okb[1]); w.y = cvt_pk_bf16(okb[2], okb[3]); w.z = cvt_pk_bf16(okb[4], okb[5]); w.w = cvt_pk_bf16(okb[6], okb[7]); *(u32x4*)(GQ + 3 * 4096 + lane * 64 + 8 * wid) = w; }
    if (PROBE_CUT == 2 && dup) return;
    __syncthreads();
    { const int r32 = lane & 31, hi = lane >> 5, dir = wid >> 2, eb = wid & 3;
      const LAS unsigned char* X = B + GB_VT; const LAS unsigned char* Y = B + (dir ? GB_QDB : GB_QDF);
      f32x16 c0 = {}, c1 = {};
#pragma unroll
      for (int ks = 0; ks < 4; ++ks) { const bf16x8 av = ldfrag(X, 32 * eb + r32, ks, hi), b0 = ldfrag(Y, r32, ks, hi), b1 = ldfrag(Y, 32 + r32, ks, hi);
          c0 = __builtin_amdgcn_mfma_f32_32x32x16_bf16(av, b0, c0, 0, 0, 0); c1 = __builtin_amdgcn_mfma_f32_32x32x16_bf16(av, b1, c1, 0, 0, 0); }
      float* out = KVS + (size_t)(slot + dir) * 8192;
#pragma unroll
      for (int r = 0; r < 16; ++r) { const int e = 32 * eb + crow16(r, hi); out[e * 64 + r32] = c0[r]; out[e * 64 + 32 + r32] = c1[r]; } }
}
__device__ __forceinline__ void gla_scan(CArgs& a, int dup) {
    float* KVS = (float*)(a.ws + WS_KVS); float* KVO = dup ? (float*)a.out + (10u << 20) : KVS; const float* DEC = (const float*)(a.ws + WS_DEC);
    int tid = threadIdx.x; asm volatile("" : "+v"(tid));
    for (int g = blockIdx.x * 512 + tid; g < 32 * 2048; g += gridDim.x * 512) {
        const int seq = g >> 11, el = (g & 2047) * 4, d = el & 63, b = seq >> 3, h = (seq >> 1) & 3, dir = seq & 1;
        f32x4 carry = {0.f, 0.f, 0.f, 0.f};
        for (int s0 = 0; s0 < 68; s0 += 17) {
            f32x4 kv[17], dc[17]; size_t ad[17];
#pragma unroll
            for (int q = 0; q < 17; ++q) { const int s = s0 + q; const int c = dir == 0 ? s : (s < 4 ? 3 - s : 71 - s); const size_t slot = (size_t)((b * 68 + c) * 4 + h) * 2 + dir;
                ad[q] = slot * 8192 + el; kv[q] = *(const f32x4*)(KVS + ad[q]); dc[q] = *(const f32x4*)(DEC + slot * 64 + d); }
#pragma unroll
            for (int q = 0; q < 17; ++q) { *(f32x4*)(KVO + ad[q]) = carry; carry = dc[q] * carry + kv[q]; }
        }
    }
}
__device__ __forceinline__ void gla_p3(CArgs& a, int l, int cc, int h, LAS float* L) {
    int tid = threadIdx.x; asm volatile("" : "+v"(tid));
    LAS unsigned char* B = (LAS unsigned char*)L;
    const int wid = tid >> 6, lane = tid & 63, r32 = lane & 31, hi = lane >> 5;
    const bf16_t* P = (const bf16_t*)(a.ws + WS_PROJ) + (size_t)(cc * 64) * INP;
    const float* KVS = (const float*)(a.ws + WS_KVS);
    const bf16_t* GQ = (const bf16_t*)a.out + (size_t)(cc * 4 + h) * 16384;
    const int slot = (cc * 4 + h) * 2;
    u32x4 qk[4];
#pragma unroll
    for (int q = 0; q < 4; ++q) qk[q] = *(const u32x4*)(GQ + (size_t)(tid + 512 * q) * 8);
    const bf16_t* Pj = P + (size_t)lane * INP;
    const u32x4 v0 = *(const u32x4*)(Pj + C_CV + h * 128 + 16 * wid), v1 = *(const u32x4*)(Pj + C_CV + h * 128 + 16 * wid + 8);
    f32x4 sv[8];
#pragma unroll
    for (int q = 0; q < 8; ++q) sv[q] = *(const f32x4*)(KVS + (size_t)slot * 8192 + (size_t)(tid + 512 * q) * 4);
    __syncthreads();
#pragma unroll
    for (int q = 0; q < 4; ++q) { const int idx = tid + 512 * q, arr = idx >> 9, rem = idx & 511, j = rem >> 3, c = rem & 7; *(LAS u32x4*)(B + GB_QDF + arr * 9216 + (j * HS + c * 8) * 2) = qk[q]; }
    gla_store_vt(v0, v1, B, wid, lane);
#pragma unroll
    for (int q = 0; q < 8; ++q) { const int idx = tid + 512 * q, dir = idx >> 11, i = idx & 2047, e = i >> 4, d4 = (i & 15) * 4;
        u32x2 w; w.x = cvt_pk_bf16(sv[q].x, sv[q].y); w.y = cvt_pk_bf16(sv[q].z, sv[q].w); *(LAS u32x2*)(B + (dir ? GB_SBT : GB_SFT) + (e * HS + d4) * 2) = w; }
    __syncthreads();
    if (wid < 4) { const int ib = wid >> 1, jb = wid & 1; f32x16 cf = {}, cb = {};
#pragma unroll
        for (int ks = 0; ks < 4; ++ks) {
            cf = __builtin_amdgcn_mfma_f32_32x32x16_bf16(ldfrag(B + GB_QDF, 32 * ib + r32, ks, hi), ldfrag(B + GB_KDF, 32 * jb + r32, ks, hi), cf, 0, 0, 0);
            cb = __builtin_amdgcn_mfma_f32_32x32x16_bf16(ldfrag(B + GB_QDB, 32 * ib + r32, ks, hi), ldfrag(B + GB_KDB, 32 * jb + r32, ks, hi), cb, 0, 0, 0); }
#pragma unroll
        for (int r = 0; r < 16; ++r) { const int i = 32 * ib + crow16(r, hi), j = 32 * jb + r32;
            const float v = (j <= i ? cf[r] : 0.f) + (j >= i ? cb[r] : 0.f);
            *(LAS unsigned short*)(B + GB_ATT + (i * HS + j) * 2) = f2bf(v); } }
    __syncthreads();
    { const int ib = wid >> 2, eb = wid & 3; f32x16 acc = {};
#pragma unroll
      for (int ks = 0; ks < 4; ++ks) {
          acc = __builtin_amdgcn_mfma_f32_32x32x16_bf16(ldfrag(B + GB_ATT, 32 * ib + r32, ks, hi), ldfrag(B + GB_VT, 32 * eb + r32, ks, hi), acc, 0, 0, 0);
          acc = __builtin_amdgcn_mfma_f32_32x32x16_bf16(ldfrag(B + GB_QDF, 32 * ib + r32, ks, hi), ldfrag(B + GB_SFT, 32 * eb + r32, ks, hi), acc, 0, 0, 0);
          acc = __builtin_amdgcn_mfma_f32_32x32x16_bf16(ldfrag(B + GB_QDB, 32 * ib + r32, ks, hi), ldfrag(B + GB_SBT, 32 * eb + r32, ks, hi), acc, 0, 0, 0); }
#pragma unroll
      for (int r = 0; r < 16; ++r) L[(32 * ib + crow16(r, hi)) * 128 + 32 * eb + r32] = acc[r]; }
    __syncthreads();
    const int i0 = (tid >> 5) * 4, e4 = (tid & 31) * 4;
    bf16_t* Z = (bf16_t*)(a.ws + WS_HZ);
    const f32x4 gn = *(const f32x4*)(a.in[I_CON] + l * 128 + e4);
#pragma unroll
    for (int r = 0; r < 4; ++r) { const f32x4 o = *(const LAS f32x4*)(L + (i0 + r) * 128 + e4);
        float ss = (o.x * o.x + o.y * o.y) + (o.z * o.z + o.w * o.w);
#pragma unroll
        for (int m = 1; m < 32; m <<= 1) ss += __shfl_xor(ss, m);
        const float rs = rsqrtf(ss * (1.f / 128.f) + EPS);
        const size_t row = (size_t)cc * 64 + i0 + r;
        const u32x2 gw = *(const u32x2*)(P + (size_t)(i0 + r) * INP + C_CG + h * 128 + e4);
        const f32x4 y = o * rs * gn;
        u32x2 w; w.x = cvt_pk_bf16(y.x * silu_f(bflo(gw.x)), y.y * silu_f(bfhi(gw.x))); w.y = cvt_pk_bf16(y.z * silu_f(bflo(gw.y)), y.w * silu_f(bfhi(gw.y)));
        *(u32x2*)(Z + row * DM + 1536 + h * 128 + e4) = w; }
}

__device__ __forceinline__ void phase_mixer(CArgs& a, int l, unsigned char* lds_g, LAS unsigned char* lds, int dup) {
    int tid = threadIdx.x; asm volatile("" : "+v"(tid));
    unsigned* ctr = (unsigned*)(a.ws + WS_CTL) + CW_QUEUE + 64 * l + 32 * dup;
    volatile LAS unsigned* qw = (volatile LAS unsigned*)(lds + LDS_QWORD);
    const bf16_t* PROJ = (const bf16_t*)(a.ws + WS_PROJ); const bf16_t* QB = (const bf16_t*)(a.ws + WS_QB); const bf16_t* KB = (const bf16_t*)(a.ws + WS_KB);
    const bf16_t* KVB = (const bf16_t*)(a.ws + WS_KVB); bf16_t* Z = (bf16_t*)(a.ws + WS_HZ);
    const int nG = (l == 0) ? NCHUNK * 4 : 256 * 4, nC = (l == 0) ? 48 : 0, total = 768 + nG + nC;
    for (;;) {
        __syncthreads();
        if (tid == 0) *qw = atomicAdd(ctr, 1u);
        __syncthreads();
        const int idx = (int)*qw;
        if (idx >= total) break;
        int kind, b, h, seq; size_t q0;
        if (idx < 256) { kind = 0; b = idx >> 6; h = (idx >> 4) & 3; q0 = (size_t)b * TOK + CTXL + (idx & 15) * 256; seq = TOK; }
        else if (idx < 768) { const int i = idx - 256; kind = 1; b = i >> 7; h = (i >> 4) & 7; q0 = (size_t)b * TOK + CTXL + (i & 15) * 256; seq = TOK; }
        else if (idx < 768 + nG) { kind = 2; b = 0; h = 0; q0 = 0; seq = 0; }
        else { const int i = idx - 768 - nG; seq = CTXL;
            if (i < 32) { kind = 1; b = i >> 3; h = i & 7; } else { kind = 0; b = (i - 32) >> 2; h = (i - 32) & 3; }
            q0 = (size_t)b * TOK; }
        const size_t r0 = (size_t)b * TOK;
        if (PROBE_KIND >= 0 && dup && kind != PROBE_KIND) continue;
        bf16_t* Zo = (PROBE_ATT && dup) ? (bf16_t*)((float*)a.out + (10u << 20)) : Z;
#ifndef NO_ATTB
        if (kind == 0)
            att::attn_body_s<192, 768, 768, 1024, DM>(QB + q0 * 768 + h * 192, KB + r0 * 768 + h * 192, KVB + r0 * 1024 + h * 256 + 128, Zo + q0 * DM + 1024 + h * 128, seq, (char*)lds_g, dup);
#endif
#ifndef NO_ATTA
        if (kind == 1)
            att::attn_body_s<128, INP, INP, INP, DM>(PROJ + q0 * INP + C_AQ + h * 128, PROJ + r0 * INP + C_AK + (h >> 2) * 128, PROJ + r0 * INP + C_AV + (h >> 2) * 128, Zo + q0 * DM + h * 128, seq, (char*)lds_g, dup);
#endif
#ifndef NO_GLA3
        if (kind == 2) {
            const int i = idx - 768; int cc; const int hh = i & 3;
            if (l == 0) cc = i >> 2; else { const int lc = i >> 2; cc = (lc >> 6) * 68 + (lc & 63) + 4; }
            gla_p3(a, l, cc, hh, (LAS float*)lds);
        }
#endif
    }
}

__device__ __forceinline__ void run_phase(CArgs& a, int ph, unsigned char* lds_g, LAS unsigned char* lds, int dup) {
    int tid = threadIdx.x; asm volatile("" : "+v"(tid));
    const int lane = tid & 63, wid = tid >> 6;
    const int G = gridDim.x, gw = blockIdx.x * 8 + wid, NGW = G * 8;
    if (ph == 0) { phase_prologue(a, lds); return; }
    const int l = (ph - 1) / 10, k = (ph - 1) % 10;
    unsigned char* wb = a.ws + WS_W + (size_t)l * W_LAYER;
    const float* MOD = (const float*)(a.ws + WS_MOD) + (size_t)l * 5 * 12288;
    if (k == 0 || k == 7) { phase_norm(a, l, k == 7); return; }
    if (k == 1 || k == 3) {
        const int ng = (k == 1) ? 1 : 2;
        for (int gi = 0; gi < ng; ++gi) {
            if (PROBE_DUP == 20 && dup) break;
            pg8::Gemm g; pg8::EpiStore E; E.skipctx = 0;
            if (k == 1) { g = pg8::Gemm{(const bf16_t*)(a.ws + WS_HZ), (const bf16_t*)(wb + WO_IN), NR, INP, DM, DM, 0, DM}; E.O = (bf16_t*)(a.ws + WS_PROJ); E.ldc = INP; }
            else if (gi == 0) { g = pg8::Gemm{(const bf16_t*)(a.ws + WS_PROJ) + C_BCQ, (const bf16_t*)(wb + WO_UQ), NR, 768, 512, INP, 0, 512}; E.O = (bf16_t*)(a.ws + WS_QB); E.ldc = 768; }
            else { g = pg8::Gemm{(const bf16_t*)(a.ws + WS_PROJ) + C_BCKV, (const bf16_t*)(wb + WO_UKV), NR, 1024, 256, INP, 0, 256}; E.O = (bf16_t*)(a.ws + WS_KVB); E.ldc = 1024; }
            pg8::StaticOrder S; S.init(g.M, g.N, G, (int)blockIdx.x);
            pg8::gemm_phase<pg8::EpiStore>(lds, g, S, E);
        }
        if (k == 3) gla_scan(a, dup);
        return;
    }
    if (k == 2) {
        if (!dup || PROBE_DUP == 20) for (int r = gw; r < NR; r += 2 * NGW) { const int r1 = r + NGW; const bool two = r1 < NR;
            E1Regs g0, g1; e1_load(a, r, lane, g0); e1_load(a, two ? r1 : r, lane, g1); asm volatile("" ::: "memory");
            e1_row(a, l, r, lane, dup, g0); if (two) e1_row(a, l, r1, lane, dup, g1); }
        if (!(dup && PROBE_DUP == 20)) { int hst = -1; for (int u = blockIdx.x; u < NCHUNK * 4; u += G) { const int h = u & 3; gla_p1(a, l, u >> 2, h, (LAS float*)lds, dup, h != hst); hst = h; } }
        return;
    }
    if (k == 4) { for (int r = gw; r < NR; r += 2 * NGW) { const int r1 = r + NGW; const bool two = r1 < NR;
            E2Regs g0, g1; e2_load(a, r, lane, g0); e2_load(a, two ? r1 : r, lane, g1); asm volatile("" ::: "memory");
            e2_row(a, l, r, lane, dup, g0); if (two) e2_row(a, l, r1, lane, dup, g1); }
        return; }
    if (k == 5) { phase_mixer(a, l, lds_g, lds, dup); return; }
    if (k == 6 || k == 9) {
        pg8::Gemm g; pg8::EpiResid E;
        if (k == 6) g = pg8::Gemm{(const bf16_t*)(a.ws + WS_HZ), (const bf16_t*)(wb + WO_OUT), NBATCH * SEQ, DM, DM, DM, 1, DM};
        else g = pg8::Gemm{(const bf16_t*)(a.ws + WS_ACT), (const bf16_t*)(wb + WO_DN), NBATCH * SEQ, DM, DFF, DFF, 1, DFF};
        E.xin = a.in[I_X]; E.ctxin = a.in[I_CTX]; E.xr_in = (const float*)(a.ws + WS_XR); E.xr_out = (float*)(a.ws + WS_XR); E.fin_out = a.out;
        E.gate = MOD + (k == 6 ? 2 : 5) * DM; E.in_split = (l == 0 && k == 6); E.out_final = (l == 1 && k == 9); E.skipctx = 1;
        pg8::StaticOrder S; S.init(g.M, g.N, G, (int)blockIdx.x);
        pg8::gemm_phase<pg8::EpiResid>(lds, g, S, E);
        if (l == 0) {
            const int ks = (k == 6) ? 8 : 4;
            pg8::Gemm g2 = g; g2.M = NBATCH * CTXL; g2.skipctx = 2; g2.kpart = g.K / ks;
            pg8::EpiPartial E2{(float*)a.out + PART_OFF};
            pg8::StaticOrder S2; S2.init(g2.M, g2.N, G, (int)blockIdx.x, ks);
            pg8::gemm_phase<pg8::EpiPartial>(lds, g2, S2, E2);
        }
        return;
    }
    if (k == 8) {
        const int skip = (l == 1);
        pg8::Gemm g{(const bf16_t*)(a.ws + WS_HZ), (const bf16_t*)(wb + WO_GU), skip ? NBATCH * SEQ : NR, 2 * DFF, DM, DM, skip, DM};
        pg8::EpiSwiGLU E{(bf16_t*)(a.ws + WS_ACT), skip};
        pg8::StaticOrder S; S.init(g.M, g.N, G, (int)blockIdx.x);
        pg8::gemm_phase<pg8::EpiSwiGLU>(lds, g, S, E);
        return;
    }
}

#define XB_TMO      128
#define XB_XCNT(j)  (256  + 64 * (j))
#define XB_XSUB(j)  (1280 + 64 * (j))
#define XB_XGEN(j)  (2304 + 64 * (j))
#define XB_TOP      3328
#define XB_TOPGEN   3392
#define XCD_BAR_WORDS 3456
#define XB_SPIN_CAP (1u << 22)
constexpr int CW_BAR = 4096;
__device__ __forceinline__ unsigned xb_ld(unsigned* p)              { return __hip_atomic_load(p, __ATOMIC_RELAXED, __HIP_MEMORY_SCOPE_AGENT); }
__device__ __forceinline__ unsigned xb_add(unsigned* p, unsigned v) { return __hip_atomic_fetch_add(p, v, __ATOMIC_RELAXED, __HIP_MEMORY_SCOPE_AGENT); }
__device__ __forceinline__ unsigned xb_xcc_id() { return (unsigned)__builtin_amdgcn_s_getreg((3 << 11) | 20) & 0xFu; }
#define XB_SPIN(cond, bar) do { unsigned _sp = 0; while (cond) { __builtin_amdgcn_s_sleep(1); \
    if ((++_sp & 255u) == 0u) { if (xb_ld(&(bar)[XB_TMO])) break; if (_sp > XB_SPIN_CAP) { atomicAdd(&(bar)[XB_TMO], 1u); break; } } } } while (0)
struct XcdBarrier { unsigned* bar; unsigned x; volatile LAS unsigned* st; };
__device__ __forceinline__ XcdBarrier xcd_barrier_post(unsigned* bar, volatile LAS unsigned* st) {
    XcdBarrier b; b.bar = bar; b.x = xb_xcc_id(); b.st = st;
    if (threadIdx.x == 0) (void)xb_add(&bar[XB_XCNT(b.x)], 1u);
    return b;
}
__device__ __forceinline__ void xcd_barrier_complete(unsigned* bar, unsigned x, unsigned& nloc, unsigned& nx) {
    const unsigned G = gridDim.x * gridDim.y * gridDim.z;
    unsigned sum, cnt, mine, sp = 0u;
    for (;;) {
        sum = 0u; cnt = 0u; mine = 0u;
#pragma unroll
        for (unsigned j = 0; j < 16; ++j) { const unsigned c = xb_ld(&bar[XB_XCNT(j)]); sum += c; cnt += (c > 0u) ? 1u : 0u; mine = (j == x) ? c : mine; }
        if (sum == G) break;
        __builtin_amdgcn_s_sleep(1);
        if ((++sp & 255u) == 0u) { if (xb_ld(&bar[XB_TMO])) break; if (sp > XB_SPIN_CAP) { atomicAdd(&bar[XB_TMO], 1u); break; } }
    }
    nloc = mine > 0u ? mine : 1u; nx = cnt > 0u ? cnt : 1u;
}
__device__ __forceinline__ void xcd_barrier(const XcdBarrier& b) {
    asm volatile("s_waitcnt vmcnt(0)" ::: "memory");
    __syncthreads();
    if (threadIdx.x == 0) {
        unsigned* bar = b.bar;
        __builtin_amdgcn_s_waitcnt(0);
        unsigned nloc = b.st[0], nx = b.st[1];
        if (nloc == 0u) { xcd_barrier_complete(bar, b.x, nloc, nx); b.st[0] = nloc; b.st[1] = nx; }
        const unsigned old = xb_add(&bar[XB_XSUB(b.x)], 1u);
        const unsigned gen = old / nloc;
        if (old + 1u == (gen + 1u) * nloc) {
            __builtin_amdgcn_fence(__ATOMIC_RELEASE, "agent");
            asm volatile("s_waitcnt vmcnt(0)" ::: "memory");
            const unsigned og = xb_add(&bar[XB_TOP], 1u);
            const unsigned tg = og / nx;
            if (og + 1u == (tg + 1u) * nx) xb_add(&bar[XB_TOPGEN], 1u);
            else XB_SPIN(xb_ld(&bar[XB_TOPGEN]) == tg, bar);
            __builtin_amdgcn_fence(__ATOMIC_ACQUIRE, "agent");
            xb_add(&bar[XB_XGEN(b.x)], 1u);
            asm volatile("s_waitcnt vmcnt(0)" ::: "memory");
        } else {
            XB_SPIN(xb_ld(&bar[XB_XGEN(b.x)]) == gen, bar);
            __builtin_amdgcn_fence(__ATOMIC_ACQUIRE, "agent");
            asm volatile("s_waitcnt vmcnt(0)" ::: "memory");
        }
    }
    __syncthreads();
}

__global__ void __launch_bounds__(512, 2) mega(Args a) {
    extern __shared__ __attribute__((aligned(16))) unsigned char lds_raw[];
    cg::grid_group grid = cg::this_grid();
    volatile LAS unsigned* bst = (volatile LAS unsigned*)((LAS unsigned char*)lds_raw + LDS_QWORD + 16);
    if (threadIdx.x < 2) bst[threadIdx.x] = 0u;
    __syncthreads();
    const XcdBarrier bar = xcd_barrier_post((unsigned*)(a.ws + WS_CTL) + CW_BAR, bst);
    if (a.coop == 0x7fffffff) grid.sync();
    int dup = 0;
    for (int ph = a.ph_lo; ph < a.ph_hi; ++ph) {
        CArgs* ap = (CArgs*)__builtin_amdgcn_kernarg_segment_ptr(); asm volatile("" : "+s"(ap));
        run_phase(*ap, ph, lds_raw, (LAS unsigned char*)lds_raw, dup);
        if (PROBE_DUP >= 0 && dup == 0 && ((ph > 0 && (ph - 1) % 10 == PROBE_DUP) || (ph == 0 && PROBE_DUP == 10) || (PROBE_DUP == 20 && ph > 0 && ((ph - 1) % 10 == 2 || (ph - 1) % 10 == 3 || (ph - 1) % 10 == 4)))) { dup = 1; --ph; } else dup = 0;
        if (ph + 1 < a.ph_hi) { xcd_barrier(bar); for (int q = 0; q < PROBE_SYNC; ++q) xcd_barrier(bar); }
    }
}

constexpr int NPHASE = 21;
extern "C" void kernel_launch(void* const* d_in, const int* in_sizes, int n_in, void* d_out, int out_size, void* d_ws, size_t ws_size, hipStream_t stream) {
    static int grid = 0;
    if (grid == 0) {
        if (n_in != 28 || ws_size < WS_END) { fprintf(stderr, "kernel_launch: unexpected n_in %d or ws %zu < %zu\n", n_in, ws_size, (size_t)WS_END); grid = -1; return; }
        int dev = 0, cus = 0, per_cu = 0;
        hipGetDevice(&dev); hipDeviceGetAttribute(&cus, hipDeviceAttributeMultiprocessorCount, dev);
        if (hipFuncSetAttribute((const void*)mega, hipFuncAttributeMaxDynamicSharedMemorySize, LDS_BYTES) != hipSuccess) { fprintf(stderr, "kernel_launch: hipFuncSetAttribute failed\n"); grid = -1; return; }
        if (hipOccupancyMaxActiveBlocksPerMultiprocessor(&per_cu, (const void*)mega, 512, LDS_BYTES) != hipSuccess || per_cu < 1) per_cu = 1;
        (void)hipGetLastError();
        grid = cus * per_cu;
    }
    if (grid < 0) return;
    hipMemsetAsync((char*)d_ws + WS_CTL, 0, CTL_BYTES, stream);
    Args a{};
    for (int i = 0; i < 28; ++i) a.in[i] = (const float*)d_in[i];
    a.out = (float*)d_out; a.ws = (unsigned char*)d_ws; a.coop = MK_COOP; a.pad = 0;
#if MK_COOP
    a.ph_lo = 0; a.ph_hi = NPHASE;
    void* args[] = {&a};
    hipError_t e = hipLaunchCooperativeKernel((const void*)mega, dim3(grid), dim3(512), args, LDS_BYTES, stream);
    if (e != hipSuccess) fprintf(stderr, "cooperative launch failed: %s (grid %d)\n", hipGetErrorString(e), grid);
#else
    for (int ph = 0; ph < NPHASE; ++ph) { a.ph_lo = ph; a.ph_hi = ph + 1; hipLaunchKernelGGL(mega, dim3(grid), dim3(512), LDS_BYTES, stream, a); }
#endif
}
```

```cpp
#include <hip/hip_runtime.h>
#include <hip/hip_cooperative_groups.h>
#include <hip/hip_bf16.h>
#include <cstdio>
#include <cstdint>
namespace cg = cooperative_groups;

#ifndef MK_COOP
#define MK_COOP 1
#endif
#define PROBE_DUP -1
#define PROBE_CUT 0
#define PROBE_ATT 0
#define PROBE_SYNC 0
#define PROBE_KIND -1

#define LAS __attribute__((address_space(3)))
typedef unsigned short bf16_t;
typedef short bf16x8 __attribute__((ext_vector_type(8)));
typedef short s16x4 __attribute__((ext_vector_type(4)));
typedef float f32x4 __attribute__((ext_vector_type(4)));
typedef float f32x2 __attribute__((ext_vector_type(2)));
typedef float f32x16 __attribute__((ext_vector_type(16)));
typedef unsigned u32x4 __attribute__((ext_vector_type(4)));
typedef unsigned u32x2 __attribute__((ext_vector_type(2)));

constexpr int DM = 2048, NBATCH = 4, SEQ = 4096, CTXL = 256, TOK = SEQ + CTXL  , NR = NBATCH * TOK  ;
constexpr int INC = 3936, INP = 4096, DFF = 5632;
constexpr int C_AQ = 0, C_AK = 1024, C_AV = 1280, C_BCQ = 1536, C_BCKV = 2048, C_BKR = 2304, C_CQ = 2368, C_CK = 2624, C_CV = 2880, C_CG = 3392, C_CGF = 3904, C_CGB = 3920;
constexpr float EPS = 1e-6f;
constexpr float QSCALE_A = 0.088388347648318440f * 1.4426950408889634f, QSCALE_B = 0.072168783648703220f * 1.4426950408889634f;
constexpr int NCHUNK = NR / 64;
constexpr size_t MiB = 1u << 20;
constexpr size_t WS_CTL = 0, CTL_BYTES = 1 * MiB;
constexpr size_t WS_MOD = 64 * 1024;
constexpr size_t WS_W = 1 * MiB, W_LAYER = 92 * MiB;
constexpr size_t WO_IN = 0, WO_UQ = 16 * MiB, WO_UKV = 17 * MiB, WO_OUT = 18 * MiB, WO_GU = 26 * MiB, WO_DN = 70 * MiB;
constexpr size_t WS_HZ = WS_W + 2 * W_LAYER;
constexpr size_t WS_XR = WS_HZ + 68 * MiB;
constexpr size_t WS_S = WS_XR + 136 * MiB;
constexpr size_t WS_PROJ = WS_S;
constexpr size_t WS_QB = WS_PROJ + 136 * MiB;
constexpr size_t WS_KVB = WS_QB + 26 * MiB;
constexpr size_t WS_KB = WS_KVB + 34 * MiB;
constexpr size_t WS_KVS = WS_KB + 26 * MiB;
constexpr size_t WS_DEC = WS_KVS + 68 * MiB;
constexpr size_t WS_ACT = WS_S;
constexpr size_t WS_END = WS_DEC + 1 * MiB;
constexpr int CW_QUEUE = 64;

constexpr size_t PART_OFF = 10u << 20;
constexpr int LDS_BYTES = 155648;
constexpr int LDS_QWORD = 153600;

__device__ __forceinline__ float bf2f(unsigned short x) { return __uint_as_float(((unsigned)x) << 16); }
__device__ __forceinline__ float bflo(unsigned w) { return __uint_as_float(w << 16); }
__device__ __forceinline__ float bfhi(unsigned w) { return __uint_as_float(w & 0xffff0000u); }
__device__ __forceinline__ unsigned cvt_pk_bf16(float lo, float hi) { unsigned r; asm volatile("v_cvt_pk_bf16_f32 %0, %1, %2" : "=v"(r) : "v"(lo), "v"(hi)); return r; }
__device__ __forceinline__ unsigned short f2bf(float f) { return (unsigned short)(cvt_pk_bf16(f, 0.f) & 0xffffu); }
__device__ __forceinline__ float wave_sum(float v) {
#pragma unroll
    for (int o = 1; o < 64; o <<= 1) v += __shfl_xor(v, o);
    return v;
}
__device__ __forceinline__ float silu_f(float g) { return g * __builtin_amdgcn_rcpf(1.f + __expf(-g)); }

namespace pg8 {
constexpr int BM = 256, BK = 64, HALF = 128, HTB = HALF * BK * 2, STAGE_BYTES = 8 * HTB, NXCD = 8, WGM = 8;
__host__ __device__ __forceinline__ int lds_byte(int r, int c) { const int st = (r >> 4) * 2 + (c >> 5), rr = r & 15, cc = c & 31, ob = rr * 64 + cc * 2; return st * 1024 + (ob ^ (((ob >> 9) & 1) << 5)); }
__host__ __device__ __forceinline__ void stage_rc(int b, int& R, int& C) { const int st = b / 1024, sb = b % 1024, swz = sb ^ (((sb >> 9) & 1) << 5); R = (st >> 1) * 16 + swz / 64; C = (st & 1) * 32 + (swz % 64) / 2; }
__host__ __device__ __forceinline__ int perm32(int rho) { const int n = rho >> 4, i = rho & 15; return 8 * (i >> 2) + 4 * n + (i & 3); }
struct Unit { int pm, pn, kp; };
struct Gemm { const bf16_t* A; const bf16_t* Bt; int M, N, K, lda, skipctx, kpart; };
__device__ __forceinline__ int phys_tile(int pm, int skip) { return skip == 1 ? pm + (pm >> 4) + 1 : (skip == 2 ? pm * 17 : pm); }
struct StaticOrder {
    int nM, nN, nwg, G, c, n2;
    __device__ void init(int M, int N, int G_, int c_, int ks = 1) { nM = M / BM; nN = N / BM; n2 = nM * nN; nwg = n2 * ks; G = G_; c = c_; }
    __device__ bool next(int i, Unit& u) const {
        const long L = (long)i * G + c; if (L >= nwg) return false;
        int wgid = (int)L; { const int q = nwg / NXCD, r = nwg % NXCD, xcd = wgid % NXCD, off = wgid / NXCD; wgid = (xcd < r ? xcd * (q + 1) : r * (q + 1) + (xcd - r) * q) + off; }
        u.kp = wgid / n2; wgid -= u.kp * n2;
        const int nig = WGM * nN, gid = wgid / nig, fm = gid * WGM, gsz = (nM - fm) < WGM ? (nM - fm) : WGM;
        u.pm = fm + ((wgid % nig) % gsz); u.pn = (wgid % nig) / gsz; return true;
    }
};
struct EpiStore {
    static constexpr bool PERM = true;
    bf16_t* O; int ldc; int skipctx;
    __device__ __forceinline__ void operator()(const f32x4 (&acc)[2][2][4][2], const Unit& u, int wr, int wc, int fr, int fq) const {
        const int row0 = phys_tile(u.pm, skipctx) * BM + wr * 64 + fr, col0 = u.pn * BM + wc * 32 + 8 * fq;
#pragma unroll
        for (int ai = 0; ai < 2; ++ai)
#pragma unroll
            for (int m = 0; m < 4; ++m) { bf16_t* rowp = O + (size_t)(row0 + ai * HALF + m * 16) * ldc + col0;
#pragma unroll
                for (int bj = 0; bj < 2; ++bj) { const f32x4 v0 = acc[ai][bj][m][0], v1 = acc[ai][bj][m][1];
                    u32x4 w; w.x = cvt_pk_bf16(v0[0], v0[1]); w.y = cvt_pk_bf16(v0[2], v0[3]); w.z = cvt_pk_bf16(v1[0], v1[1]); w.w = cvt_pk_bf16(v1[2], v1[3]);
                    *(u32x4*)(rowp + bj * HALF) = w; } }
    }
};
struct EpiSwiGLU {
    static constexpr bool PERM = true;
    bf16_t* O; int skipctx;
    __device__ __forceinline__ void operator()(const f32x4 (&acc)[2][2][4][2], const Unit& u, int wr, int wc, int fr, int fq) const {
        const int row0 = phys_tile(u.pm, skipctx) * BM + wr * 64 + fr, col0 = u.pn * HALF + wc * 32 + 8 * fq;
#pragma unroll
        for (int ai = 0; ai < 2; ++ai)
#pragma unroll
            for (int m = 0; m < 4; ++m) { bf16_t* rowp = O + (size_t)(row0 + ai * HALF + m * 16) * DFF + col0;
                float r[8];
#pragma unroll
                for (int n = 0; n < 2; ++n)
#pragma unroll
                    for (int e = 0; e < 4; ++e) r[n * 4 + e] = silu_f(acc[ai][0][m][n][e]) * acc[ai][1][m][n][e];
                u32x4 w; w.x = cvt_pk_bf16(r[0], r[1]); w.y = cvt_pk_bf16(r[2], r[3]); w.z = cvt_pk_bf16(r[4], r[5]); w.w = cvt_pk_bf16(r[6], r[7]);
                *(u32x4*)rowp = w; }
    }
};
struct EpiPartial {
    static constexpr bool PERM = false;
    float* P;
    __device__ __forceinline__ void operator()(const f32x4 (&acc)[2][2][4][2], const Unit& u, int wr, int wc, int fr, int fq) const {
        float* t = P + ((size_t)(u.kp * 32 + u.pm * 8 + u.pn) << 16); const int col0 = wc * 32 + 4 * fq;
#pragma unroll
        for (int ai = 0; ai < 2; ++ai)
#pragma unroll
            for (int m = 0; m < 4; ++m) { float* rp = t + (ai * HALF + wr * 64 + m * 16 + fr) * 256 + col0;
#pragma unroll
                for (int bj = 0; bj < 2; ++bj)
#pragma unroll
                    for (int n = 0; n < 2; ++n) *(f32x4*)(rp + bj * HALF + n * 16) = acc[ai][bj][m][n]; }
    }
};
struct EpiResid {
    static constexpr bool PERM = false;
    const float* xin; const float* ctxin; const float* xr_in; float* xr_out; float* fin_out; const float* gate; int in_split, out_final, skipctx;
    __device__ __forceinline__ void operator()(const f32x4 (&acc)[2][2][4][2], const Unit& u, int wr, int wc, int fr, int fq) const {
        const int pt = phys_tile(u.pm, skipctx), b = pt / 17, t = pt - b * 17, v = (t == 0) ? 4 : b;
        const float* inb = in_split ? (t == 0 ? ctxin + (size_t)b * CTXL * DM : xin + ((size_t)b * SEQ + (size_t)(t - 1) * 256) * DM) : xr_in + (size_t)pt * BM * DM;
        float* ob = out_final ? fin_out + ((size_t)b * SEQ + (size_t)(t - 1) * 256) * DM : xr_out + (size_t)pt * BM * DM;
        const int col0 = u.pn * BM + wc * 32 + 4 * fq;
        const float* gp = gate + (size_t)v * 12288 + col0;
        f32x4 gv[2][2];
#pragma unroll
        for (int bj = 0; bj < 2; ++bj)
#pragma unroll
            for (int n = 0; n < 2; ++n) gv[bj][n] = *(const f32x4*)(gp + bj * HALF + n * 16);
#pragma unroll
        for (int ai = 0; ai < 2; ++ai)
#pragma unroll
            for (int m = 0; m < 4; ++m) { const size_t off = (size_t)(ai * HALF + wr * 64 + m * 16 + fr) * DM + col0;
#pragma unroll
                for (int bj = 0; bj < 2; ++bj)
#pragma unroll
                    for (int n = 0; n < 2; ++n) { const f32x4 bs = *(const f32x4*)(inb + off + bj * HALF + n * 16);
                        *(f32x4*)(ob + off + bj * HALF + n * 16) = bs + gv[bj][n] * acc[ai][bj][m][n]; }
                if (m == 3) asm volatile("" ::: "memory"); }
    }
};

template <class Epi>
__device__ __forceinline__ void gemm_phase(LAS unsigned char* lds, const Gemm g, const StaticOrder& S, const Epi& E) {
    int tid_ = threadIdx.x; asm volatile("" : "+v"(tid_));
    const int tid = tid_, wid = __builtin_amdgcn_readfirstlane(tid >> 6), lane = tid & 63, wr = wid >> 2, wc = wid & 3, fr = lane & 15, fq = lane >> 4;
    const int K = g.K, nt = g.kpart / BK, lda = g.lda;
    unsigned voffA[2], voffB[2];
#pragma unroll
    for (int i = 0; i < 2; ++i) { int R, C; stage_rc(tid * 16 + i * 8192, R, C); const int Rb = Epi::PERM ? ((R & ~31) + perm32(R & 31)) : R;
        voffA[i] = (unsigned)(R * lda + C) * 2u; voffB[i] = (unsigned)(Rb * K + C) * 2u; }
    const size_t kstep = (size_t)(BK * 2);
    const size_t hstepA = (size_t)HALF * lda * 2, hstepB = (size_t)HALF * K * 2;
    const size_t tstepA = 2 * hstepA, tstepB = 2 * hstepB;
    const unsigned ldsw = (unsigned)wid * 1024u;
    const int aoff = lds_byte(wr * 64 + fr, fq * 8), boff = lds_byte(wc * 32 + fr, fq * 8);
#define PG8_SA(b, h) (((b) * 2 + (h)) * HTB)
#define PG8_SB(b, h) ((4 + (b) * 2 + (h)) * HTB)
#define PG8_STAGE(bufoff, gbase, voff) do { _Pragma("unroll") for (int _i = 0; _i < 2; ++_i) \
        __builtin_amdgcn_global_load_lds((const unsigned*)((const char*)(gbase) + (voff)[_i]), (LAS unsigned*)(lds + (bufoff) + ldsw + _i * 8192), 16, 0, 0); } while (0)
#define PG8_LDA(dst, b, h) do { _Pragma("unroll") for (int m = 0; m < 4; ++m) _Pragma("unroll") for (int k = 0; k < 2; ++k) dst[m][k] = *(const LAS bf16x8*)(lds + PG8_SA(b, h) + aoff + m * 2048 + k * 1024); } while (0)
#define PG8_LDB(dst, b, h) do { _Pragma("unroll") for (int n = 0; n < 2; ++n) _Pragma("unroll") for (int k = 0; k < 2; ++k) dst[n][k] = *(const LAS bf16x8*)(lds + PG8_SB(b, h) + boff + n * 2048 + k * 1024); } while (0)
#define PG8_MMA(ai, bj, At, Bt) do { __builtin_amdgcn_s_setprio(1); _Pragma("unroll") for (int m = 0; m < 4; ++m) _Pragma("unroll") for (int n = 0; n < 2; ++n) _Pragma("unroll") for (int k = 0; k < 2; ++k) \
        acc[ai][bj][m][n] = __builtin_amdgcn_mfma_f32_16x16x32_bf16(Bt[n][k], At[m][k], acc[ai][bj][m][n], 0, 0, 0); __builtin_amdgcn_s_setprio(0); } while (0)
#define PG8_WAIT_V(n) asm volatile("s_waitcnt vmcnt(" #n ")" ::: "memory")
#define PG8_WAIT_L(n) asm volatile("s_waitcnt lgkmcnt(" #n ")" ::: "memory")
#define PG8_BAR __builtin_amdgcn_s_barrier()
#define PG8_SCHED __builtin_amdgcn_sched_barrier(0)
    Unit cur, nxt; int ui = 0;
    if (!S.next(0, cur)) return;
    f32x4 acc[2][2][4][2];
#pragma unroll
    for (int a = 0; a < 2; ++a)
#pragma unroll
        for (int b = 0; b < 2; ++b)
#pragma unroll
            for (int m = 0; m < 4; ++m)
#pragma unroll
                for (int n = 0; n < 2; ++n) acc[a][b][m][n] = (f32x4){0.f, 0.f, 0.f, 0.f};
    bf16x8 At[4][2], B0[2][2], B1[2][2];
    const size_t kpb = (size_t)g.kpart * 2;
    const char* cA = (const char*)g.A + (size_t)phys_tile(cur.pm, g.skipctx) * tstepA + cur.kp * kpb; const char* cB = (const char*)g.Bt + (size_t)cur.pn * tstepB + cur.kp * kpb;
    PG8_STAGE(PG8_SB(0, 0), cB, voffB); PG8_STAGE(PG8_SB(0, 1), cB + hstepB, voffB); PG8_STAGE(PG8_SA(0, 0), cA, voffA); PG8_STAGE(PG8_SA(0, 1), cA + hstepA, voffA);
    if (wr == 1) PG8_BAR;
    PG8_WAIT_V(2); PG8_BAR;
    PG8_STAGE(PG8_SB(1, 0), cB + kstep, voffB); PG8_STAGE(PG8_SA(1, 0), cA + kstep, voffA); PG8_STAGE(PG8_SB(1, 1), cB + hstepB + kstep, voffB);
    PG8_WAIT_V(6); PG8_BAR;
    for (;;) {
        const bool has_next = S.next(ui + 1, nxt);
        const char* nA = has_next ? (const char*)g.A + (size_t)phys_tile(nxt.pm, g.skipctx) * tstepA + nxt.kp * kpb : cA; const char* nB = has_next ? (const char*)g.Bt + (size_t)nxt.pn * tstepB + nxt.kp * kpb : cB;
        for (int t = 0; t < nt; t += 2) {
            const bool last = (t == nt - 2);
            const char* a1 = cA + (size_t)(t + 1) * kstep;
            const char* a2 = last ? nA : cA + (size_t)(t + 2) * kstep; const char* b2 = last ? nB : cB + (size_t)(t + 2) * kstep;
            const char* a3 = a2 + kstep; const char* b3 = b2 + kstep;
            PG8_LDB(B0, 0, 0); PG8_LDB(B1, 0, 1); PG8_SCHED; PG8_LDA(At, 0, 0); PG8_STAGE(PG8_SA(1, 1), a1 + hstepA, voffA);
            PG8_WAIT_V(8); PG8_WAIT_L(0); PG8_BAR; PG8_MMA(0, 0, At, B0); PG8_MMA(0, 1, At, B1); PG8_BAR; PG8_SCHED;
            PG8_LDA(At, 0, 1); PG8_STAGE(PG8_SB(0, 0), b2, voffB); PG8_STAGE(PG8_SB(0, 1), b2 + hstepB, voffB); PG8_STAGE(PG8_SA(0, 0), a2, voffA);
            PG8_WAIT_V(8); PG8_WAIT_L(0); PG8_BAR; PG8_MMA(1, 0, At, B0); PG8_MMA(1, 1, At, B1); PG8_BAR; PG8_SCHED;
            PG8_LDB(B0, 1, 0); PG8_LDB(B1, 1, 1); PG8_SCHED; PG8_LDA(At, 1, 0); PG8_STAGE(PG8_SA(0, 1), a2 + hstepA, voffA);
            PG8_WAIT_V(8); PG8_WAIT_L(0); PG8_BAR; PG8_MMA(0, 0, At, B0); PG8_MMA(0, 1, At, B1); PG8_BAR; PG8_SCHED;
            PG8_LDA(At, 1, 1); PG8_STAGE(PG8_SB(1, 0), b3, voffB); PG8_STAGE(PG8_SB(1, 1), b3 + hstepB, voffB); PG8_STAGE(PG8_SA(1, 0), a3, voffA);
            PG8_WAIT_V(8); PG8_WAIT_L(0); PG8_BAR; PG8_MMA(1, 0, At, B0); PG8_MMA(1, 1, At, B1); PG8_BAR; PG8_SCHED;
        }
        if (wr == 0) PG8_BAR;
        E(acc, cur, wr, wc, fr, fq);
        if (!has_next) break;
#pragma unroll
        for (int a = 0; a < 2; ++a)
#pragma unroll
            for (int b = 0; b < 2; ++b)
#pragma unroll
                for (int m = 0; m < 4; ++m)
#pragma unroll
                    for (int n = 0; n < 2; ++n) acc[a][b][m][n] = (f32x4){0.f, 0.f, 0.f, 0.f};
        cur = nxt; cA = nA; cB = nB; ++ui;
        if (wr == 1) PG8_BAR;
    }
    PG8_WAIT_V(0);
    PG8_BAR;
#undef PG8_SA
#undef PG8_SB
#undef PG8_STAGE
#undef PG8_LDA
#undef PG8_LDB
#undef PG8_MMA
#undef PG8_WAIT_V
#undef PG8_WAIT_L
#undef PG8_BAR
#undef PG8_SCHED
}
}

namespace att {
using bf16 = bf16_t;
constexpr int NW = 8, QBLK = 32, KVBLK = 64;
constexpr float THR = 8.f;
#define SBAR() __builtin_amdgcn_sched_barrier(0)
__device__ __forceinline__ int crow(int r, int hi) { return (r & 3) + 8 * (r >> 2) + 4 * hi; }
template <int DQK> __device__ __forceinline__ int kswz(int r) { return DQK == 128 ? ((r & 15) << 4) : (((r >> 1) & 7) << 4); }
template <int DQK> struct Cfg {
    static constexpr int KCH = DQK / 8, NKC = 64 * KCH / 512, ROWB = DQK * 2;
    static constexpr int SHM_K = 64 * DQK * 2, SHM_V = 64 * 128 * 2;
    static constexpr float SCALE = DQK == 128 ? 0.088388347648318440f : 0.072168783648703220f;
};
template <int DQK> __device__ __forceinline__ void partialSM(f32x16& p0, f32x16& p1, float& m_reg, float& mn, float& alpha) {
    constexpr float SCALE = Cfg<DQK>::SCALE;
    constexpr float C = SCALE * 1.4426950408889634f;
    float pmax = p0[0];
#pragma unroll
    for (int r = 1; r < 16; ++r) pmax = fmaxf(pmax, p0[r]);
#pragma unroll
    for (int r = 0; r < 16; ++r) pmax = fmaxf(pmax, p1[r]);
    { auto rr = __builtin_amdgcn_permlane32_swap(__float_as_uint(pmax), __float_as_uint(pmax), false, false);
      pmax = fmaxf(__uint_as_float(rr[0]), __uint_as_float(rr[1])); }
    if (__builtin_expect(__all(pmax - m_reg <= THR / SCALE), 1)) { mn = m_reg; alpha = 1.f; }
    else { mn = fmaxf(m_reg, pmax); alpha = __builtin_amdgcn_exp2f((m_reg - mn) * C); m_reg = mn; }
    float mnC = -mn * C;
#pragma unroll
    for (int r = 0; r < 16; ++r) p0[r] = fmaf(p0[r], C, mnC);
#pragma unroll
    for (int r = 0; r < 16; ++r) p1[r] = fmaf(p1[r], C, mnC);
#pragma unroll
    for (int r = 0; r < 16; ++r) p0[r] = __builtin_amdgcn_exp2f(p0[r]);
}
__device__ __forceinline__ void finishSM(f32x16& p0, f32x16& p1, float alpha, float& l_reg, bf16x8& pa0, bf16x8& pa1, bf16x8& pa2, bf16x8& pa3) {
#pragma unroll
    for (int r = 0; r < 16; ++r) p1[r] = __builtin_amdgcn_exp2f(p1[r]);
    float ps = 0;
#pragma unroll
    for (int r = 0; r < 16; ++r) ps += p0[r];
#pragma unroll
    for (int r = 0; r < 16; ++r) ps += p1[r];
    { auto rr = __builtin_amdgcn_permlane32_swap(__float_as_uint(ps), __float_as_uint(ps), false, false);
      ps = __uint_as_float(rr[0]) + __uint_as_float(rr[1]); }
    l_reg = l_reg * alpha + ps;
#define PK4(P, BASE, OUT) do { unsigned a0 = cvt_pk_bf16(P[BASE + 0], P[BASE + 1]), a1 = cvt_pk_bf16(P[BASE + 2], P[BASE + 3]);   \
    unsigned b0 = cvt_pk_bf16(P[BASE + 4], P[BASE + 5]), b1 = cvt_pk_bf16(P[BASE + 6], P[BASE + 7]);                              \
    auto r0 = __builtin_amdgcn_permlane32_swap(a0, b0, false, false); auto r1 = __builtin_amdgcn_permlane32_swap(a1, b1, false, false); \
    u32x4 w = {r0[0], r1[0], r0[1], r1[1]}; OUT = *reinterpret_cast<bf16x8*>(&w); } while (0)
    PK4(p0, 0, pa0); PK4(p0, 8, pa1); PK4(p1, 0, pa2); PK4(p1, 8, pa3);
#undef PK4
}
constexpr float THR2 = 8.f;
__device__ __forceinline__ void partialSM2(f32x16& p0, f32x16& p1, float& m_hat, f32x16& negm, float& alpha) {
    float pmax = fmaxf(p0[0], p0[1]);
#pragma unroll
    for (int r = 2; r < 16; ++r) pmax = fmaxf(pmax, p0[r]);
#pragma unroll
    for (int r = 0; r < 16; ++r) pmax = fmaxf(pmax, p1[r]);
    { auto rr = __builtin_amdgcn_permlane32_swap(__float_as_uint(pmax), __float_as_uint(pmax), false, false);
      pmax = fmaxf(__uint_as_float(rr[0]), __uint_as_float(rr[1])); }
    if (__builtin_expect(__all(pmax <= THR2), 1)) { alpha = 1.f; }
    else { const float dl = fmaxf(pmax, 0.f); m_hat += dl; alpha = __builtin_amdgcn_exp2f(-dl);
#pragma unroll
        for (int r = 0; r < 16; ++r) { p0[r] -= dl; p1[r] -= dl; }
#pragma unroll
        for (int r = 0; r < 16; ++r) negm[r] = -m_hat; }
#pragma unroll
    for (int r = 0; r < 16; ++r) p0[r] = __builtin_amdgcn_exp2f(p0[r]);
}
__device__ __forceinline__ void finishSM2(f32x16& p0, f32x16& p1, bf16x8& pa0, bf16x8& pa1, bf16x8& pa2, bf16x8& pa3) {
#pragma unroll
    for (int r = 0; r < 16; ++r) p1[r] = __builtin_amdgcn_exp2f(p1[r]);
#define PK4(P, BASE, OUT) do { unsigned a0 = cvt_pk_bf16(P[BASE + 0], P[BASE + 1]), a1 = cvt_pk_bf16(P[BASE + 2], P[BASE + 3]);   \
    unsigned b0 = cvt_pk_bf16(P[BASE + 4], P[BASE + 5]), b1 = cvt_pk_bf16(P[BASE + 6], P[BASE + 7]);                              \
    auto r0 = __builtin_amdgcn_permlane32_swap(a0, b0, false, false); auto r1 = __builtin_amdgcn_permlane32_swap(a1, b1, false, false); \
    u32x4 w = {r0[0], r1[0], r0[1], r1[1]}; OUT = *reinterpret_cast<bf16x8*>(&w); } while (0)
    PK4(p0, 0, pa0); PK4(p0, 8, pa1); PK4(p1, 0, pa2); PK4(p1, 8, pa3);
#undef PK4
}
template <int DQK> __device__ __forceinline__ void qkt(f32x16& p0, f32x16& p1, const char* Ks, const bf16x8* qr, const char* qrl, int r32, int hi, const f32x16& c0) {
    constexpr int ROWB = Cfg<DQK>::ROWB;
    p0 = c0; p1 = c0;
#pragma unroll
    for (int d0 = 0; d0 < 8; ++d0) { const int cb = (d0 * 16 + hi * 8) * 2;
        bf16x8 b0 = *reinterpret_cast<const bf16x8*>(Ks + r32 * ROWB + (cb ^ kswz<DQK>(r32)));
        bf16x8 b1 = *reinterpret_cast<const bf16x8*>(Ks + (32 + r32) * ROWB + (cb ^ kswz<DQK>(r32)));
        p0 = __builtin_amdgcn_mfma_f32_32x32x16_bf16(b0, qr[d0], p0, 0, 0, 0);
        p1 = __builtin_amdgcn_mfma_f32_32x32x16_bf16(b1, qr[d0], p1, 0, 0, 0);
        if constexpr (DQK == 192) { if (d0 == 3 || d0 == 7) SBAR(); } }
    if constexpr (DQK == 192) {
#pragma unroll
        for (int d0 = 8; d0 < 12; ++d0) { const int cb = (d0 * 16 + hi * 8) * 2;
            const bf16x8 q = *reinterpret_cast<const bf16x8*>(qrl + (d0 - 8) * 1024);
            bf16x8 b0 = *reinterpret_cast<const bf16x8*>(Ks + r32 * ROWB + (cb ^ kswz<DQK>(r32)));
            bf16x8 b1 = *reinterpret_cast<const bf16x8*>(Ks + (32 + r32) * ROWB + (cb ^ kswz<DQK>(r32)));
            p0 = __builtin_amdgcn_mfma_f32_32x32x16_bf16(b0, q, p0, 0, 0, 0);
            p1 = __builtin_amdgcn_mfma_f32_32x32x16_bf16(b1, q, p1, 0, 0, 0); }
    }
}
__device__ __forceinline__ int v_st(int k, int c) { const int kk = (k & ~0xC) | ((k & 4) << 1) | ((k & 8) >> 1); return ((kk >> 3) * 4 + (c >> 5)) * 512 + ((kk & 7) * 32 + (c & 31)) * 2; }
__device__ __forceinline__ int v_rd_base(int lane) { return ((lane & 3) << 3) | (((lane >> 2) & 3) << 6) | (((lane >> 4) & 1) << 5) | (((lane >> 5) & 1) << 8); }
constexpr int v_rd_off(int d0, int ks, int half) { return d0 * 512 + ks * 4096 + half * 2048; }
template <int OFF> __device__ __forceinline__ s16x4 tr_read(int vb) {
    s16x4 r; asm volatile("ds_read_b64_tr_b16 %0, %1 offset:%2" : "=&v"(r) : "v"(vb), "i"(OFF) : "memory"); return r;
}
template <int D0> __device__ __forceinline__ void pv_one(f32x16& od, int vb, bf16x8 pa0, bf16x8 pa1, bf16x8 pa2, bf16x8 pa3) {
    const s16x4 l0 = tr_read<v_rd_off(D0, 0, 0)>(vb), h0 = tr_read<v_rd_off(D0, 0, 1)>(vb), l1 = tr_read<v_rd_off(D0, 1, 0)>(vb), h1 = tr_read<v_rd_off(D0, 1, 1)>(vb);
    const s16x4 l2 = tr_read<v_rd_off(D0, 2, 0)>(vb), h2 = tr_read<v_rd_off(D0, 2, 1)>(vb), l3 = tr_read<v_rd_off(D0, 3, 0)>(vb), h3 = tr_read<v_rd_off(D0, 3, 1)>(vb);
    asm volatile("s_waitcnt lgkmcnt(0)" ::: "memory"); SBAR();
#define PK(L, H) (bf16x8){L[0], L[1], L[2], L[3], H[0], H[1], H[2], H[3]}
    od = __builtin_amdgcn_mfma_f32_32x32x16_bf16(pa0, PK(l0, h0), od, 0, 0, 0);
    od = __builtin_amdgcn_mfma_f32_32x32x16_bf16(pa1, PK(l1, h1), od, 0, 0, 0);
    od = __builtin_amdgcn_mfma_f32_32x32x16_bf16(pa2, PK(l2, h2), od, 0, 0, 0);
    od = __builtin_amdgcn_mfma_f32_32x32x16_bf16(pa3, PK(l3, h3), od, 0, 0, 0);
#undef PK
}
__device__ __forceinline__ void pv_d0(f32x16* o, int vb, bf16x8 pa0, bf16x8 pa1, bf16x8 pa2, bf16x8 pa3) {
    pv_one<0>(o[0], vb, pa0, pa1, pa2, pa3); pv_one<1>(o[1], vb, pa0, pa1, pa2, pa3); pv_one<2>(o[2], vb, pa0, pa1, pa2, pa3); pv_one<3>(o[3], vb, pa0, pa1, pa2, pa3);
}
template <int DQK, int SDEPTH, int LDQ, int LDK, int LDV, int LDO>
__device__ __forceinline__ void attn_body(const bf16* __restrict__ Qb, const bf16* __restrict__ Kh, const bf16* __restrict__ Vh,
                                          bf16* __restrict__ Ob, int seq, char* lds) {
    using C = Cfg<DQK>;
    constexpr int SHM_K = C::SHM_K, SHM_V = C::SHM_V, NKC = C::NKC, KCH = C::KCH, ROWB = C::ROWB;
    int tid_ = threadIdx.x; asm volatile("" : "+v"(tid_));
    const int tid = tid_, wid = tid >> 6, lane = tid & 63, r32 = lane & 31, hi = lane >> 5;
    char* V_lds = lds; char* K_lds = lds + 2 * SHM_V;
    float* ws = (float*)(lds + 2 * SHM_V + 2 * SHM_K) + wid * 64; float* li_l = ws; float* al_l = ws + 32;
    char* QR_lds = lds + 2 * SHM_V + 2 * SHM_K + 2048 + wid * 4096 + lane * 16;
    float m_reg = -1e30f, l_reg = 0; f32x16 o[4] = {}; bf16x8 qr[8];
    const bf16* Qw = Qb + (long)(wid * QBLK + r32) * LDQ + hi * 8;
    __syncthreads();
#pragma unroll
    for (int d0 = 0; d0 < 8; ++d0) qr[d0] = *reinterpret_cast<const bf16x8*>(Qw + d0 * 16);
    if constexpr (DQK == 192) {
#pragma unroll
        for (int d0 = 8; d0 < 12; ++d0) *reinterpret_cast<bf16x8*>(QR_lds + (d0 - 8) * 1024) = *reinterpret_cast<const bf16x8*>(Qw + d0 * 16);
    }
    const int sr = tid >> 4, sc = (tid & 15) * 8, vst0 = v_st(sr, sc), vst1 = v_st(32 + sr, sc);
    int krow[NKC], kcol[NKC], kdst[NKC];
#pragma unroll
    for (int i = 0; i < NKC; ++i) { const int c = tid + 512 * i; krow[i] = c / KCH; kcol[i] = (c % KCH) * 8; kdst[i] = krow[i] * ROWB + ((kcol[i] * 2) ^ kswz<DQK>(krow[i])); }
    const int vb0 = (int)(uintptr_t)V_lds + v_rd_base(lane);
    struct { bf16x8 vs0, vs1, ks[NKC]; } sr_[SDEPTH];
#define SLOAD(i, k0) do { sr_[i].vs0 = *reinterpret_cast<const bf16x8*>(&Vh[(long)((k0) + sr) * LDV + sc]); sr_[i].vs1 = *reinterpret_cast<const bf16x8*>(&Vh[(long)((k0) + 32 + sr) * LDV + sc]); \
    _Pragma("unroll") for (int q_ = 0; q_ < NKC; ++q_) sr_[i].ks[q_] = *reinterpret_cast<const bf16x8*>(&Kh[(long)((k0) + krow[q_]) * LDK + kcol[q_]]); } while (0)
#define SWRITE(b, i) do { *(bf16x8*)(V_lds + (b) * SHM_V + vst0) = sr_[i].vs0; *(bf16x8*)(V_lds + (b) * SHM_V + vst1) = sr_[i].vs1; \
    _Pragma("unroll") for (int q_ = 0; q_ < NKC; ++q_) *(bf16x8*)(K_lds + (b) * SHM_K + kdst[q_]) = sr_[i].ks[q_]; } while (0)
#define SWAIT() do { if constexpr (SDEPTH == 2) { if constexpr (NKC == 2) asm volatile("s_waitcnt vmcnt(4)" ::: "memory"); else asm volatile("s_waitcnt vmcnt(5)" ::: "memory"); } else asm volatile("s_waitcnt vmcnt(0)" ::: "memory"); } while (0)
#define RESC(a) do { if (__any((a) < 1.f)) { if (hi == 0) al_l[r32] = (a); asm volatile("s_waitcnt lgkmcnt(0)" ::: "memory"); \
    _Pragma("unroll") for (int d = 0; d < 4; ++d) _Pragma("unroll") for (int r = 0; r < 16; ++r) o[d][r] *= al_l[crow(r, hi)]; } } while (0)
    f32x16 pA0, pA1, pB0, pB1; float mnA, mnB, alA, alB; bf16x8 pa0, pa1, pa2, pa3; const int NT = seq / KVBLK;
    constexpr int SE = 0, SO = SDEPTH - 1;
    SLOAD(SE, 0); asm volatile("s_waitcnt vmcnt(0)" ::: "memory"); SWRITE(0, SE); __syncthreads();
    qkt<DQK>(pA0, pA1, K_lds, qr, QR_lds, r32, hi, f32x16{}); partialSM<DQK>(pA0, pA1, m_reg, mnA, alA);
    SLOAD(SO, KVBLK); if constexpr (SDEPTH == 2) { if (2 < NT) SLOAD(SE, 2 * KVBLK); }
    SWAIT(); SWRITE(1, SO); __syncthreads();
    for (int j = 1; j + 1 < NT; j += 2) {
        SBAR(); qkt<DQK>(pB0, pB1, K_lds + SHM_K, qr, QR_lds, r32, hi, f32x16{});
        finishSM(pA0, pA1, alA, l_reg, pa0, pa1, pa2, pa3); SBAR();
        SLOAD(SO, (j + SDEPTH) * KVBLK); SBAR();
        pv_d0(o, vb0, pa0, pa1, pa2, pa3); partialSM<DQK>(pB0, pB1, m_reg, mnB, alB);
        __syncthreads(); SWAIT(); SWRITE(0, SE);
        RESC(alB); __syncthreads();
        SBAR(); qkt<DQK>(pA0, pA1, K_lds, qr, QR_lds, r32, hi, f32x16{});
        finishSM(pB0, pB1, alB, l_reg, pa0, pa1, pa2, pa3); SBAR();
        if (SDEPTH == 1 || j + 3 < NT) SLOAD(SE, (j + 1 + SDEPTH) * KVBLK); SBAR();
        pv_d0(o, vb0 + (int)SHM_V, pa0, pa1, pa2, pa3); partialSM<DQK>(pA0, pA1, m_reg, mnA, alA);
        __syncthreads(); SWAIT(); SWRITE(1, SO);
        RESC(alA); __syncthreads();
    }
    SBAR(); qkt<DQK>(pB0, pB1, K_lds + SHM_K, qr, QR_lds, r32, hi, f32x16{});
    finishSM(pA0, pA1, alA, l_reg, pa0, pa1, pa2, pa3); SBAR();
    pv_d0(o, vb0, pa0, pa1, pa2, pa3); partialSM<DQK>(pB0, pB1, m_reg, mnB, alB);
    __syncthreads(); RESC(alB);
    finishSM(pB0, pB1, alB, l_reg, pa0, pa1, pa2, pa3); SBAR();
    pv_d0(o, vb0 + (int)SHM_V, pa0, pa1, pa2, pa3);
    if (hi == 0) li_l[r32] = l_reg; asm volatile("s_waitcnt lgkmcnt(0)" ::: "memory");
    float rli[16];
#pragma unroll
    for (int r = 0; r < 16; ++r) rli[r] = __builtin_amdgcn_rcpf(li_l[crow(r, hi)]);
    bf16* Ow = Ob + (long)(wid * QBLK) * LDO;
#pragma unroll
    for (int r = 0; r < 16; ++r) { const int orow = crow(r, hi);
#pragma unroll
        for (int d0 = 0; d0 < 4; ++d0) Ow[(long)orow * LDO + d0 * 32 + r32] = f2bf(o[d0][r] * rli[r]); }
#undef SLOAD
#undef SWRITE
#undef SWAIT
#undef RESC
}

template <int DQK, int LDQ, int LDK, int LDV, int LDO>
__device__ __forceinline__ void attn_body_s(const bf16* __restrict__ Qb, const bf16* __restrict__ Kh, const bf16* __restrict__ Vh,
                                            bf16* __restrict__ Ob, int seq, char* lds, int dup) {
    using C = Cfg<DQK>;
    constexpr int SHM_K = C::SHM_K, SHM_V = C::SHM_V, NKC = C::NKC, KCH = C::KCH, ROWB = C::ROWB;
    int tid_ = threadIdx.x; asm volatile("" : "+v"(tid_));
    const int tid = tid_, wid = __builtin_amdgcn_readfirstlane(tid >> 6), lane = tid & 63, r32 = lane & 31, hi = lane >> 5;
    const bool late = false;
    char* V_lds = lds; char* K_lds = lds + 3 * SHM_V;
    float* ws = (float*)(lds + 3 * SHM_V + 2 * SHM_K) + wid * 64; float* li_l = ws; float* al_l = ws + 32;
    char* QR_lds = lds + 3 * SHM_V + 2 * SHM_K + 2048 + wid * 4096 + lane * 16;
    float m_reg = 0.f; f32x16 o[4] = {}; f32x16 negm = {}, lsum = {}; bf16x8 qr[8];
    const bf16x8 ones = {0x3F80, 0x3F80, 0x3F80, 0x3F80, 0x3F80, 0x3F80, 0x3F80, 0x3F80};
    const bf16* Qw = Qb + (long)(wid * QBLK + r32) * LDQ + hi * 8;
    __syncthreads();
#pragma unroll
    for (int d0 = 0; d0 < 8; ++d0) qr[d0] = *reinterpret_cast<const bf16x8*>(Qw + d0 * 16);
    if constexpr (DQK == 192) {
#pragma unroll
        for (int d0 = 8; d0 < 12; ++d0) *reinterpret_cast<bf16x8*>(QR_lds + (d0 - 8) * 1024) = *reinterpret_cast<const bf16x8*>(Qw + d0 * 16);
    }
    const int sr = tid >> 4, sc = (tid & 15) * 8, vst0 = v_st(sr, sc), vst1 = v_st(32 + sr, sc);
    int ksrc[NKC], kdst[NKC];
#pragma unroll
    for (int i = 0; i < NKC; ++i) { const int c = tid + 512 * i, kr = c / KCH, kc = (c % KCH) * 8; ksrc[i] = kr * LDK + kc; kdst[i] = kr * ROWB + ((kc * 2) ^ kswz<DQK>(kr)); }
    const int vb0 = (int)(uintptr_t)V_lds + v_rd_base(lane);
    bf16x8 vs0, vs1, ks[NKC];
#define SLOAD(k0) do { vs0 = *reinterpret_cast<const bf16x8*>(&Vh[(long)((k0) + sr) * LDV + sc]); vs1 = *reinterpret_cast<const bf16x8*>(&Vh[(long)((k0) + 32 + sr) * LDV + sc]); \
    _Pragma("unroll") for (int q_ = 0; q_ < NKC; ++q_) ks[q_] = *reinterpret_cast<const bf16x8*>(&Kh[(long)(k0) * LDK + ksrc[q_]]); } while (0)
#define SWRITE(kb, vslot) do { *(bf16x8*)(V_lds + (vslot) * SHM_V + vst0) = vs0; *(bf16x8*)(V_lds + (vslot) * SHM_V + vst1) = vs1; \
    _Pragma("unroll") for (int q_ = 0; q_ < NKC; ++q_) *(bf16x8*)(K_lds + (kb) * SHM_K + kdst[q_]) = ks[q_]; } while (0)
    const int NT = seq / KVBLK;
    SLOAD(0); SWRITE(0, 0); SLOAD(KVBLK);
    __syncthreads();
    int vcur = 0, vnext = 1, vprev = 2;
    bf16x8 pa0, pa1, pa2, pa3;
    pa0 = bf16x8{}; pa1 = bf16x8{}; pa2 = bf16x8{}; pa3 = bf16x8{};
    for (int j = 0; j < NT; ++j) {
        const int b = j & 1;
        f32x16 p0, p1; float mn, al;
        if (late && j > 0) { pv_d0(o, vb0 + vprev * (int)SHM_V, pa0, pa1, pa2, pa3); }
        SBAR(); qkt<DQK>(p0, p1, K_lds + b * SHM_K, qr, QR_lds, r32, hi, negm);
        if ((PROBE_ATT & 1) && dup) { mn = 0.f; al = 1.f; } else
        partialSM2(p0, p1, m_reg, negm, al); SBAR();
        if (!((PROBE_ATT & 4) && dup)) {
        if (j + 1 < NT) { SWRITE(b ^ 1, vnext); }
        if (j + 2 < NT) { SLOAD((j + 2) * KVBLK); } }
        SBAR();
        if (__any(al < 1.f)) { if (hi == 0) al_l[r32] = al; asm volatile("s_waitcnt lgkmcnt(0)" ::: "memory");
#pragma unroll
            for (int d = 0; d < 4; ++d)
#pragma unroll
                for (int r = 0; r < 16; ++r) o[d][r] *= al_l[crow(r, hi)];
#pragma unroll
            for (int r = 0; r < 16; ++r) lsum[r] *= al_l[crow(r, hi)]; }
        if ((PROBE_ATT & 1) && dup) { pa0 = __builtin_bit_cast(bf16x8, (u32x4){cvt_pk_bf16(p0[0], p0[1]), cvt_pk_bf16(p0[2], p0[3]), cvt_pk_bf16(p0[4], p0[5]), cvt_pk_bf16(p0[6], p0[7])});
            pa1 = __builtin_bit_cast(bf16x8, (u32x4){cvt_pk_bf16(p0[8], p0[9]), cvt_pk_bf16(p0[10], p0[11]), cvt_pk_bf16(p0[12], p0[13]), cvt_pk_bf16(p0[14], p0[15])});
            pa2 = __builtin_bit_cast(bf16x8, (u32x4){cvt_pk_bf16(p1[0], p1[1]), cvt_pk_bf16(p1[2], p1[3]), cvt_pk_bf16(p1[4], p1[5]), cvt_pk_bf16(p1[6], p1[7])});
            pa3 = __builtin_bit_cast(bf16x8, (u32x4){cvt_pk_bf16(p1[8], p1[9]), cvt_pk_bf16(p1[10], p1[11]), cvt_pk_bf16(p1[12], p1[13]), cvt_pk_bf16(p1[14], p1[15])}); } else
        finishSM2(p0, p1, pa0, pa1, pa2, pa3); SBAR();
        lsum = __builtin_amdgcn_mfma_f32_32x32x16_bf16(pa0, ones, lsum, 0, 0, 0); lsum = __builtin_amdgcn_mfma_f32_32x32x16_bf16(pa1, ones, lsum, 0, 0, 0);
        lsum = __builtin_amdgcn_mfma_f32_32x32x16_bf16(pa2, ones, lsum, 0, 0, 0); lsum = __builtin_amdgcn_mfma_f32_32x32x16_bf16(pa3, ones, lsum, 0, 0, 0);
        if (!late && !((PROBE_ATT & 2) && dup)) { pv_d0(o, vb0 + vcur * (int)SHM_V, pa0, pa1, pa2, pa3); }
        if (!((PROBE_ATT & 8) && dup)) __syncthreads();
        { const int t = vprev; vprev = vcur; vcur = vnext; vnext = t; }
    }
    if (late) { pv_d0(o, vb0 + vprev * (int)SHM_V, pa0, pa1, pa2, pa3); }
    float rli[16];
#pragma unroll
    for (int r = 0; r < 16; ++r) rli[r] = __builtin_amdgcn_rcpf(lsum[r]);
    bf16* Ow = Ob + (long)(wid * QBLK) * LDO;
    char* stg = lds + wid * (32 * 272);
#pragma unroll
    for (int r = 0; r < 16; ++r) { const int orow = crow(r, hi);
#pragma unroll
        for (int d0 = 0; d0 < 4; ++d0) *reinterpret_cast<unsigned short*>(stg + orow * 272 + (d0 * 32 + r32) * 2) = f2bf(o[d0][r] * rli[r]); }
    asm volatile("s_waitcnt lgkmcnt(0)" ::: "memory");
#pragma unroll
    for (int it = 0; it < 8; ++it) { const int row = it * 4 + (lane >> 4), ch = lane & 15;
        const u32x4 v = *reinterpret_cast<const u32x4*>(stg + row * 272 + ch * 16);
        *reinterpret_cast<u32x4*>(Ow + (long)row * LDO + ch * 8) = v; }
#undef SLOAD
#undef SWRITE
}
#undef SBAR
}

struct Args { const float* in[28]; float* out; unsigned char* ws; int ph_lo, ph_hi, coop, pad; };
typedef const __attribute__((address_space(4))) Args CArgs;
enum { I_X = 0, I_C, I_CTX, I_CCTX, I_WMOD, I_BMOD, I_N1G, I_N2G, I_WIN, I_AQN, I_AKN, I_BQLN, I_BKVLN, I_WUQ, I_WUKV, I_BQNN, I_BKNN, I_BQRN, I_BKRN,
       I_WGKF, I_BGKF, I_WGKB, I_BGKB, I_CON, I_WOUT, I_WGATE, I_WUP, I_WDOWN };

__device__ __forceinline__ unsigned pk2(float lo, float hi) { return cvt_pk_bf16(lo, hi); }
struct TrDesc { const float* W; bf16_t* WT; int K, N, grp, gstride, off, item; };
__device__ __forceinline__ void tr_load(const TrDesc& t, f32x4 (&v)[16], int lane) {
    const int nblk = (t.N + 63) / 64, kb = t.item / nblk, nb = t.item % nblk, k0 = 64 * kb, n0 = 64 * nb;
    const int kr = lane >> 4, c = lane & 15; const bool valid = n0 + 4 * c < t.N;
#pragma unroll
    for (int i = 0; i < 16; ++i) v[i] = valid ? *(const f32x4*)(t.W + (size_t)(k0 + 4 * i + kr) * t.N + n0 + 4 * c) : (f32x4){0.f, 0.f, 0.f, 0.f};
}
__device__ __forceinline__ void tr_store(const TrDesc& t, const f32x4 (&v)[16], LAS float* scr, int lane) {
    const int nblk = (t.N + 63) / 64, kb = t.item / nblk, nb = t.item % nblk, k0 = 64 * kb, n0 = 64 * nb;
    const int drow0 = (n0 / t.grp) * t.gstride + (n0 % t.grp) + t.off;
    const int kr = lane >> 4, c = lane & 15;
#pragma unroll
    for (int i = 0; i < 16; ++i) { LAS float* p = scr + (4 * i + kr) * 65 + 4 * c; p[0] = v[i].x; p[1] = v[i].y; p[2] = v[i].z; p[3] = v[i].w; }
    asm volatile("s_waitcnt lgkmcnt(0)" ::: "memory");
    const int c8 = lane & 7, nl = lane >> 3;
#pragma unroll
    for (int j = 0; j < 8; ++j) { const int n = nl + 8 * j; const LAS float* s = scr + (8 * c8) * 65 + n;
        u32x4 o; o.x = pk2(s[0 * 65], s[1 * 65]); o.y = pk2(s[2 * 65], s[3 * 65]); o.z = pk2(s[4 * 65], s[5 * 65]); o.w = pk2(s[6 * 65], s[7 * 65]);
        if (n0 + n < t.N) *(u32x4*)(t.WT + (size_t)(drow0 + n) * t.K + k0 + 8 * c8) = o; }
    asm volatile("s_waitcnt lgkmcnt(0)" ::: "memory");
}
constexpr int TR_IN = 32 * 62, TR_UQ = 8 * 12, TR_UKV = 4 * 16, TR_OUT = 32 * 32, TR_G = 32 * 88, TR_D = 88 * 32, TR_L = TR_IN + TR_UQ + TR_UKV + TR_OUT + 2 * TR_G + TR_D;
__device__ __forceinline__ TrDesc tr_decode(CArgs& a, int it) {
    constexpr int BIG = 1 << 30;
    const int l = it / TR_L; int r = it % TR_L;
    unsigned char* wb = a.ws + WS_W + (size_t)l * W_LAYER;
    if (r < TR_IN) return TrDesc{a.in[I_WIN] + (size_t)l * DM * INC, (bf16_t*)(wb + WO_IN), DM, INC, BIG, 0, 0, r}; r -= TR_IN;
    if (r < TR_UQ) return TrDesc{a.in[I_WUQ] + (size_t)l * 512 * 768, (bf16_t*)(wb + WO_UQ), 512, 768, BIG, 0, 0, r}; r -= TR_UQ;
    if (r < TR_UKV) return TrDesc{a.in[I_WUKV] + (size_t)l * 256 * 1024, (bf16_t*)(wb + WO_UKV), 256, 1024, BIG, 0, 0, r}; r -= TR_UKV;
    if (r < TR_OUT) return TrDesc{a.in[I_WOUT] + (size_t)l * DM * DM, (bf16_t*)(wb + WO_OUT), DM, DM, BIG, 0, 0, r}; r -= TR_OUT;
    if (r < TR_G) return TrDesc{a.in[I_WGATE] + (size_t)l * DM * DFF, (bf16_t*)(wb + WO_GU), DM, DFF, 128, 256, 0, r}; r -= TR_G;
    if (r < TR_G) return TrDesc{a.in[I_WUP] + (size_t)l * DM * DFF, (bf16_t*)(wb + WO_GU), DM, DFF, 128, 256, 128, r}; r -= TR_G;
    return TrDesc{a.in[I_WDOWN] + (size_t)l * DFF * DM, (bf16_t*)(wb + WO_DN), DFF, DM, BIG, 0, 0, r};
}
__device__ __forceinline__ void transposes_dynamic(CArgs& a, LAS unsigned char* lds, int layer) {
    int tid = threadIdx.x; asm volatile("" : "+v"(tid));
    const int lane = tid & 63, wid = tid >> 6;
    LAS float* scr = (LAS float*)(lds + wid * 16640);
    unsigned* ctr = (unsigned*)(a.ws + WS_CTL) + CW_QUEUE + 128 + 64 * layer;
    for (;;) {
        unsigned base = 0; if (lane == 0) base = atomicAdd(ctr, 2u);
        const int it = __builtin_amdgcn_readfirstlane(base);
        if (it >= TR_L) break;
        const bool two = it + 1 < TR_L;
        const TrDesc t0 = tr_decode(a, layer * TR_L + it), t1 = tr_decode(a, layer * TR_L + (two ? it + 1 : it));
        f32x4 v0[16], v1[16];
        tr_load(t0, v0, lane); tr_load(t1, v1, lane);
        tr_store(t0, v0, scr, lane);
        if (two) tr_store(t1, v1, scr, lane);
    }
}
__device__ __forceinline__ void phase_prologue(CArgs& a, LAS unsigned char* lds) {
    int tid = threadIdx.x; asm volatile("" : "+v"(tid));
    const int lane = tid & 63, wid = tid >> 6;
    LAS float* scr = (LAS float*)(lds + wid * 16384);
    const int gw = blockIdx.x * 8 + wid, NGW = gridDim.x * 8;
    float* MOD = (float*)(a.ws + WS_MOD);
    for (int it = blockIdx.x; it < 2 * 96; it += gridDim.x) {
        const int l = it / 96, jb = it % 96;
        __syncthreads();
#pragma unroll
        for (int q = 0; q < 4; ++q) { const int k = wid * 256 + q * 64 + lane;
#pragma unroll
            for (int v = 0; v < 5; ++v) { const float cv = (v < 4) ? a.in[I_C][v * DM + k] : a.in[I_CCTX][k]; scr[v * 256 + q * 64 + lane] = silu_f(cv); } }
        asm volatile("s_waitcnt lgkmcnt(0)" ::: "memory");
        const float* W = a.in[I_WMOD] + (size_t)l * DM * 12288 + (size_t)(wid * 256) * 12288 + jb * 128 + lane * 2;
        f32x2 acc[5];
#pragma unroll
        for (int v = 0; v < 5; ++v) acc[v] = (f32x2){0.f, 0.f};
        for (int k0 = 0; k0 < 256; k0 += 64) { f32x2 wv[64];
#pragma unroll
            for (int e = 0; e < 64; ++e) wv[e] = *(const f32x2*)(W + (size_t)(k0 + e) * 12288);
#pragma unroll
            for (int e = 0; e < 64; ++e) { const int kk = k0 + e; const f32x2 w = wv[e];
#pragma unroll
            for (int v = 0; v < 5; ++v) acc[v] += scr[v * 256 + kk] * w; } }
#pragma unroll
        for (int v = 0; v < 5; ++v) *(LAS f32x2*)(scr + 2048 + v * 128 + lane * 2) = acc[v];
        __syncthreads();
        if (wid < 5) { f32x2 sum = *(const f32x2*)(a.in[I_BMOD] + l * 12288 + jb * 128 + lane * 2);
#pragma unroll
            for (int w = 0; w < 8; ++w) sum += *(const LAS f32x2*)((LAS float*)(lds + w * 16384) + 2048 + wid * 128 + lane * 2);
            *(f32x2*)(MOD + (size_t)(l * 5 + wid) * 12288 + jb * 128 + lane * 2) = sum; }
    }
    __syncthreads();
    transposes_dynamic(a, lds, 0); transposes_dynamic(a, lds, 1);
    for (int l = 0; l < 2; ++l) { u32x4* z = (u32x4*)(a.ws + WS_W + (size_t)l * W_LAYER + WO_IN + (size_t)INC * DM * 2);
        for (int i = blockIdx.x * 512 + tid; i < (INP - INC) * DM * 2 / 16; i += gridDim.x * 512) z[i] = (u32x4){0u, 0u, 0u, 0u}; }
}

__device__ __forceinline__ void phase_norm(CArgs& a, int l, int which) {
    int tid = threadIdx.x; asm volatile("" : "+v"(tid));
    const int lane = tid & 63, wid = tid >> 6;
    const int gw = blockIdx.x * 8 + wid, NGW = gridDim.x * 8;
    const float* MOD = (const float*)(a.ws + WS_MOD) + (size_t)l * 5 * 12288;
    const float* MOD0 = (const float*)(a.ws + WS_MOD);
    const float* gn = a.in[which ? I_N2G : I_N1G] + l * DM;
    float* XR = (float*)(a.ws + WS_XR);
    const float* PART = (const float*)a.out + PART_OFF;
    bf16_t* H = (bf16_t*)(a.ws + WS_HZ);
    const bool skip = (l == 1 && which == 1);
    const int npart = (l == 0 && which == 1) ? 8 : ((l == 1 && which == 0) ? 4 : 0);
    for (int r0 = gw; r0 < NR; r0 += 2 * NGW) {
        f32x4 x[2][8]; const float* sh[2]; const float* sc[2]; bool ok[2];
#pragma unroll
        for (int u = 0; u < 2; ++u) { const int r = r0 + u * NGW; ok[u] = r < NR; const int rr = ok[u] ? r : r0;
            const int b = rr / TOK, i = rr - b * TOK, v = (i < CTXL) ? 4 : b;
            if (skip && i < CTXL) ok[u] = false;
            const bool first = (l == 0 && which == 0), ctxsplit = (npart == 8 && i < CTXL);
            const float* src = (first || ctxsplit) ? (i < CTXL ? a.in[I_CTX] + ((size_t)b * CTXL + i) * DM : a.in[I_X] + ((size_t)b * SEQ + (i - CTXL)) * DM) : XR + (size_t)rr * DM;
            sh[u] = MOD + (size_t)v * 12288 + (which * 3 + 0) * DM; sc[u] = MOD + (size_t)v * 12288 + (which * 3 + 1) * DM;
#pragma unroll
            for (int j = 0; j < 8; ++j) x[u][j] = *(const f32x4*)(src + 4 * lane + 256 * j);
            if (npart && i < CTXL) {
                const float* gt = MOD0 + (size_t)4 * 12288 + (npart == 8 ? 2 : 5) * DM;
                f32x4 ps[8];
#pragma unroll
                for (int j = 0; j < 8; ++j) ps[j] = (f32x4){0.f, 0.f, 0.f, 0.f};
                for (int p = 0; p < npart; ++p)
#pragma unroll
                    for (int j = 0; j < 8; ++j) ps[j] += *(const f32x4*)(PART + ((size_t)(p * 32 + b * 8 + j) << 16) + i * 256 + 4 * lane);
#pragma unroll
                for (int j = 0; j < 8; ++j) { x[u][j] += *(const f32x4*)(gt + 4 * lane + 256 * j) * ps[j]; *(f32x4*)(XR + (size_t)rr * DM + 4 * lane + 256 * j) = x[u][j]; }
            } }
#pragma unroll
        for (int u = 0; u < 2; ++u) { float ss = 0.f;
#pragma unroll
            for (int j = 0; j < 8; ++j) ss += (x[u][j].x * x[u][j].x + x[u][j].y * x[u][j].y) + (x[u][j].z * x[u][j].z + x[u][j].w * x[u][j].w);
            const float rs = rsqrtf(wave_sum(ss) * (1.f / DM) + EPS);
            if (!ok[u]) continue;
            bf16_t* o = H + (size_t)(r0 + u * NGW) * DM;
#pragma unroll
            for (int j = 0; j < 8; ++j) { const int c = 4 * lane + 256 * j; const f32x4 g = *(const f32x4*)(gn + c), s1 = *(const f32x4*)(sc[u] + c), s0 = *(const f32x4*)(sh[u] + c);
                const f32x4 y = (x[u][j] * rs) * g * (1.f + s1) + s0;
                u32x2 w; w.x = cvt_pk_bf16(y.x, y.y); w.y = cvt_pk_bf16(y.z, y.w); *(u32x2*)(o + c) = w; } }
    }
}

__device__ __forceinline__ void rope128(float& y0, float& y1, int lane, int prow, int pcol) {
    const float pos = (float)(lane < 32 ? prow : pcol);
    const int i0 = (2 * lane) & 31;
    const float f0 = __builtin_amdgcn_exp2f(-(float)i0 * (13.287712379549449f / 32.f)), f1 = __builtin_amdgcn_exp2f(-(float)(i0 + 1) * (13.287712379549449f / 32.f));
    const float a0 = pos * f0, a1 = pos * f1;
    const float c0 = __cosf(a0), s0 = __sinf(a0), c1 = __cosf(a1), s1 = __sinf(a1);
    const float p0 = __shfl_xor(y0, 16), p1 = __shfl_xor(y1, 16);
    if (((lane >> 4) & 1) == 0) { y0 = y0 * c0 - p0 * s0; y1 = y1 * c1 - p1 * s1; }
    else { y0 = p0 * s0 + y0 * c0; y1 = p1 * s1 + y1 * c1; }
}
__device__ __forceinline__ void rope64(float& y0, float& y1, int lane, int prow, int pcol) {
    const int l = lane & 31;
    const float pos = (float)(l < 16 ? prow : pcol);
    const int i0 = (2 * l) & 15;
    const float f0 = __builtin_amdgcn_exp2f(-(float)i0 * (13.287712379549449f / 16.f)), f1 = __builtin_amdgcn_exp2f(-(float)(i0 + 1) * (13.287712379549449f / 16.f));
    const float a0 = pos * f0, a1 = pos * f1;
    const float c0 = __cosf(a0), s0 = __sinf(a0), c1 = __cosf(a1), s1 = __sinf(a1);
    const float p0 = __shfl_xor(y0, 8), p1 = __shfl_xor(y1, 8);
    if (((l >> 3) & 1) == 0) { y0 = y0 * c0 - p0 * s0; y1 = y1 * c1 - p1 * s1; }
    else { y0 = p0 * s0 + y0 * c0; y1 = p1 * s1 + y1 * c1; }
}

struct E1Regs { u32x4 hq[3]; u32x4 cqw; u32x2 ckw; unsigned krw; };
__device__ __forceinline__ void e1_load(CArgs& a, int r, int lane, E1Regs& g) {
    const bf16_t* P0 = (const bf16_t*)(a.ws + WS_PROJ) + (size_t)r * INP;
#pragma unroll
    for (int t = 0; t < 3; ++t) g.hq[t] = *((const u32x4*)(P0 + t * 512) + lane);
    g.cqw = *((const u32x4*)(P0 + C_BCQ) + lane);
    g.ckw = *((const u32x2*)(P0 + C_BCKV) + lane);
    g.krw = *((const unsigned*)(P0 + C_BKR) + (lane & 31));
}
__device__ __forceinline__ void e1_row(CArgs& a, int l, int r, int lane, int dup, const E1Regs& g) {
    bf16_t* P0 = (bf16_t*)(a.ws + WS_PROJ) + (size_t)r * INP;
    bf16_t* P = dup ? (bf16_t*)((float*)a.out + (10u << 20)) + (size_t)r * 2368 : P0;
    const int i = r % TOK; const bool lat = i >= CTXL; const int n = i - CTXL, prow = n >> 6, pcol = n & 63;
    { const int li = lane & 15, hsub = lane >> 4;
      const float pos = (float)(li < 8 ? prow : pcol); const bool second = ((li >> 2) & 1) != 0;
      float cs[8], sn[8];
      if (lat) {
#pragma unroll
          for (int e = 0; e < 8; ++e) { const float ang = pos * __builtin_amdgcn_exp2f(-(float)(8 * (li & 3) + e) * (13.287712379549449f / 32.f)); cs[e] = __cosf(ang); sn[e] = __sinf(ang); } }
#pragma unroll
      for (int t = 0; t < 3; ++t) { const int hh = 4 * t + hsub; const u32x4 w = g.hq[t];
          float x[8] = {bflo(w.x), bfhi(w.x), bflo(w.y), bfhi(w.y), bflo(w.z), bfhi(w.z), bflo(w.w), bfhi(w.w)};
          float ss = 0.f;
#pragma unroll
          for (int e = 0; e < 8; ++e) ss += x[e] * x[e];
#pragma unroll
          for (int m = 1; m < 16; m <<= 1) ss += __shfl_xor(ss, m);
          const float rs = rsqrtf(ss * (1.f / 128.f) + EPS) * (hh < 8 ? QSCALE_A : 1.f);
          const float* gg = a.in[hh < 8 ? I_AQN : I_AKN] + l * 128 + 8 * li;
          const f32x4 ga = *(const f32x4*)gg, gb = *(const f32x4*)(gg + 4);
          float y[8] = {x[0] * rs * ga.x, x[1] * rs * ga.y, x[2] * rs * ga.z, x[3] * rs * ga.w, x[4] * rs * gb.x, x[5] * rs * gb.y, x[6] * rs * gb.z, x[7] * rs * gb.w};
          if (lat) {
#pragma unroll
              for (int e = 0; e < 8; ++e) { const float p = __shfl_xor(y[e], 4); y[e] = second ? (p * sn[e] + y[e] * cs[e]) : (y[e] * cs[e] - p * sn[e]); } }
          u32x4 o; o.x = cvt_pk_bf16(y[0], y[1]); o.y = cvt_pk_bf16(y[2], y[3]); o.z = cvt_pk_bf16(y[4], y[5]); o.w = cvt_pk_bf16(y[6], y[7]);
          if (hh < 10) *((u32x4*)(P + t * 512) + lane) = o; } }
    { const u32x4 w = g.cqw;
        float x[8] = {bflo(w.x), bfhi(w.x), bflo(w.y), bfhi(w.y), bflo(w.z), bfhi(w.z), bflo(w.w), bfhi(w.w)};
        float ss = 0.f;
#pragma unroll
        for (int e = 0; e < 8; ++e) ss += x[e] * x[e];
        const float rs = rsqrtf(wave_sum(ss) * (1.f / 512.f) + EPS);
        const float* gg = a.in[I_BQLN] + l * 512 + 8 * lane;
        u32x4 o; o.x = cvt_pk_bf16(x[0] * rs * gg[0], x[1] * rs * gg[1]); o.y = cvt_pk_bf16(x[2] * rs * gg[2], x[3] * rs * gg[3]);
        o.z = cvt_pk_bf16(x[4] * rs * gg[4], x[5] * rs * gg[5]); o.w = cvt_pk_bf16(x[6] * rs * gg[6], x[7] * rs * gg[7]); *((u32x4*)(P + C_BCQ) + lane) = o;
    }
    { const u32x2 w = g.ckw;
        float x[4] = {bflo(w.x), bfhi(w.x), bflo(w.y), bfhi(w.y)};
        const float rs = rsqrtf(wave_sum(x[0] * x[0] + x[1] * x[1] + x[2] * x[2] + x[3] * x[3]) * (1.f / 256.f) + EPS);
        const float* gg = a.in[I_BKVLN] + l * 256 + 4 * lane;
        u32x2 o; o.x = cvt_pk_bf16(x[0] * rs * gg[0], x[1] * rs * gg[1]); o.y = cvt_pk_bf16(x[2] * rs * gg[2], x[3] * rs * gg[3]); *((u32x2*)(P + C_BCKV) + lane) = o;
    }
    { const unsigned w = g.krw;
        float x0 = lane < 32 ? bflo(w) : 0.f, x1 = lane < 32 ? bfhi(w) : 0.f;
        const float rs = rsqrtf(wave_sum(x0 * x0 + x1 * x1) * (1.f / 64.f) + EPS);
        const float* gg = a.in[I_BKRN] + l * 64 + 2 * (lane & 31);
        float y0 = x0 * rs * gg[0], y1 = x1 * rs * gg[1];
        if (lat) rope64(y0, y1, lane, prow, pcol);
        if (lane < 32) *((unsigned*)(P + C_BKR) + lane) = cvt_pk_bf16(y0, y1);
    }
}
struct E2Regs { u32x4 qn, qr, kn, kr; };
__device__ __forceinline__ void e2_load(CArgs& a, int r, int lane, E2Regs& g) {
    const bf16_t* Q0 = (const bf16_t*)(a.ws + WS_QB) + (size_t)r * 768;
    const bf16_t* KV = (const bf16_t*)(a.ws + WS_KVB) + (size_t)r * 1024;
    const bf16_t* P = (const bf16_t*)(a.ws + WS_PROJ) + (size_t)r * INP;
    const int h16 = lane >> 4, li = lane & 15, h8 = (lane >> 3) & 3, li8 = lane & 7;
    g.qn = *(const u32x4*)(Q0 + h16 * 192 + 8 * li);
    g.qr = *(const u32x4*)(Q0 + h8 * 192 + 128 + 8 * li8);
    g.kn = *(const u32x4*)(KV + h16 * 256 + 8 * li);
    g.kr = *(const u32x4*)(P + C_BKR + 8 * li8);
}
__device__ __forceinline__ void e2_row(CArgs& a, int l, int r, int lane, int dup, const E2Regs& g) {
    bf16_t* Q = dup ? (bf16_t*)((float*)a.out + (10u << 20)) + (size_t)r * 768 : (bf16_t*)(a.ws + WS_QB) + (size_t)r * 768;
    bf16_t* KB = dup ? (bf16_t*)((float*)a.out + (18u << 20)) + (size_t)r * 768 : (bf16_t*)(a.ws + WS_KB) + (size_t)r * 768;
    const int i = r % TOK; const bool lat = i >= CTXL; const int n = i - CTXL, prow = n >> 6, pcol = n & 63;
    const int h16 = lane >> 4, li = lane & 15, h8 = (lane >> 3) & 3, li8 = lane & 7;
#define E2_UNPK(wv_, arr_) float arr_[8] = {bflo(wv_[0]), bfhi(wv_[0]), bflo(wv_[1]), bfhi(wv_[1]), bflo(wv_[2]), bfhi(wv_[2]), bflo(wv_[3]), bfhi(wv_[3])}
    { E2_UNPK(g.qn, x); float ss = 0.f;
#pragma unroll
      for (int e = 0; e < 8; ++e) ss += x[e] * x[e];
#pragma unroll
      for (int m = 1; m < 16; m <<= 1) ss += __shfl_xor(ss, m);
      const float rs = rsqrtf(ss * (1.f / 128.f) + EPS) * QSCALE_B;
      const float* gg = a.in[I_BQNN] + l * 128 + 8 * li; const f32x4 ga = *(const f32x4*)gg, gb = *(const f32x4*)(gg + 4);
      u32x4 o; o.x = cvt_pk_bf16(x[0] * rs * ga.x, x[1] * rs * ga.y); o.y = cvt_pk_bf16(x[2] * rs * ga.z, x[3] * rs * ga.w);
      o.z = cvt_pk_bf16(x[4] * rs * gb.x, x[5] * rs * gb.y); o.w = cvt_pk_bf16(x[6] * rs * gb.z, x[7] * rs * gb.w);
      *(u32x4*)(Q + h16 * 192 + 8 * li) = o; }
    { E2_UNPK(g.qr, x); float ss = 0.f;
#pragma unroll
      for (int e = 0; e < 8; ++e) ss += x[e] * x[e];
#pragma unroll
      for (int m = 1; m < 8; m <<= 1) ss += __shfl_xor(ss, m);
      const float rs = rsqrtf(ss * (1.f / 64.f) + EPS) * QSCALE_B;
      const float* gg = a.in[I_BQRN] + l * 64 + 8 * li8; const f32x4 ga = *(const f32x4*)gg, gb = *(const f32x4*)(gg + 4);
      float y[8] = {x[0] * rs * ga.x, x[1] * rs * ga.y, x[2] * rs * ga.z, x[3] * rs * ga.w, x[4] * rs * gb.x, x[5] * rs * gb.y, x[6] * rs * gb.z, x[7] * rs * gb.w};
      if (lat) { const float pos = (float)(li8 < 4 ? prow : pcol); const bool second = ((li8 >> 1) & 1) != 0;
#pragma unroll
          for (int e = 0; e < 8; ++e) { const float ang = pos * __builtin_amdgcn_exp2f(-(float)(8 * (li8 & 1) + e) * (13.287712379549449f / 16.f));
              const float c = __cosf(ang), sn = __sinf(ang), p = __shfl_xor(y[e], 2); y[e] = second ? (p * sn + y[e] * c) : (y[e] * c - p * sn); } }
      u32x4 o; o.x = cvt_pk_bf16(y[0], y[1]); o.y = cvt_pk_bf16(y[2], y[3]); o.z = cvt_pk_bf16(y[4], y[5]); o.w = cvt_pk_bf16(y[6], y[7]);
      if (lane < 32) { *(u32x4*)(Q + h8 * 192 + 128 + 8 * li8) = o; *(u32x4*)(KB + h8 * 192 + 128 + 8 * li8) = g.kr; } }
    { E2_UNPK(g.kn, x); float ss = 0.f;
#pragma unroll
      for (int e = 0; e < 8; ++e) ss += x[e] * x[e];
#pragma unroll
      for (int m = 1; m < 16; m <<= 1) ss += __shfl_xor(ss, m);
      const float rs = rsqrtf(ss * (1.f / 128.f) + EPS);
      const float* gg = a.in[I_BKNN] + l * 128 + 8 * li; const f32x4 ga = *(const f32x4*)gg, gb = *(const f32x4*)(gg + 4);
      u32x4 o; o.x = cvt_pk_bf16(x[0] * rs * ga.x, x[1] * rs * ga.y); o.y = cvt_pk_bf16(x[2] * rs * ga.z, x[3] * rs * ga.w);
      o.z = cvt_pk_bf16(x[4] * rs * gb.x, x[5] * rs * gb.y); o.w = cvt_pk_bf16(x[6] * rs * gb.z, x[7] * rs * gb.w);
      *(u32x4*)(KB + h16 * 192 + 8 * li) = o; }
#undef E2_UNPK
}

constexpr int GS = 65, GA = 64 * GS;
constexpr int GL_QF = 0, GL_QB = GA, GL_CGF = 33664, GL_CGB = 34688, GL_WF = 35712, GL_WB = 36736, GL_BF = 37760, GL_BB = 37824, GL_END = 37888;
constexpr int GB_QDF = 33280, GB_QDB = 42496, GB_KDF = 51712, GB_KDB = 60928, GB_VT = 70144, GB_ATT = 88576, GB_SFT = 97792, GB_SBT = 116224;
constexpr int HS = 72;
static_assert(GL_END * 4 <= LDS_QWORD && GB_SBT + 128 * HS * 2 <= GL_CGF * 4, "GLA LDS");
__device__ __forceinline__ bf16x8 ldfrag(const LAS unsigned char* base, int row, int ks, int hi) { return *(const LAS bf16x8*)(base + row * (HS * 2) + ks * 32 + hi * 16); }
__device__ __forceinline__ int crow16(int r, int hi) { return (r & 3) + 8 * (r >> 2) + 4 * hi; }
__device__ __forceinline__ float logsig(float x) { return fminf(x, 0.f) - __logf(1.f + __expf(-fabsf(x))); }
__device__ __forceinline__ float wave_incl_scan(float x, int lane) {
#pragma unroll
    for (int o = 1; o < 64; o <<= 1) { const float t = __shfl_up(x, o); if (lane >= o) x += t; }
    return x;
}
__device__ __forceinline__ void gla_store_vt(const u32x4 v0, const u32x4 v1, LAS unsigned char* B, int wid, int lane) {
    const int e0 = (lane & 15) * 8;
#pragma unroll
    for (int i = 0; i < 2; ++i) { const u32x4 v = i ? v1 : v0; const int j = 8 * wid + 4 * i + (lane >> 4);
#pragma unroll
        for (int q = 0; q < 4; ++q) { *(LAS unsigned short*)(B + GB_VT + ((e0 + 2 * q) * HS + j) * 2) = (unsigned short)(v[q] & 0xffffu);
            *(LAS unsigned short*)(B + GB_VT + ((e0 + 2 * q + 1) * HS + j) * 2) = (unsigned short)(v[q] >> 16); } }
}
__device__ __forceinline__ void gla_p1(CArgs& a, int l, int cc, int h, LAS float* L, int dup, bool stagew) {
    int tid = threadIdx.x; asm volatile("" : "+v"(tid));
    LAS unsigned char* B = (LAS unsigned char*)L;
    const int wid = __builtin_amdgcn_readfirstlane(tid >> 6), lane = tid & 63;
    const bf16_t* Pj = (const bf16_t*)(a.ws + WS_PROJ) + (size_t)(cc * 64 + lane) * INP;
    float* KVS = (float*)(a.ws + WS_KVS); float* DEC = (float*)(a.ws + WS_DEC);
    bf16_t* GQ = (bf16_t*)a.out + (size_t)(cc * 4 + h) * 16384;
    const int slot = (cc * 4 + h) * 2;
    const bf16_t* Pw = (const bf16_t*)(a.ws + WS_PROJ) + (size_t)(cc * 64 + 8 * wid) * INP;
    const int lr8 = lane >> 3, lc8 = lane & 7;
    const u32x4 cgx = *(const u32x4*)(Pw + (size_t)((lane >> 2) & 7) * INP + C_CGF + (lane & 3) * 8);
    const u32x4 kx = *(const u32x4*)(Pw + (size_t)lr8 * INP + C_CK + h * 64 + lc8 * 8), qx = *(const u32x4*)(Pw + (size_t)lr8 * INP + C_CQ + h * 64 + lc8 * 8);
    const u32x4 v0 = *(const u32x4*)(Pw + (size_t)(lane >> 4) * INP + C_CV + h * 128 + (lane & 15) * 8), v1 = *(const u32x4*)(Pw + (size_t)(4 + (lane >> 4)) * INP + C_CV + h * 128 + (lane & 15) * 8);
    __syncthreads();
    { LAS unsigned char* S = B + GB_SFT;
      if (lane < 32) *(LAS u32x4*)(S + (8 * wid + (lane >> 2)) * 64 + (lane & 3) * 16) = cgx;
      *(LAS u32x4*)(S + 4096 + (8 * wid + lr8) * 128 + lc8 * 16) = kx; *(LAS u32x4*)(S + 12288 + (8 * wid + lr8) * 128 + lc8 * 16) = qx; }
    if (stagew) {
    for (int i = tid; i < 2048; i += 512) { const int dir = i >> 10, r = (i >> 6) & 15, d = i & 63; L[(dir ? GL_WB : GL_WF) + d * 16 + r] = a.in[dir ? I_WGKB : I_WGKF][(size_t)l * 16 * 256 + r * 256 + h * 64 + d]; }
    if (tid < 128) { const int dir = tid >> 6, d = tid & 63; L[(dir ? GL_BB : GL_BF) + d] = a.in[dir ? I_BGKB : I_BGKF][l * 256 + h * 64 + d]; } }
    gla_store_vt(v0, v1, B, wid, lane);
    __syncthreads();
    if (PROBE_CUT == 1 && dup) return;
    float cgf[16], cgb[16];
    const LAS unsigned char* S = B + GB_SFT;
    const u32x4 g0 = *(const LAS u32x4*)(S + lane * 64), g1 = *(const LAS u32x4*)(S + lane * 64 + 16), g2 = *(const LAS u32x4*)(S + lane * 64 + 32), g3 = *(const LAS u32x4*)(S + lane * 64 + 48);
    const u32x4 k8 = *(const LAS u32x4*)(S + 4096 + lane * 128 + wid * 16), q8 = *(const LAS u32x4*)(S + 12288 + lane * 128 + wid * 16);
    { const unsigned wf[8] = {g0.x, g0.y, g0.z, g0.w, g1.x, g1.y, g1.z, g1.w}, wb[8] = {g2.x, g2.y, g2.z, g2.w, g3.x, g3.y, g3.z, g3.w};
#pragma unroll
      for (int q = 0; q < 8; ++q) { cgf[2 * q] = bflo(wf[q]); cgf[2 * q + 1] = bfhi(wf[q]); cgb[2 * q] = bflo(wb[q]); cgb[2 * q + 1] = bfhi(wb[q]); } }
    const unsigned kw[4] = {k8.x, k8.y, k8.z, k8.w}, qw[4] = {q8.x, q8.y, q8.z, q8.w};
    float oqf[8], oqb[8], okf[8], okb[8];
#pragma unroll
    for (int dd = 0; dd < 8; ++dd) { const int d = 8 * wid + dd;
        float pf = L[GL_BF + d], pb = L[GL_BB + d];
#pragma unroll
        for (int q = 0; q < 4; ++q) { const f32x4 wf4 = *(const LAS f32x4*)(L + GL_WF + d * 16 + 4 * q), wb4 = *(const LAS f32x4*)(L + GL_WB + d * 16 + 4 * q);
#pragma unroll
            for (int e = 0; e < 4; ++e) { pf += cgf[4 * q + e] * wf4[e]; pb += cgb[4 * q + e] * wb4[e]; } }
        const float gf = logsig(pf) * (1.f / 16.f), gb = logsig(pb) * (1.f / 16.f);
        const float cf = wave_incl_scan(gf, lane), pbi = wave_incl_scan(gb, lane);
        const float totf = __shfl(cf, 63), totb = __shfl(pbi, 63);
        const float cb = totb - pbi + gb;
        const float k = (dd & 1) ? bfhi(kw[dd >> 1]) : bflo(kw[dd >> 1]), q = ((dd & 1) ? bfhi(qw[dd >> 1]) : bflo(qw[dd >> 1])) * 0.125f;
        oqf[dd] = q * __expf(cf); oqb[dd] = q * __expf(cb); okf[dd] = k * __expf(-cf); okb[dd] = k * __expf(-cb);
        *(LAS unsigned short*)(B + GB_QDF + (d * HS + lane) * 2) = f2bf(k * __expf(totf - cf));
        *(LAS unsigned short*)(B + GB_QDB + (d * HS + lane) * 2) = f2bf(k * __expf(totb - cb));
        if (lane == 0) { DEC[(size_t)slot * 64 + d] = __expf(totf); DEC[(size_t)(slot + 1) * 64 + d] = __expf(totb); } }
    { u32x4 w;
      w.x = cvt_pk_bf16(oqf[0], oqf[1]); w.y = cvt_pk_bf16(oqf[2], oqf[3]); w.z = cvt_pk_bf16(oqf[4], oqf[5]); w.w = cvt_pk_bf16(oqf[6], oqf[7]); *(u32x4*)(GQ + 0 * 4096 + lane * 64 + 8 * wid) = w;
      w.x = cvt_pk_bf16(oqb[0], oqb[1]); w.y = cvt_pk_bf16(oqb[2], oqb[3]); w.z = cvt_pk_bf16(oqb[4], oqb[5]); w.w = cvt_pk_bf16(oqb[6], oqb[7]); *(u32x4*)(GQ + 1 * 4096 + lane * 64 + 8 * wid) = w;
      w.x = cvt_pk_bf16(okf[0], okf[1]); w.y = cvt_pk_bf16(okf[2], okf[3]); w.z = cvt_pk_bf16(okf[4], okf[5]); w.w = cvt_pk_bf16(okf[6], okf[7]); *(u32x4*)(GQ + 2 * 4096 + lane * 64 + 8 * wid) = w;
      w.x = cvt_pk_bf16(okb[0], okb[1]); w.y = cvt_pk_bf16(okb[2], okb[3]); w.z = cvt_pk_bf16(okb[4], okb[5]); w.w = cvt_pk_bf16(okb[6], okb[7]); *(u32x4*)(GQ + 3 * 4096 + lane * 64 + 8 * wid) = w; }
    if (PROBE_CUT == 2 && dup) return;
    __syncthreads();
    { const int r32 = lane & 31, hi = lane >> 5, dir = wid >> 2, eb = wid & 3;
      const LAS unsigned char* X = B + GB_VT; const LAS unsigned char* Y = B + (dir ? GB_QDB : GB_QDF);
      f32x16 c0 = {}, c1 = {};
#pragma unroll
      for (int ks = 0; ks < 4; ++ks) { const bf16x8 av = ldfrag(X, 32 * eb + r32, ks, hi), b0 = ldfrag(Y, r32, ks, hi), b1 = ldfrag(Y, 32 + r32, ks, hi);
          c0 = __builtin_amdgcn_mfma_f32_32x32x16_bf16(av, b0, c0, 0, 0, 0); c1 = __builtin_amdgcn_mfma_f32_32x32x16_bf16(av, b1, c1, 0, 0, 0); }
      float* out = KVS + (size_t)(slot + dir) * 8192;
#pragma unroll
      for (int r = 0; r < 16; ++r) { const int e = 32 * eb + crow16(r, hi); out[e * 64 + r32] = c0[r]; out[e * 64 + 32 + r32] = c1[r]; } }
}
__device__ __forceinline__ void gla_scan(CArgs& a, int dup) {
    float* KVS = (float*)(a.ws + WS_KVS); float* KVO = dup ? (float*)a.out + (10u << 20) : KVS; const float* DEC = (const float*)(a.ws + WS_DEC);
    int tid = threadIdx.x; asm volatile("" : "+v"(tid));
    for (int g = blockIdx.x * 512 + tid; g < 32 * 2048; g += gridDim.x * 512) {
        const int seq = g >> 11, el = (g & 2047) * 4, d = el & 63, b = seq >> 3, h = (seq >> 1) & 3, dir = seq & 1;
        f32x4 carry = {0.f, 0.f, 0.f, 0.f};
        for (int s0 = 0; s0 < 68; s0 += 17) {
            f32x4 kv[17], dc[17]; size_t ad[17];
#pragma unroll
            for (int q = 0; q < 17; ++q) { const int s = s0 + q; const int c = dir == 0 ? s : (s < 4 ? 3 - s : 71 - s); const size_t slot = (size_t)((b * 68 + c) * 4 + h) * 2 + dir;
                ad[q] = slot * 8192 + el; kv[q] = *(const f32x4*)(KVS + ad[q]); dc[q] = *(const f32x4*)(DEC + slot * 64 + d); }
#pragma unroll
            for (int q = 0; q < 17; ++q) { *(f32x4*)(KVO + ad[q]) = carry; carry = dc[q] * carry + kv[q]; }
        }
    }
}
__device__ __forceinline__ void gla_p3(CArgs& a, int l, int cc, int h, LAS float* L) {
    int tid = threadIdx.x; asm volatile("" : "+v"(tid));
    LAS unsigned char* B = (LAS unsigned char*)L;
    const int wid = tid >> 6, lane = tid & 63, r32 = lane & 31, hi = lane >> 5;
    const bf16_t* P = (const bf16_t*)(a.ws + WS_PROJ) + (size_t)(cc * 64) * INP;
    const float* KVS = (const float*)(a.ws + WS_KVS);
    const bf16_t* GQ = (const bf16_t*)a.out + (size_t)(cc * 4 + h) * 16384;
    const int slot = (cc * 4 + h) * 2;
    u32x4 qk[4];
#pragma unroll
    for (int q = 0; q < 4; ++q) qk[q] = *(const u32x4*)(GQ + (size_t)(tid + 512 * q) * 8);
    const bf16_t* Pw = P + (size_t)(8 * wid) * INP;
    const u32x4 v0 = *(const u32x4*)(Pw + (size_t)(lane >> 4) * INP + C_CV + h * 128 + (lane & 15) * 8), v1 = *(const u32x4*)(Pw + (size_t)(4 + (lane >> 4)) * INP + C_CV + h * 128 + (lane & 15) * 8);
    f32x4 sv[8];
#pragma unroll
    for (int q = 0; q < 8; ++q) sv[q] = *(const f32x4*)(KVS + (size_t)slot * 8192 + (size_t)(tid + 512 * q) * 4);
    __syncthreads();
#pragma unroll
    for (int q = 0; q < 4; ++q) { const int idx = tid + 512 * q, arr = idx >> 9, rem = idx & 511, j = rem >> 3, c = rem & 7; *(LAS u32x4*)(B + GB_QDF + arr * 9216 + (j * HS + c * 8) * 2) = qk[q]; }
    gla_store_vt(v0, v1, B, wid, lane);
#pragma unroll
    for (int q = 0; q < 8; ++q) { const int idx = tid + 512 * q, dir = idx >> 11, i = idx & 2047, e = i >> 4, d4 = (i & 15) * 4;
        u32x2 w; w.x = cvt_pk_bf16(sv[q].x, sv[q].y); w.y = cvt_pk_bf16(sv[q].z, sv[q].w); *(LAS u32x2*)(B + (dir ? GB_SBT : GB_SFT) + (e * HS + d4) * 2) = w; }
    __syncthreads();
    if (wid < 4) { const int ib = wid >> 1, jb = wid & 1; f32x16 cf = {}, cb = {};
#pragma unroll
        for (int ks = 0; ks < 4; ++ks) {
            cf = __builtin_amdgcn_mfma_f32_32x32x16_bf16(ldfrag(B + GB_QDF, 32 * ib + r32, ks, hi), ldfrag(B + GB_KDF, 32 * jb + r32, ks, hi), cf, 0, 0, 0);
            cb = __builtin_amdgcn_mfma_f32_32x32x16_bf16(ldfrag(B + GB_QDB, 32 * ib + r32, ks, hi), ldfrag(B + GB_KDB, 32 * jb + r32, ks, hi), cb, 0, 0, 0); }
#pragma unroll
        for (int r = 0; r < 16; ++r) { const int i = 32 * ib + crow16(r, hi), j = 32 * jb + r32;
            const float v = (j <= i ? cf[r] : 0.f) + (j >= i ? cb[r] : 0.f);
            *(LAS unsigned short*)(B + GB_ATT + (i * HS + j) * 2) = f2bf(v); } }
    __syncthreads();
    { const int ib = wid >> 2, eb = wid & 3; f32x16 acc = {};
#pragma unroll
      for (int ks = 0; ks < 4; ++ks) {
          acc = __builtin_amdgcn_mfma_f32_32x32x16_bf16(ldfrag(B + GB_ATT, 32 * ib + r32, ks, hi), ldfrag(B + GB_VT, 32 * eb + r32, ks, hi), acc, 0, 0, 0);
          acc = __builtin_amdgcn_mfma_f32_32x32x16_bf16(ldfrag(B + GB_QDF, 32 * ib + r32, ks, hi), ldfrag(B + GB_SFT, 32 * eb + r32, ks, hi), acc, 0, 0, 0);
          acc = __builtin_amdgcn_mfma_f32_32x32x16_bf16(ldfrag(B + GB_QDB, 32 * ib + r32, ks, hi), ldfrag(B + GB_SBT, 32 * eb + r32, ks, hi), acc, 0, 0, 0); }
#pragma unroll
      for (int r = 0; r < 16; ++r) L[(32 * ib + crow16(r, hi)) * 128 + 32 * eb + r32] = acc[r]; }
    __syncthreads();
    const int i0 = (tid >> 5) * 4, e4 = (tid & 31) * 4;
    bf16_t* Z = (bf16_t*)(a.ws + WS_HZ);
    const f32x4 gn = *(const f32x4*)(a.in[I_CON] + l * 128 + e4);
#pragma unroll
    for (int r = 0; r < 4; ++r) { const f32x4 o = *(const LAS f32x4*)(L + (i0 + r) * 128 + e4);
        float ss = (o.x * o.x + o.y * o.y) + (o.z * o.z + o.w * o.w);
#pragma unroll
        for (int m = 1; m < 32; m <<= 1) ss += __shfl_xor(ss, m);
        const float rs = rsqrtf(ss * (1.f / 128.f) + EPS);
        const size_t row = (size_t)cc * 64 + i0 + r;
        const u32x2 gw = *(const u32x2*)(P + (size_t)(i0 + r) * INP + C_CG + h * 128 + e4);
        const f32x4 y = o * rs * gn;
        u32x2 w; w.x = cvt_pk_bf16(y.x * silu_f(bflo(gw.x)), y.y * silu_f(bfhi(gw.x))); w.y = cvt_pk_bf16(y.z * silu_f(bflo(gw.y)), y.w * silu_f(bfhi(gw.y)));
        *(u32x2*)(Z + row * DM + 1536 + h * 128 + e4) = w; }
}

__device__ __forceinline__ void phase_mixer(CArgs& a, int l, unsigned char* lds_g, LAS unsigned char* lds, int dup) {
    int tid = threadIdx.x; asm volatile("" : "+v"(tid));
    unsigned* ctr = (unsigned*)(a.ws + WS_CTL) + CW_QUEUE + 64 * l + 32 * dup;
    volatile LAS unsigned* qw = (volatile LAS unsigned*)(lds + LDS_QWORD);
    const bf16_t* PROJ = (const bf16_t*)(a.ws + WS_PROJ); const bf16_t* QB = (const bf16_t*)(a.ws + WS_QB); const bf16_t* KB = (const bf16_t*)(a.ws + WS_KB);
    const bf16_t* KVB = (const bf16_t*)(a.ws + WS_KVB); bf16_t* Z = (bf16_t*)(a.ws + WS_HZ);
    const int nG = (l == 0) ? NCHUNK * 4 : 256 * 4, nC = (l == 0) ? 48 : 0, total = 768 + nG + nC;
    for (;;) {
        __syncthreads();
        if (tid == 0) *qw = atomicAdd(ctr, 1u);
        __syncthreads();
        const int idx = (int)*qw;
        if (idx >= total) break;
        int kind, b, h, seq; size_t q0;
        if (idx < 256) { kind = 0; b = idx >> 6; h = (idx >> 4) & 3; q0 = (size_t)b * TOK + CTXL + (idx & 15) * 256; seq = TOK; }
        else if (idx < 768) { const int i = idx - 256; kind = 1; b = i >> 7; h = (i >> 4) & 7; q0 = (size_t)b * TOK + CTXL + (i & 15) * 256; seq = TOK; }
        else if (idx < 768 + nG) { kind = 2; b = 0; h = 0; q0 = 0; seq = 0; }
        else { const int i = idx - 768 - nG; seq = CTXL;
            if (i < 32) { kind = 1; b = i >> 3; h = i & 7; } else { kind = 0; b = (i - 32) >> 2; h = (i - 32) & 3; }
            q0 = (size_t)b * TOK; }
        const size_t r0 = (size_t)b * TOK;
        if (PROBE_KIND >= 0 && dup && kind != PROBE_KIND) continue;
        bf16_t* Zo = (PROBE_ATT && dup) ? (bf16_t*)((float*)a.out + (10u << 20)) : Z;
#ifndef NO_ATTB
        if (kind == 0)
            att::attn_body_s<192, 768, 768, 1024, DM>(QB + q0 * 768 + h * 192, KB + r0 * 768 + h * 192, KVB + r0 * 1024 + h * 256 + 128, Zo + q0 * DM + 1024 + h * 128, seq, (char*)lds_g, dup);
#endif
#ifndef NO_ATTA
        if (kind == 1)
            att::attn_body_s<128, INP, INP, INP, DM>(PROJ + q0 * INP + C_AQ + h * 128, PROJ + r0 * INP + C_AK + (h >> 2) * 128, PROJ + r0 * INP + C_AV + (h >> 2) * 128, Zo + q0 * DM + h * 128, seq, (char*)lds_g, dup);
#endif
#ifndef NO_GLA3
        if (kind == 2) {
            const int i = idx - 768; int cc; const int hh = i & 3;
            if (l == 0) cc = i >> 2; else { const int lc = i >> 2; cc = (lc >> 6) * 68 + (lc & 63) + 4; }
            gla_p3(a, l, cc, hh, (LAS float*)lds);
        }
#endif
    }
}

__device__ __forceinline__ void run_phase(CArgs& a, int ph, unsigned char* lds_g, LAS unsigned char* lds, int dup) {
    int tid = threadIdx.x; asm volatile("" : "+v"(tid));
    const int lane = tid & 63, wid = tid >> 6;
    const int G = gridDim.x, gw = blockIdx.x * 8 + wid, NGW = G * 8;
    if (ph == 0) { phase_prologue(a, lds); return; }
    const int l = (ph - 1) / 10, k = (ph - 1) % 10;
    unsigned char* wb = a.ws + WS_W + (size_t)l * W_LAYER;
    const float* MOD = (const float*)(a.ws + WS_MOD) + (size_t)l * 5 * 12288;
    if (k == 0 || k == 7) { phase_norm(a, l, k == 7); return; }
    if (k == 1 || k == 3) {
        const int ng = (k == 1) ? 1 : 2;
        for (int gi = 0; gi < ng; ++gi) {
            if (PROBE_DUP == 20 && dup) break;
            pg8::Gemm g; pg8::EpiStore E; E.skipctx = 0;
            if (k == 1) { g = pg8::Gemm{(const bf16_t*)(a.ws + WS_HZ), (const bf16_t*)(wb + WO_IN), NR, INP, DM, DM, 0, DM}; E.O = (bf16_t*)(a.ws + WS_PROJ); E.ldc = INP; }
            else if (gi == 0) { g = pg8::Gemm{(const bf16_t*)(a.ws + WS_PROJ) + C_BCQ, (const bf16_t*)(wb + WO_UQ), NR, 768, 512, INP, 0, 512}; E.O = (bf16_t*)(a.ws + WS_QB); E.ldc = 768; }
            else { g = pg8::Gemm{(const bf16_t*)(a.ws + WS_PROJ) + C_BCKV, (const bf16_t*)(wb + WO_UKV), NR, 1024, 256, INP, 0, 256}; E.O = (bf16_t*)(a.ws + WS_KVB); E.ldc = 1024; }
            pg8::StaticOrder S; S.init(g.M, g.N, G, (int)blockIdx.x);
            pg8::gemm_phase<pg8::EpiStore>(lds, g, S, E);
        }
        if (k == 3) gla_scan(a, dup);
        return;
    }
    if (k == 2) {
        if (!dup || PROBE_DUP == 20) for (int r = gw; r < NR; r += 2 * NGW) { const int r1 = r + NGW; const bool two = r1 < NR;
            E1Regs g0, g1; e1_load(a, r, lane, g0); e1_load(a, two ? r1 : r, lane, g1); asm volatile("" ::: "memory");
            e1_row(a, l, r, lane, dup, g0); if (two) e1_row(a, l, r1, lane, dup, g1); }
        if (!(dup && PROBE_DUP == 20)) { int hst = -1; for (int u = blockIdx.x; u < NCHUNK * 4; u += G) { const int h = u & 3; gla_p1(a, l, u >> 2, h, (LAS float*)lds, dup, h != hst); hst = h; } }
        return;
    }
    if (k == 4) { for (int r = gw; r < NR; r += 2 * NGW) { const int r1 = r + NGW; const bool two = r1 < NR;
            E2Regs g0, g1; e2_load(a, r, lane, g0); e2_load(a, two ? r1 : r, lane, g1); asm volatile("" ::: "memory");
            e2_row(a, l, r, lane, dup, g0); if (two) e2_row(a, l, r1, lane, dup, g1); }
        return; }
    if (k == 5) { phase_mixer(a, l, lds_g, lds, dup); return; }
    if (k == 6 || k == 9) {
        pg8::Gemm g; pg8::EpiResid E;
        if (k == 6) g = pg8::Gemm{(const bf16_t*)(a.ws + WS_HZ), (const bf16_t*)(wb + WO_OUT), NBATCH * SEQ, DM, DM, DM, 1, DM};
        else g = pg8::Gemm{(const bf16_t*)(a.ws + WS_ACT), (const bf16_t*)(wb + WO_DN), NBATCH * SEQ, DM, DFF, DFF, 1, DFF};
        E.xin = a.in[I_X]; E.ctxin = a.in[I_CTX]; E.xr_in = (const float*)(a.ws + WS_XR); E.xr_out = (float*)(a.ws + WS_XR); E.fin_out = a.out;
        E.gate = MOD + (k == 6 ? 2 : 5) * DM; E.in_split = (l == 0 && k == 6); E.out_final = (l == 1 && k == 9); E.skipctx = 1;
        pg8::StaticOrder S; S.init(g.M, g.N, G, (int)blockIdx.x);
        pg8::gemm_phase<pg8::EpiResid>(lds, g, S, E);
        if (l == 0) {
            const int ks = (k == 6) ? 8 : 4;
            pg8::Gemm g2 = g; g2.M = NBATCH * CTXL; g2.skipctx = 2; g2.kpart = g.K / ks;
            pg8::EpiPartial E2{(float*)a.out + PART_OFF};
            pg8::StaticOrder S2; S2.init(g2.M, g2.N, G, (int)blockIdx.x, ks);
            pg8::gemm_phase<pg8::EpiPartial>(lds, g2, S2, E2);
        }
        return;
    }
    if (k == 8) {
        const int skip = (l == 1);
        pg8::Gemm g{(const bf16_t*)(a.ws + WS_HZ), (const bf16_t*)(wb + WO_GU), skip ? NBATCH * SEQ : NR, 2 * DFF, DM, DM, skip, DM};
        pg8::EpiSwiGLU E{(bf16_t*)(a.ws + WS_ACT), skip};
        pg8::StaticOrder S; S.init(g.M, g.N, G, (int)blockIdx.x);
        pg8::gemm_phase<pg8::EpiSwiGLU>(lds, g, S, E);
        return;
    }
}

#define XB_TMO      128
#define XB_XCNT(j)  (256  + 64 * (j))
#define XB_XSUB(j)  (1280 + 64 * (j))
#define XB_XGEN(j)  (2304 + 64 * (j))
#define XB_TOP      3328
#define XB_TOPGEN   3392
#define XCD_BAR_WORDS 3456
#define XB_SPIN_CAP (1u << 22)
constexpr int CW_BAR = 4096;
__device__ __forceinline__ unsigned xb_ld(unsigned* p)              { return __hip_atomic_load(p, __ATOMIC_RELAXED, __HIP_MEMORY_SCOPE_AGENT); }
__device__ __forceinline__ unsigned xb_add(unsigned* p, unsigned v) { return __hip_atomic_fetch_add(p, v, __ATOMIC_RELAXED, __HIP_MEMORY_SCOPE_AGENT); }
__device__ __forceinline__ unsigned xb_xcc_id() { return (unsigned)__builtin_amdgcn_s_getreg((3 << 11) | 20) & 0xFu; }
#define XB_SPIN(cond, bar) do { unsigned _sp = 0; while (cond) { __builtin_amdgcn_s_sleep(1); \
    if ((++_sp & 255u) == 0u) { if (xb_ld(&(bar)[XB_TMO])) break; if (_sp > XB_SPIN_CAP) { atomicAdd(&(bar)[XB_TMO], 1u); break; } } } } while (0)
struct XcdBarrier { unsigned* bar; unsigned x; volatile LAS unsigned* st; };
__device__ __forceinline__ XcdBarrier xcd_barrier_post(unsigned* bar, volatile LAS unsigned* st) {
    XcdBarrier b; b.bar = bar; b.x = xb_xcc_id(); b.st = st;
    if (threadIdx.x == 0) (void)xb_add(&bar[XB_XCNT(b.x)], 1u);
    return b;
}
__device__ __forceinline__ void xcd_barrier_complete(unsigned* bar, unsigned x, unsigned& nloc, unsigned& nx) {
    const unsigned G = gridDim.x * gridDim.y * gridDim.z;
    unsigned sum, cnt, mine, sp = 0u;
    for (;;) {
        sum = 0u; cnt = 0u; mine = 0u;
#pragma unroll
        for (unsigned j = 0; j < 16; ++j) { const unsigned c = xb_ld(&bar[XB_XCNT(j)]); sum += c; cnt += (c > 0u) ? 1u : 0u; mine = (j == x) ? c : mine; }
        if (sum == G) break;
        __builtin_amdgcn_s_sleep(1);
        if ((++sp & 255u) == 0u) { if (xb_ld(&bar[XB_TMO])) break; if (sp > XB_SPIN_CAP) { atomicAdd(&bar[XB_TMO], 1u); break; } }
    }
    nloc = mine > 0u ? mine : 1u; nx = cnt > 0u ? cnt : 1u;
}
__device__ __forceinline__ void xcd_barrier(const XcdBarrier& b) {
    asm volatile("s_waitcnt vmcnt(0)" ::: "memory");
    __syncthreads();
    if (threadIdx.x == 0) {
        unsigned* bar = b.bar;
        __builtin_amdgcn_s_waitcnt(0);
        unsigned nloc = b.st[0], nx = b.st[1];
        if (nloc == 0u) { xcd_barrier_complete(bar, b.x, nloc, nx); b.st[0] = nloc; b.st[1] = nx; }
        const unsigned old = xb_add(&bar[XB_XSUB(b.x)], 1u);
        const unsigned gen = old / nloc;
        if (old + 1u == (gen + 1u) * nloc) {
            __builtin_amdgcn_fence(__ATOMIC_RELEASE, "agent");
            asm volatile("s_waitcnt vmcnt(0)" ::: "memory");
            const unsigned og = xb_add(&bar[XB_TOP], 1u);
            const unsigned tg = og / nx;
            if (og + 1u == (tg + 1u) * nx) xb_add(&bar[XB_TOPGEN], 1u);
            else XB_SPIN(xb_ld(&bar[XB_TOPGEN]) == tg, bar);
            __builtin_amdgcn_fence(__ATOMIC_ACQUIRE, "agent");
            xb_add(&bar[XB_XGEN(b.x)], 1u);
            asm volatile("s_waitcnt vmcnt(0)" ::: "memory");
        } else {
            XB_SPIN(xb_ld(&bar[XB_XGEN(b.x)]) == gen, bar);
            __builtin_amdgcn_fence(__ATOMIC_ACQUIRE, "agent");
            asm volatile("s_waitcnt vmcnt(0)" ::: "memory");
        }
    }
    __syncthreads();
}

__global__ void __launch_bounds__(512, 2) mega(Args a) {
    extern __shared__ __attribute__((aligned(16))) unsigned char lds_raw[];
    cg::grid_group grid = cg::this_grid();
    volatile LAS unsigned* bst = (volatile LAS unsigned*)((LAS unsigned char*)lds_raw + LDS_QWORD + 16);
    if (threadIdx.x < 2) bst[threadIdx.x] = 0u;
    __syncthreads();
    const XcdBarrier bar = xcd_barrier_post((unsigned*)(a.ws + WS_CTL) + CW_BAR, bst);
    if (a.coop == 0x7fffffff) grid.sync();
    int dup = 0;
    for (int ph = a.ph_lo; ph < a.ph_hi; ++ph) {
        CArgs* ap = (CArgs*)__builtin_amdgcn_kernarg_segment_ptr(); asm volatile("" : "+s"(ap));
        run_phase(*ap, ph, lds_raw, (LAS unsigned char*)lds_raw, dup);
        if (PROBE_DUP >= 0 && dup == 0 && ((ph > 0 && (ph - 1) % 10 == PROBE_DUP) || (ph == 0 && PROBE_DUP == 10) || (PROBE_DUP == 20 && ph > 0 && ((ph - 1) % 10 == 2 || (ph - 1) % 10 == 3 || (ph - 1) % 10 == 4)))) { dup = 1; --ph; } else dup = 0;
        if (ph + 1 < a.ph_hi) { xcd_barrier(bar); for (int q = 0; q < PROBE_SYNC; ++q) xcd_barrier(bar); }
    }
}

constexpr int NPHASE = 21;
extern "C" void kernel_launch(void* const* d_in, const int* in_sizes, int n_in, void* d_out, int out_size, void* d_ws, size_t ws_size, hipStream_t stream) {
    static int grid = 0;
    if (grid == 0) {
        if (n_in != 28 || ws_size < WS_END) { fprintf(stderr, "kernel_launch: unexpected n_in %d or ws %zu < %zu\n", n_in, ws_size, (size_t)WS_END); grid = -1; return; }
        int dev = 0, cus = 0, per_cu = 0;
        hipGetDevice(&dev); hipDeviceGetAttribute(&cus, hipDeviceAttributeMultiprocessorCount, dev);
        if (hipFuncSetAttribute((const void*)mega, hipFuncAttributeMaxDynamicSharedMemorySize, LDS_BYTES) != hipSuccess) { fprintf(stderr, "kernel_launch: hipFuncSetAttribute failed\n"); grid = -1; return; }
        if (hipOccupancyMaxActiveBlocksPerMultiprocessor(&per_cu, (const void*)mega, 512, LDS_BYTES) != hipSuccess || per_cu < 1) per_cu = 1;
        (void)hipGetLastError();
        grid = cus * per_cu;
    }
    if (grid < 0) return;
    hipMemsetAsync((char*)d_ws + WS_CTL, 0, CTL_BYTES, stream);
    Args a{};
    for (int i = 0; i < 28; ++i) a.in[i] = (const float*)d_in[i];
    a.out = (float*)d_out; a.ws = (unsigned char*)d_ws; a.coop = MK_COOP; a.pad = 0;
#if MK_COOP
    a.ph_lo = 0; a.ph_hi = NPHASE;
    void* args[] = {&a};
    hipError_t e = hipLaunchCooperativeKernel((const void*)mega, dim3(grid), dim3(512), args, LDS_BYTES, stream);
    if (e != hipSuccess) fprintf(stderr, "cooperative launch failed: %s (grid %d)\n", hipGetErrorString(e), grid);
#else
    for (int ph = 0; ph < NPHASE; ++ph) { a.ph_lo = ph; a.ph_hi = ph + 1; hipLaunchKernelGGL(mega, dim3(grid), dim3(512), LDS_BYTES, stream, a); }
#endif
}
```
